# Optimizing an MI355X kernel written in HIP

```python
import math
import jax, jax.numpy as jnp
from jax import lax
import numpy as np

D_MODEL = 1024
BATCH = 1
SEQ = 16384
DEPTH = 4

FOX_HEADS = 4
FOX_HEAD_DIM = 64
FOX_WIDTH = FOX_HEADS * FOX_HEAD_DIM
Q_BLOCK = 128

GLA_HEADS = 4
GLA_DK = 32
GLA_DV = 64
GLA_KW = GLA_HEADS * GLA_DK
GLA_VW = GLA_HEADS * GLA_DV
GLA_RANK = 16
GLA_TAU = 16.0
GLA_CHUNK = 64

MOBA_HEADS = 4
MOBA_HEAD_DIM = 64
MOBA_WIDTH = MOBA_HEADS * MOBA_HEAD_DIM
MOBA_BLOCK = 256
MOBA_TOPK = 3

N_BRANCH = 3
BRANCH_WIDTH = 256

N_EXPERTS = 32
TOP_K = 4
D_EXPERT = D_MODEL
SWIGLU_LIMIT = 7.0
SWIGLU_ALPHA = 1.702
MOE_BLOCK = 128

ALPHA = (2 * DEPTH) ** 0.25
BETA = (8 * DEPTH) ** -0.25
LN_EPS = 1e-5
RMS_EPS = 1e-6

SPLIT_SIZES = (
    FOX_WIDTH, FOX_WIDTH, FOX_WIDTH, FOX_HEADS,
    GLA_KW, GLA_KW, GLA_VW, GLA_RANK, GLA_VW,
    MOBA_WIDTH, MOBA_WIDTH, MOBA_WIDTH,
    N_BRANCH * D_MODEL,
)
SPLIT_POINTS = tuple(int(p) for p in np.cumsum(SPLIT_SIZES)[:-1])
D_IN = sum(SPLIT_SIZES)

kernel_name = 'hybrid_fox_gla_moba_moe_deepnorm'

F32 = jnp.float32


def layer_norm(x, g, b):
    xf = x.astype(F32)
    mu = jnp.mean(xf, axis=-1, keepdims=True)
    var = jnp.mean(jnp.square(xf - mu), axis=-1, keepdims=True)
    return ((xf - mu) * lax.rsqrt(var + LN_EPS)).astype(x.dtype) * g + b


def head_rms_norm(o, g):
    B, S = o.shape[0], o.shape[1]
    of = o.astype(F32)
    of = of * lax.rsqrt(jnp.mean(of * of, axis=-1, keepdims=True) + RMS_EPS)
    return of.astype(o.dtype).reshape(B, S, -1) * g


def forgetting_attention(q, k, v, f_logit):
    B, S, H, Dh = q.shape
    c = jnp.cumsum(jax.nn.log_sigmoid(f_logit.astype(F32)), axis=1)
    cT = c.transpose(0, 2, 1)
    n_blk = S // Q_BLOCK
    qb = q.reshape(B, n_blk, Q_BLOCK, H, Dh).transpose(1, 0, 2, 3, 4)
    cb = c.reshape(B, n_blk, Q_BLOCK, H).transpose(1, 0, 2, 3)
    pos_k = jnp.arange(S)
    scale = Dh ** -0.5

    def block(args):
        i, q_i, c_i = args
        s = jnp.einsum('bqhd,bkhd->bhqk', q_i, k).astype(F32) * scale
        s = s + c_i.transpose(0, 2, 1)[..., None] - cT[:, :, None, :]
        pos_q = i * Q_BLOCK + jnp.arange(Q_BLOCK)
        s = jnp.where(pos_k[None, :] <= pos_q[:, None], s, -jnp.inf)
        p = jax.nn.softmax(s, axis=-1).astype(v.dtype)
        return jnp.einsum('bhqk,bkhd->bqhd', p, v)

    o = lax.map(block, (jnp.arange(n_blk), qb, cb))
    return o.transpose(1, 0, 2, 3, 4).reshape(B, S, H * Dh)


def gated_linear_attention(q, k, v, log_a):
    B, S, H, dk = q.shape
    dv = v.shape[-1]
    C = GLA_CHUNK
    n = S // C

    def to_chunks(t):
        return t.reshape(B, n, C, H, t.shape[-1]).transpose(1, 0, 3, 2, 4)

    qc, kc, vc, ac = to_chunks(q), to_chunks(k), to_chunks(v), to_chunks(log_a)
    causal = jnp.tril(jnp.ones((C, C), dtype=bool))
    scale = dk ** -0.5

    def step(state, inp):
        q_i, k_i, v_i, a_i = inp
        b = jnp.cumsum(a_i, axis=2)
        qf = q_i.astype(F32) * scale
        kf = k_i.astype(F32)
        vf = v_i.astype(F32)
        o_inter = jnp.einsum('bhck,bhkv->bhcv', qf * jnp.exp(b), state)
        diff = jnp.where(causal[..., None], b[:, :, :, None, :] - b[:, :, None, :, :], -jnp.inf)
        A = jnp.einsum('bhtk,bhsk,bhtsk->bhts', qf, kf, jnp.exp(diff))
        o_intra = jnp.einsum('bhts,bhsv->bhtv', A, vf)
        b_last = b[:, :, -1:, :]
        new_state = state * jnp.exp(b_last[:, :, 0, :])[..., None] + jnp.einsum(
            'bhck,bhcv->bhkv', kf * jnp.exp(b_last - b), vf)
        return new_state, o_inter + o_intra

    state0 = jnp.zeros((B, H, dk, dv), F32)
    _, o = lax.scan(step, state0, (qc, kc, vc, ac))
    return o.transpose(1, 0, 3, 2, 4).reshape(B, S, H, dv).astype(v.dtype)


def block_sparse_attention(q, k, v):
    B, S, H, Dh = q.shape
    L = MOBA_BLOCK
    Sp = -(-S // L) * L
    pad = ((0, 0), (0, Sp - S), (0, 0), (0, 0))
    nb = Sp // L
    n_gate = max(nb, MOBA_TOPK)
    kb = jnp.pad(k, pad).reshape(B, nb, L, H, Dh).transpose(0, 3, 1, 2, 4)
    vb = jnp.pad(v, pad).reshape(B, nb, L, H, Dh).transpose(0, 3, 1, 2, 4)
    k_mean = jnp.mean(kb.astype(F32), axis=3)
    k_mean = jnp.pad(k_mean, ((0, 0), (0, 0), (0, n_gate - nb), (0, 0)))
    n_q = S // Q_BLOCK
    qb = q.reshape(B, n_q, Q_BLOCK, H, Dh).transpose(1, 0, 2, 3, 4)
    scale = Dh ** -0.5
    bi = jnp.arange(B)[:, None, None, None]
    hi = jnp.arange(H)[None, None, :, None]
    slot = jnp.arange(MOBA_TOPK)
    blk_ids = jnp.arange(n_gate)

    def block(args):
        i, q_i = args
        pos_q = i * Q_BLOCK + jnp.arange(Q_BLOCK)
        own = (i * Q_BLOCK) // L
        gate = jnp.einsum('bqhd,bhnd->bqhn', q_i.astype(F32), k_mean)
        gate = jnp.where(blk_ids < own, gate, -jnp.inf)
        _, idx = lax.top_k(gate, MOBA_TOPK)
        idx = jnp.minimum(idx, nb - 1)
        valid = slot < own
        k_sel = kb[bi, hi, idx]
        v_sel = vb[bi, hi, idx]
        s_sel = jnp.einsum('bqhd,bqhnld->bqhnl', q_i, k_sel).astype(F32) * scale
        s_sel = jnp.where(valid[:, None], s_sel, -jnp.inf).reshape(B, Q_BLOCK, H, MOBA_TOPK * L)
        k_own = lax.dynamic_slice_in_dim(kb, own, 1, axis=2)[:, :, 0]
        v_own = lax.dynamic_slice_in_dim(vb, own, 1, axis=2)[:, :, 0]
        s_own = jnp.einsum('bqhd,bhld->bqhl', q_i, k_own).astype(F32) * scale
        pos_k = own * L + jnp.arange(L)
        s_own = jnp.where((pos_k[None, :] <= pos_q[:, None])[:, None, :], s_own, -jnp.inf)
        p = jax.nn.softmax(jnp.concatenate([s_sel, s_own], axis=-1), axis=-1).astype(v.dtype)
        p_sel = p[..., :MOBA_TOPK * L].reshape(B, Q_BLOCK, H, MOBA_TOPK, L)
        p_own = p[..., MOBA_TOPK * L:]
        return (jnp.einsum('bqhnl,bqhnld->bqhd', p_sel, v_sel)
                + jnp.einsum('bqhl,bhld->bqhd', p_own, v_own))

    o = lax.map(block, (jnp.arange(n_q), qb))
    return o.transpose(1, 0, 2, 3, 4).reshape(B, S, H * Dh)


def mixer(x, w_in, fox_fb, gla_a_up, gla_a_b, gla_norm_g, w_branch, w_out):
    B, S, _ = x.shape
    (fq, fk, fv, ff, gq, gk, gv, ga, gr, mq, mk, mv, gates) = jnp.split(
        x @ w_in, SPLIT_POINTS, axis=-1)

    def heads(t, h):
        return t.reshape(B, S, h, -1)

    y_fox = forgetting_attention(heads(fq, FOX_HEADS), heads(fk, FOX_HEADS), heads(fv, FOX_HEADS),
                                 ff + fox_fb)
    log_a = jax.nn.log_sigmoid((ga @ gla_a_up + gla_a_b).astype(F32)) / GLA_TAU
    o_gla = gated_linear_attention(heads(gq, GLA_HEADS), heads(gk, GLA_HEADS), heads(gv, GLA_HEADS),
                                   heads(log_a, GLA_HEADS))
    y_gla = head_rms_norm(o_gla, gla_norm_g) * jax.nn.silu(gr)
    y_moba = block_sparse_attention(heads(mq, MOBA_HEADS), heads(mk, MOBA_HEADS), heads(mv, MOBA_HEADS))
    ys = jnp.stack([y_fox, y_gla, y_moba], axis=2)
    up = jnp.einsum('bsnc,ncd->bsnd', ys, w_branch)
    g = jax.nn.sigmoid(gates.reshape(B, S, N_BRANCH, D_MODEL))
    merged = jnp.sum(g * up, axis=2)
    return merged @ w_out


def moe(x, w_router, b_router, w_gu, b_gu, w_dn, b_dn):
    B, S, D = x.shape
    T = B * S
    x2 = x.reshape(T, D)
    logits = (x2 @ w_router + b_router).astype(F32)
    top_v, top_i = lax.top_k(logits, TOP_K)
    gates = jax.nn.softmax(top_v, axis=-1).astype(x.dtype)
    n_assign = T * TOP_K
    flat_e = top_i.reshape(-1)
    flat_tok = jnp.repeat(jnp.arange(T, dtype=jnp.int32), TOP_K)
    order = jnp.argsort(flat_e)
    sorted_e = flat_e[order]
    sorted_tok = flat_tok[order]
    sorted_gate = gates.reshape(-1)[order]
    counts = jnp.bincount(flat_e, length=N_EXPERTS)
    padded = (counts + MOE_BLOCK - 1) // MOE_BLOCK * MOE_BLOCK
    pad_end = jnp.cumsum(padded)
    pad_start = pad_end - padded
    start = jnp.cumsum(counts) - counts
    dest = pad_start[sorted_e] + (jnp.arange(n_assign) - start[sorted_e])
    n_blocks = (n_assign + N_EXPERTS * (MOE_BLOCK - 1) + MOE_BLOCK - 1) // MOE_BLOCK
    buf_tok = jnp.zeros((n_blocks * MOE_BLOCK,), jnp.int32).at[dest].set(sorted_tok)
    block_expert = jnp.clip(jnp.searchsorted(pad_end, jnp.arange(n_blocks) * MOE_BLOCK, side='right'),
                            0, N_EXPERTS - 1)
    xin = x2[buf_tok].reshape(n_blocks, MOE_BLOCK, D)

    def expert_block(args):
        xb, e = args
        h = xb @ w_gu[e] + b_gu[e]
        gate = jnp.minimum(h[:, 0::2], SWIGLU_LIMIT)
        upv = jnp.clip(h[:, 1::2], -SWIGLU_LIMIT, SWIGLU_LIMIT)
        act = (upv + 1.0) * (gate * jax.nn.sigmoid(SWIGLU_ALPHA * gate))
        return act @ w_dn[e] + b_dn[e]

    yb = lax.map(expert_block, (xin, block_expert)).reshape(n_blocks * MOE_BLOCK, D)
    y_assign = yb[dest] * sorted_gate[:, None]
    out = jnp.zeros((T, D), x.dtype).at[sorted_tok].add(y_assign)
    return out.reshape(B, S, D)


def setup_inputs(seed: int = 0) -> dict:
    key = jax.random.key(seed)
    ks = jax.random.split(key, 20)
    nrm = jax.random.normal
    x = nrm(ks[0], (BATCH, SEQ, D_MODEL), F32)
    w_in = nrm(ks[1], (DEPTH, D_MODEL, D_IN), F32) * D_MODEL ** -0.5
    fox_fb = (jnp.linspace(1.0, 5.0, FOX_HEADS, dtype=F32)[None, :]
              + 0.01 * nrm(ks[2], (DEPTH, FOX_HEADS), F32))
    gla_a_up = nrm(ks[3], (DEPTH, GLA_RANK, GLA_KW), F32) * GLA_RANK ** -0.5
    gla_a_b = 0.01 * nrm(ks[4], (DEPTH, GLA_KW), F32)
    gla_norm_g = 1.0 + 0.01 * nrm(ks[5], (DEPTH, GLA_VW), F32)
    w_branch = nrm(ks[6], (DEPTH, N_BRANCH, BRANCH_WIDTH, D_MODEL), F32) * BRANCH_WIDTH ** -0.5
    w_out = nrm(ks[7], (DEPTH, D_MODEL, D_MODEL), F32) * (D_MODEL ** -0.5 * BETA)
    ln1_g = 1.0 + 0.01 * nrm(ks[8], (DEPTH, D_MODEL), F32)
    ln1_b = 0.01 * nrm(ks[9], (DEPTH, D_MODEL), F32)
    w_router = nrm(ks[10], (DEPTH, D_MODEL, N_EXPERTS), F32) * D_MODEL ** -0.5
    b_router = 0.01 * nrm(ks[11], (DEPTH, N_EXPERTS), F32)
    w_gu = nrm(ks[12], (DEPTH, N_EXPERTS, D_MODEL, 2 * D_EXPERT), F32) * D_MODEL ** -0.5
    b_gu = 0.01 * nrm(ks[13], (DEPTH, N_EXPERTS, 2 * D_EXPERT), F32)
    w_dn = nrm(ks[14], (DEPTH, N_EXPERTS, D_EXPERT, D_MODEL), F32) * (D_EXPERT ** -0.5 * BETA)
    b_dn = 0.01 * nrm(ks[15], (DEPTH, N_EXPERTS, D_MODEL), F32)
    ln2_g = 1.0 + 0.01 * nrm(ks[16], (DEPTH, D_MODEL), F32)
    ln2_b = 0.01 * nrm(ks[17], (DEPTH, D_MODEL), F32)
    return {'x': x, 'w_in': w_in, 'fox_fb': fox_fb, 'gla_a_up': gla_a_up, 'gla_a_b': gla_a_b,
            'gla_norm_g': gla_norm_g, 'w_branch': w_branch, 'w_out': w_out,
            'ln1_g': ln1_g, 'ln1_b': ln1_b, 'w_router': w_router, 'b_router': b_router,
            'w_gu': w_gu, 'b_gu': b_gu, 'w_dn': w_dn, 'b_dn': b_dn,
            'ln2_g': ln2_g, 'ln2_b': ln2_b}


def reference(x, w_in, fox_fb, gla_a_up, gla_a_b, gla_norm_g, w_branch, w_out,
              ln1_g, ln1_b, w_router, b_router, w_gu, b_gu, w_dn, b_dn, ln2_g, ln2_b):
    for l in range(DEPTH):
        m = mixer(x, w_in[l], fox_fb[l], gla_a_up[l], gla_a_b[l], gla_norm_g[l], w_branch[l], w_out[l])
        x = layer_norm(ALPHA * x + m, ln1_g[l], ln1_b[l])
        f = moe(x, w_router[l], b_router[l], w_gu[l], b_gu[l], w_dn[l], b_dn[l])
        x = layer_norm(ALPHA * x + f, ln2_g[l], ln2_b[l])
    return x
```

```cpp
#include <hip/hip_runtime.h>
#include <cstdio>
#include <cstdint>

#ifndef MK_PER_PHASE
#define MK_PER_PHASE 0
#endif

#ifndef DBG_DUMP
#define DBG_DUMP 0
#endif
#define DBG_AFTER (DBG_DUMP <= 4 ? (DBG_DUMP == 4 ? 2 : 0) : DBG_DUMP == 5 ? 3 : DBG_DUMP == 6 ? 4 : DBG_DUMP == 7 ? 4 : DBG_DUMP == 8 ? 6 : DBG_DUMP == 9 ? 9 : DBG_DUMP == 14 ? 4 : 3)
#ifndef DBG_NO_MOE
#define DBG_NO_MOE 0
#endif
#define LAS __attribute__((address_space(3)))
#define GAS __attribute__((address_space(1)))
typedef unsigned short bf16;
typedef short bf16x8 __attribute__((ext_vector_type(8)));
typedef float f32x4 __attribute__((ext_vector_type(4)));
typedef float f32x2 __attribute__((ext_vector_type(2)));
typedef unsigned u32x4 __attribute__((ext_vector_type(4)));
typedef unsigned u32x2 __attribute__((ext_vector_type(2)));

constexpr int S = 16384, D = 1024, DEPTH = 4;
constexpr int D_IN = 5396, NIN = 5632;
constexpr int NE = 32;
constexpr int NSLOT = 73728;
constexpr float ALPHA = 1.6817928305074290f;
constexpr float LOG2E = 1.4426950408889634f;
constexpr float C2 = 0.125f * LOG2E;
constexpr float LN_EPS = 1e-5f, RMS_EPS = 1e-6f;
constexpr int NPH = 10;
constexpr int NPHASE = 1 + DEPTH * NPH;

constexpr size_t MiB = 1ull << 20;
constexpr size_t WS_CTL = 0, CTL_ZERO_BYTES = 1 * MiB;
constexpr size_t WS_WIN = 1 * MiB;
constexpr size_t WS_WBR = WS_WIN + 44 * MiB;
constexpr size_t WS_WOUT = WS_WBR + 6 * MiB;
constexpr size_t WS_WGU = WS_WOUT + 8 * MiB;
constexpr size_t WS_WDN = WS_WGU + 512 * MiB;
constexpr size_t WS_XB = WS_WDN + 256 * MiB;
constexpr size_t WS_X1 = WS_XB + 32 * MiB;
constexpr size_t WS_PROJ = WS_X1 + 32 * MiB;
constexpr size_t WS_SG = WS_PROJ + 72 * MiB;
constexpr size_t WS_LA = WS_SG + 96 * MiB;
constexpr size_t WS_FFL = WS_LA + 8 * MiB;
constexpr size_t WS_CF = WS_FFL + 1 * MiB;
constexpr size_t WS_YS = WS_CF + 1 * MiB;
constexpr size_t WS_T = WS_YS + 24 * MiB;
constexpr size_t WS_MRG = WS_T + 64 * MiB;
constexpr size_t WS_Y = WS_MRG + 32 * MiB;
constexpr size_t WS_ACT = WS_Y + 64 * MiB;
constexpr size_t WS_YB = WS_ACT + 144 * MiB;
constexpr size_t WS_U = WS_YB + 144 * MiB;
constexpr size_t WS_SST = WS_U + 8 * MiB;
constexpr size_t WS_DEC = WS_SST + 8 * MiB;
constexpr size_t WS_KM = WS_DEC + 1 * MiB;
constexpr size_t WS_SEL = WS_KM + 1 * MiB;
constexpr size_t WS_QL = WS_SEL + 1 * MiB;
constexpr size_t WS_TOK = WS_QL + 16 * MiB;
constexpr size_t WS_TE = WS_TOK + 2 * MiB;
constexpr size_t WS_TP = WS_TE + 1 * MiB;
constexpr size_t WS_TG = WS_TP + 1 * MiB;
constexpr size_t WS_WBP = WS_TG + 1 * MiB;
constexpr size_t WS_END = WS_WBP + 20 * MiB;
constexpr int CW_BAR = 4096;
constexpr int CW_CNT = 16384;
constexpr int CW_MCNT = 20480;

constexpr int RING_BYTES = 131072;
constexpr int LDSCTL_OFF = RING_BYTES, MISC_OFF = LDSCTL_OFF + 320;
constexpr int TAB_OFF = RING_BYTES + 1024;
constexpr int RT_OFF = RING_BYTES + 4096;
constexpr int LDS_BYTES = 147456;

__device__ __forceinline__ float bf_lo(unsigned w) { return __uint_as_float(w << 16); }
__device__ __forceinline__ float bf_hi(unsigned w) { return __uint_as_float(w & 0xffff0000u); }
__device__ __forceinline__ float bf2f(bf16 b) { return __uint_as_float((unsigned)b << 16); }
typedef __bf16 bf16x2_t __attribute__((ext_vector_type(2)));
__device__ __forceinline__ unsigned cvt_pk_bf16(float lo, float hi) { f32x2 v = {lo, hi}; bf16x2_t b = __builtin_convertvector(v, bf16x2_t); return __builtin_bit_cast(unsigned, b); }
__device__ __forceinline__ float fast_exp2(float x) { return __builtin_amdgcn_exp2f(x); }
__device__ __forceinline__ float fast_rcp(float x) { return __builtin_amdgcn_rcpf(x); }
__device__ __forceinline__ float sigmoidf_(float x) { return fast_rcp(1.f + fast_exp2(-x * LOG2E)); }
__device__ __forceinline__ float logsigmoidf_(float x) { return fminf(x, 0.f) - __logf(1.f + __expf(-fabsf(x))); }
__device__ __forceinline__ float wave_sum(float v) {
#pragma unroll
    for (int o = 1; o < 64; o <<= 1) v += __shfl_xor(v, o);
    return v;
}

namespace pg8 {
constexpr int BM = 256, BK = 64, HALF = 128, HTB = HALF * BK * 2, NXCD = 8, WGM = 8;
__device__ __forceinline__ int lds_byte(int r, int c) { const int st = (r >> 4) * 2 + (c >> 5), rr = r & 15, cc = c & 31, ob = rr * 64 + cc * 2; return st * 1024 + (ob ^ (((ob >> 9) & 1) << 5)); }
__device__ __forceinline__ void stage_rc(int b, int& R, int& C) { const int st = b / 1024, sb = b % 1024, swz = sb ^ (((sb >> 9) & 1) << 5); R = (st >> 1) * 16 + swz / 64; C = (st & 1) * 32 + (swz % 64) / 2; }
__device__ __forceinline__ int perm32(int rho) { const int n = rho >> 4, i = rho & 15; return 8 * (i >> 2) + 4 * n + (i & 3); }

struct Unit { int pm, pn, e; };

struct DenseOrder {
    int nM, nN, nwg, G, c; const char* Bt; int K;
    __device__ void init(int M, int N, int K_, const bf16* Bt_, int G_, int c_) { nM = M / BM; nN = N / BM; nwg = nM * nN; G = G_; c = c_; Bt = (const char*)Bt_; K = K_; }
    __device__ bool next(int i, Unit& u) const {
        const long L = (long)i * G + c; if (L >= nwg) return false;
        int wgid = (int)L; { const int q = nwg / NXCD, r = nwg % NXCD, xcd = wgid % NXCD, off = wgid / NXCD; wgid = (xcd < r ? xcd * (q + 1) : r * (q + 1) + (xcd - r) * q) + off; }
        const int nig = WGM * nN, gid = wgid / nig, fm = gid * WGM, gsz = (nM - fm) < WGM ? (nM - fm) : WGM;
        u.pm = fm + ((wgid % nig) % gsz); u.pn = (wgid % nig) / gsz; u.e = 0; return true;
    }
    __device__ __forceinline__ unsigned arow(const Unit& u, int r) const { return (unsigned)(u.pm * BM + r); }
    __device__ __forceinline__ const char* bbase(const Unit& u) const { return Bt + (size_t)u.pn * BM * K * 2; }
};

struct MoeOrder {
    int G, c, NN, ntiles; const LAS int* tab; const int* toklist; const char* Bt; size_t ebytes; int K;
    __device__ bool next(int i, Unit& u) const {
        const int L = i * G + c; if (L >= ntiles * NN) return false;
        u.pm = L / NN; u.pn = L % NN; u.e = tab[128 + u.pm]; return true;
    }
    __device__ __forceinline__ unsigned arow(const Unit& u, int r) const {
        if (!toklist) return (unsigned)(u.pm * BM + r);
        const int rr = (u.pm - tab[32 + u.e]) * BM + r;
        return rr < tab[u.e] ? (unsigned)toklist[u.e * 16384 + rr] : 0u;
    }
    __device__ __forceinline__ const char* bbase(const Unit& u) const { return Bt + (size_t)u.e * ebytes + (size_t)u.pn * BM * K * 2; }
};

template <class Epi, class Sched, bool ALIGN_EPI, bool GATHER>
__device__ __forceinline__ void gemm_phase(LAS unsigned char* lds, const bf16* Abase, const int K, const Sched& S, const Epi& E) {
    int tid_ = threadIdx.x; asm volatile("" : "+v"(tid_));
    const int tid = tid_, wid = __builtin_amdgcn_readfirstlane(tid >> 6), lane = tid & 63, wr = wid >> 2, wc = wid & 3, fr = lane & 15, fq = lane >> 4;
    const int nt = K / BK;
    unsigned voffA[2], voffB[2];
#pragma unroll
    for (int i = 0; i < 2; ++i) { int R, C; stage_rc(tid * 16 + i * 8192, R, C); const int Rb = Epi::PERM ? ((R & ~31) + perm32(R & 31)) : R;
        voffA[i] = (unsigned)(R * K + C) * 2u; voffB[i] = (unsigned)(Rb * K + C) * 2u; }
    LAS u32x4* const stash = (LAS u32x4*)(lds + RING_BYTES + 8192) + tid;
    const size_t kstep = (size_t)(BK * 2);
    const size_t hstep = (size_t)HALF * K * 2;
    const unsigned ldsw = (unsigned)wid * 1024u;
    const int aoff = lds_byte(wr * 64 + fr, fq * 8), boff = lds_byte(wc * 32 + fr, fq * 8);
    const char* gA = (const char*)Abase;
#define PG8_SA(b, h) (((b) * 2 + (h)) * HTB)
#define PG8_SB(b, h) ((4 + (b) * 2 + (h)) * HTB)
#define PG8_STAGE(bufoff, gbase, voff) do { _Pragma("unroll") for (int _i = 0; _i < 2; ++_i) \
        __builtin_amdgcn_global_load_lds((const unsigned*)((const char*)(gbase) + (voff)[_i]), (LAS unsigned*)(lds + (bufoff) + ldsw + _i * 8192), 16, 0, 0); } while (0)
#define PG8_LDA(dst, b, h) do { _Pragma("unroll") for (int m = 0; m < 4; ++m) _Pragma("unroll") for (int k = 0; k < 2; ++k) dst[m][k] = *(const LAS bf16x8*)(lds + PG8_SA(b, h) + aoff + m * 2048 + k * 1024); } while (0)
#define PG8_LDB(dst, b, h) do { _Pragma("unroll") for (int n = 0; n < 2; ++n) _Pragma("unroll") for (int k = 0; k < 2; ++k) dst[n][k] = *(const LAS bf16x8*)(lds + PG8_SB(b, h) + boff + n * 2048 + k * 1024); } while (0)
#define PG8_MMA(ai, bj, At, Bt) do { __builtin_amdgcn_s_setprio(1); _Pragma("unroll") for (int m = 0; m < 4; ++m) _Pragma("unroll") for (int n = 0; n < 2; ++n) _Pragma("unroll") for (int k = 0; k < 2; ++k) \
        acc[ai][bj][m][n] = __builtin_amdgcn_mfma_f32_16x16x32_bf16(Bt[n][k], At[m][k], acc[ai][bj][m][n], 0, 0, 0); __builtin_amdgcn_s_setprio(0); } while (0)
#define PG8_WAIT_V(n) asm volatile("s_waitcnt vmcnt(" #n ")" ::: "memory")
#define PG8_WAIT_L(n) asm volatile("s_waitcnt lgkmcnt(" #n ")" ::: "memory")
#define PG8_BAR __builtin_amdgcn_s_barrier()
#define PG8_SCHED __builtin_amdgcn_sched_barrier(0)
#define PG8_AOFF(dst, u) do { _Pragma("unroll") for (int _h = 0; _h < 2; ++_h) _Pragma("unroll") for (int _i = 0; _i < 2; ++_i) { int _R, _C; stage_rc(tid * 16 + _i * 8192, _R, _C); \
        dst[_h][_i] = (S.arow(u, _h * HALF + _R) * (unsigned)K + (unsigned)_C) * 2u; } } while (0)
    Unit cur, nxt; int ui = 0;
    if (!S.next(0, cur)) return;
    f32x4 acc[2][2][4][2];
#pragma unroll
    for (int a = 0; a < 2; ++a)
#pragma unroll
        for (int b = 0; b < 2; ++b)
#pragma unroll
            for (int m = 0; m < 4; ++m)
#pragma unroll
                for (int n = 0; n < 2; ++n) acc[a][b][m][n] = (f32x4){0.f, 0.f, 0.f, 0.f};
    bf16x8 At[4][2], B0[2][2], B1[2][2];
    unsigned curA[2][2];
    const char* cA = gA;
    if constexpr (GATHER) { PG8_AOFF(curA, cur); }
    else { cA = gA + (size_t)S.arow(cur, 0) * K * 2; }
#define PG8_STA(bufoff, ptr, h) do { if constexpr (GATHER) { PG8_STAGE(bufoff, ptr, curA[h]); } else { PG8_STAGE(bufoff, (ptr) + (h) * hstep, voffA); } } while (0)
    const char* cB = S.bbase(cur);
    PG8_STAGE(PG8_SB(0, 0), cB, voffB); PG8_STAGE(PG8_SB(0, 1), cB + hstep, voffB); PG8_STA(PG8_SA(0, 0), cA, 0); PG8_STA(PG8_SA(0, 1), cA, 1);
    if (wr == 1) PG8_BAR;
    PG8_WAIT_V(2); PG8_BAR;
    PG8_STAGE(PG8_SB(1, 0), cB + kstep, voffB); PG8_STA(PG8_SA(1, 0), cA + kstep, 0); PG8_STAGE(PG8_SB(1, 1), cB + hstep + kstep, voffB);
    PG8_WAIT_V(6); PG8_BAR;
    for (;;) {
        const bool has_next = S.next(ui + 1, nxt);
        const char* nB = cB; const char* nA = cA;
        if (has_next) { nB = S.bbase(nxt);
            if constexpr (GATHER) { unsigned na[2][2]; PG8_AOFF(na, nxt); *stash = (u32x4){na[0][0], na[0][1], na[1][0], na[1][1]}; }
            else nA = gA + (size_t)S.arow(nxt, 0) * K * 2; }
        for (int t = 0; t < nt; t += 2) {
            const bool last = (t == nt - 2);
            const char* a1 = cA + (size_t)(t + 1) * kstep;
            const char* a2 = last ? nA : cA + (size_t)(t + 2) * kstep; const char* b2 = last ? nB : cB + (size_t)(t + 2) * kstep;
            const char* a3 = a2 + kstep; const char* b3 = b2 + kstep;
            PG8_LDB(B0, 0, 0); PG8_LDB(B1, 0, 1); PG8_SCHED; PG8_LDA(At, 0, 0); PG8_STA(PG8_SA(1, 1), a1, 1);
            if constexpr (GATHER) { if (last && has_next) { const u32x4 na = *stash; curA[0][0] = na.x; curA[0][1] = na.y; curA[1][0] = na.z; curA[1][1] = na.w; } }
            PG8_WAIT_V(8); PG8_WAIT_L(0); PG8_BAR; PG8_MMA(0, 0, At, B0); PG8_MMA(0, 1, At, B1); PG8_BAR; PG8_SCHED;
            PG8_LDA(At, 0, 1); PG8_STAGE(PG8_SB(0, 0), b2, voffB); PG8_STAGE(PG8_SB(0, 1), b2 + hstep, voffB); PG8_STA(PG8_SA(0, 0), a2, 0);
            PG8_WAIT_V(8); PG8_WAIT_L(0); PG8_BAR; PG8_MMA(1, 0, At, B0); PG8_MMA(1, 1, At, B1); PG8_BAR; PG8_SCHED;
            PG8_LDB(B0, 1, 0); PG8_LDB(B1, 1, 1); PG8_SCHED; PG8_LDA(At, 1, 0); PG8_STA(PG8_SA(0, 1), a2, 1);
            PG8_WAIT_V(8); PG8_WAIT_L(0); PG8_BAR; PG8_MMA(0, 0, At, B0); PG8_MMA(0, 1, At, B1); PG8_BAR; PG8_SCHED;
            PG8_LDA(At, 1, 1); PG8_STAGE(PG8_SB(1, 0), b3, voffB); PG8_STAGE(PG8_SB(1, 1), b3 + hstep, voffB); PG8_STA(PG8_SA(1, 0), a3, 0);
            PG8_WAIT_V(8); PG8_WAIT_L(0); PG8_BAR; PG8_MMA(1, 0, At, B0); PG8_MMA(1, 1, At, B1); PG8_BAR; PG8_SCHED;
        }
        if constexpr (ALIGN_EPI) { if (wr == 0) PG8_BAR; }
        E(acc, cur, wr, wc, fr, fq);
        if (!has_next) break;
#pragma unroll
        for (int a = 0; a < 2; ++a)
#pragma unroll
            for (int b = 0; b < 2; ++b)
#pragma unroll
                for (int m = 0; m < 4; ++m)
#pragma unroll
                    for (int n = 0; n < 2; ++n) acc[a][b][m][n] = (f32x4){0.f, 0.f, 0.f, 0.f};
        cur = nxt; cB = nB; cA = nA; ++ui;
        if constexpr (ALIGN_EPI) { if (wr == 1) PG8_BAR; }
    }
    PG8_WAIT_V(0);
    if constexpr (!ALIGN_EPI) { if (wr == 0) PG8_BAR; }
    PG8_BAR;
#undef PG8_SA
#undef PG8_SB
#undef PG8_STAGE
#undef PG8_LDA
#undef PG8_LDB
#undef PG8_MMA
#undef PG8_WAIT_V
#undef PG8_WAIT_L
#undef PG8_BAR
#undef PG8_SCHED
#undef PG8_AOFF
#undef PG8_STA
}

struct EpiIn {
    static constexpr bool PERM = false;
    bf16* proj; bf16* sg; float* la; float* ffl; const float* a_b; const float* fb;
    __device__ __forceinline__ void operator()(const f32x4 (&acc)[2][2][4][2], const Unit& u, int wr, int wc, int fr, int fq) const {
        const int pn = u.pn, rowb = u.pm * BM + wr * 64 + fr, cl0 = wc * 32 + 4 * fq;
        if (pn < 9) {
            bf16* base = proj + (size_t)pn * S * 256; const float sc = (pn == 0 || pn == 3) ? C2 : 1.f;
#pragma unroll
            for (int ai = 0; ai < 2; ++ai)
#pragma unroll
                for (int m = 0; m < 4; ++m) { bf16* rowp = base + (size_t)(rowb + ai * HALF + m * 16) * 256 + cl0;
#pragma unroll
                    for (int bj = 0; bj < 2; ++bj)
#pragma unroll
                        for (int n = 0; n < 2; ++n) { const f32x4 v = acc[ai][bj][m][n] * sc; u32x2 w; w.x = cvt_pk_bf16(v[0], v[1]); w.y = cvt_pk_bf16(v[2], v[3]); *(u32x2*)(rowp + bj * HALF + n * 16) = w; } }
        } else if (pn < 21) {
            bf16* base = sg + (size_t)(pn - 9) * 256;
#pragma unroll
            for (int ai = 0; ai < 2; ++ai)
#pragma unroll
                for (int m = 0; m < 4; ++m) { bf16* rowp = base + (size_t)(rowb + ai * HALF + m * 16) * 3072 + cl0;
#pragma unroll
                    for (int bj = 0; bj < 2; ++bj)
#pragma unroll
                        for (int n = 0; n < 2; ++n) { const f32x4 v = acc[ai][bj][m][n]; u32x2 w; w.x = cvt_pk_bf16(sigmoidf_(v[0]), sigmoidf_(v[1])); w.y = cvt_pk_bf16(sigmoidf_(v[2]), sigmoidf_(v[3])); *(u32x2*)(rowp + bj * HALF + n * 16) = w; } }
        } else {
#pragma unroll
            for (int n = 0; n < 2; ++n) { const f32x4 bv = *(const f32x4*)(a_b + cl0 + n * 16);
#pragma unroll
                for (int ai = 0; ai < 2; ++ai)
#pragma unroll
                    for (int m = 0; m < 4; ++m) { const f32x4 v = acc[ai][0][m][n] + bv; f32x4 o;
                        o[0] = logsigmoidf_(v[0]) * 0.0625f; o[1] = logsigmoidf_(v[1]) * 0.0625f; o[2] = logsigmoidf_(v[2]) * 0.0625f; o[3] = logsigmoidf_(v[3]) * 0.0625f;
                        *(f32x4*)(la + (size_t)(rowb + ai * HALF + m * 16) * 128 + cl0 + n * 16) = o; } }
            if (wc == 0 && fq == 0) { const f32x4 bv = *(const f32x4*)fb;
#pragma unroll
                for (int ai = 0; ai < 2; ++ai)
#pragma unroll
                    for (int m = 0; m < 4; ++m) { const f32x4 v = acc[ai][1][m][0] + bv; f32x4 o;
                        o[0] = logsigmoidf_(v[0]); o[1] = logsigmoidf_(v[1]); o[2] = logsigmoidf_(v[2]); o[3] = logsigmoidf_(v[3]);
                        *(f32x4*)(ffl + (size_t)(rowb + ai * HALF + m * 16) * 4) = o; } }
        }
    }
};
struct EpiLift {
    static constexpr bool PERM = false;
    const bf16* sg; float* T; float* T2; bf16* mrg; int nb;
    __device__ __forceinline__ void operator()(const f32x4 (&acc)[2][2][4][2], const Unit& u, int wr, int wc, int fr, int fq) const {
        const int rowb = u.pm * BM + wr * 64 + fr, col0 = u.pn * BM + wc * 32 + 4 * fq;
#pragma unroll
        for (int ai = 0; ai < 2; ++ai)
#pragma unroll
            for (int m = 0; m < 4; ++m) { const size_t row = (size_t)(rowb + ai * HALF + m * 16);
#pragma unroll
                for (int bj = 0; bj < 2; ++bj)
#pragma unroll
                    for (int n = 0; n < 2; ++n) { const int c = col0 + bj * HALF + n * 16;
                        const u32x2 gw = *(const u32x2*)(sg + row * 3072 + nb * 1024 + c);
                        f32x4 g; g[0] = bf_lo(gw.x); g[1] = bf_hi(gw.x); g[2] = bf_lo(gw.y); g[3] = bf_hi(gw.y);
                        f32x4 v = acc[ai][bj][m][n] * g;
                        if (nb == 2) v += *(const f32x4*)(T + row * 1024 + c) + *(const f32x4*)(T2 + row * 1024 + c);
                        if (nb == 0) *(f32x4*)(T + row * 1024 + c) = v;
                        else if (nb == 1) *(f32x4*)(T2 + row * 1024 + c) = v;
                        else { u32x2 w; w.x = cvt_pk_bf16(v[0], v[1]); w.y = cvt_pk_bf16(v[2], v[3]); *(u32x2*)(mrg + row * 1024 + c) = w; } } }
    }
};
struct EpiF32G {
    static constexpr bool PERM = false;
    float* C; const bf16* sg; int nb;
    __device__ __forceinline__ void operator()(const f32x4 (&acc)[2][2][4][2], const Unit& u, int wr, int wc, int fr, int fq) const {
        const int rowb = u.pm * BM + wr * 64 + fr, col0 = u.pn * BM + wc * 32 + 4 * fq;
#pragma unroll
        for (int ai = 0; ai < 2; ++ai)
#pragma unroll
            for (int m = 0; m < 4; ++m) { const size_t row = (size_t)(rowb + ai * HALF + m * 16);
#pragma unroll
                for (int bj = 0; bj < 2; ++bj)
#pragma unroll
                    for (int n = 0; n < 2; ++n) { const int c = col0 + bj * HALF + n * 16;
                        const u32x2 gw = *(const u32x2*)(sg + row * 3072 + nb * 1024 + c);
                        f32x4 g; g[0] = bf_lo(gw.x); g[1] = bf_hi(gw.x); g[2] = bf_lo(gw.y); g[3] = bf_hi(gw.y);
                        *(f32x4*)(C + row * 1024 + c) = acc[ai][bj][m][n] * g; } }
    }
};
struct EpiF32 {
    static constexpr bool PERM = false;
    float* C;
    __device__ __forceinline__ void operator()(const f32x4 (&acc)[2][2][4][2], const Unit& u, int wr, int wc, int fr, int fq) const {
        const int rowb = u.pm * BM + wr * 64 + fr, col0 = u.pn * BM + wc * 32 + 4 * fq;
#pragma unroll
        for (int ai = 0; ai < 2; ++ai)
#pragma unroll
            for (int m = 0; m < 4; ++m) { float* rowp = C + (size_t)(rowb + ai * HALF + m * 16) * 1024 + col0;
#pragma unroll
                for (int bj = 0; bj < 2; ++bj)
#pragma unroll
                    for (int n = 0; n < 2; ++n) *(f32x4*)(rowp + bj * HALF + n * 16) = acc[ai][bj][m][n]; }
    }
};
struct EpiMoe1 {
    static constexpr bool PERM = false;
    bf16* act; const float* b_gu;
    __device__ __forceinline__ void operator()(const f32x4 (&acc)[2][2][4][2], const Unit& u, int wr, int wc, int fr, int fq) const {
        const int rowb = u.pm * BM + wr * 64 + fr; const float* bb = b_gu + (size_t)u.e * 2048;
#pragma unroll
        for (int n = 0; n < 2; ++n) { const int j = u.pn * HALF + wc * 32 + n * 16 + 4 * fq;
            const f32x4 b0 = *(const f32x4*)(bb + 2 * j), b1 = *(const f32x4*)(bb + 2 * j + 4);
            const f32x4 bg = (f32x4){b0[0], b0[2], b1[0], b1[2]}, bu = (f32x4){b0[1], b0[3], b1[1], b1[3]};
#pragma unroll
            for (int ai = 0; ai < 2; ++ai)
#pragma unroll
                for (int m = 0; m < 4; ++m) { const f32x4 hg = acc[ai][0][m][n] + bg, hu = acc[ai][1][m][n] + bu; float o[4];
#pragma unroll
                    for (int i = 0; i < 4; ++i) { const float g = fminf(hg[i], 7.f), uu = fminf(fmaxf(hu[i], -7.f), 7.f); o[i] = (uu + 1.f) * (g * sigmoidf_(1.702f * g)); }
                    u32x2 w; w.x = cvt_pk_bf16(o[0], o[1]); w.y = cvt_pk_bf16(o[2], o[3]);
                    *(u32x2*)(act + (size_t)(rowb + ai * HALF + m * 16) * 1024 + j) = w; } }
    }
};
struct EpiMoe2 {
    static constexpr bool PERM = false;
    bf16* yb; const float* b_dn;
    __device__ __forceinline__ void operator()(const f32x4 (&acc)[2][2][4][2], const Unit& u, int wr, int wc, int fr, int fq) const {
        const int rowb = u.pm * BM + wr * 64 + fr, col0 = u.pn * BM + wc * 32 + 4 * fq; const float* bb = b_dn + (size_t)u.e * 1024;
#pragma unroll
        for (int bj = 0; bj < 2; ++bj)
#pragma unroll
            for (int n = 0; n < 2; ++n) { const int c = col0 + bj * HALF + n * 16; const f32x4 bv = *(const f32x4*)(bb + c);
#pragma unroll
                for (int ai = 0; ai < 2; ++ai)
#pragma unroll
                    for (int m = 0; m < 4; ++m) { const f32x4 v = acc[ai][bj][m][n] + bv; u32x2 w; w.x = cvt_pk_bf16(v[0], v[1]); w.y = cvt_pk_bf16(v[2], v[3]);
                        *(u32x2*)(yb + (size_t)(rowb + ai * HALF + m * 16) * 1024 + c) = w; } }
    }
};
}

#define XB_TMO      128
#define XB_XCNT(j)  (256  + 64 * (j))
#define XB_XSUB(j)  (1280 + 64 * (j))
#define XB_XGEN(j)  (2304 + 64 * (j))
#define XB_TOP      3328
#define XB_TOPGEN   3392
#define XCD_BAR_WORDS 3456
#define XB_SPIN_CAP (1u << 22)
__device__ __forceinline__ unsigned xb_ld(unsigned* p)              { return __hip_atomic_load(p, __ATOMIC_RELAXED, __HIP_MEMORY_SCOPE_AGENT); }
__device__ __forceinline__ unsigned xb_add(unsigned* p, unsigned v) { return __hip_atomic_fetch_add(p, v, __ATOMIC_RELAXED, __HIP_MEMORY_SCOPE_AGENT); }
__device__ __forceinline__ unsigned xb_xcc_id() { return (unsigned)__builtin_amdgcn_s_getreg((3 << 11) | 20) & 0xFu; }
#define XB_SPIN(cond, bar) do { unsigned _sp = 0; while (cond) { __builtin_amdgcn_s_sleep(1); \
    if ((++_sp & 255u) == 0u) { if (xb_ld(&(bar)[XB_TMO])) break; if (_sp > XB_SPIN_CAP) { atomicAdd(&(bar)[XB_TMO], 1u); break; } } } } while (0)
struct XcdBarrier { unsigned* bar; unsigned x; volatile LAS unsigned* st; };
__device__ __forceinline__ XcdBarrier xcd_barrier_post(unsigned* bar, volatile LAS unsigned* st) {
    XcdBarrier b; b.bar = bar; b.x = xb_xcc_id(); b.st = st;
    if (threadIdx.x == 0) (void)xb_add(&bar[XB_XCNT(b.x)], 1u);
    return b;
}
__device__ __forceinline__ void xcd_barrier_complete(unsigned* bar, unsigned x, unsigned& nloc, unsigned& nx) {
    const unsigned G = gridDim.x * gridDim.y * gridDim.z;
    unsigned sum, cnt, mine, sp = 0u;
    for (;;) {
        sum = 0u; cnt = 0u; mine = 0u;
#pragma unroll
        for (unsigned j = 0; j < 16; ++j) { const unsigned c = xb_ld(&bar[XB_XCNT(j)]); sum += c; cnt += (c > 0u) ? 1u : 0u; mine = (j == x) ? c : mine; }
        if (sum == G) break;
        __builtin_amdgcn_s_sleep(1);
        if ((++sp & 255u) == 0u) { if (xb_ld(&bar[XB_TMO])) break; if (sp > XB_SPIN_CAP) { atomicAdd(&bar[XB_TMO], 1u); break; } }
    }
    nloc = mine > 0u ? mine : 1u; nx = cnt > 0u ? cnt : 1u;
}
__device__ __forceinline__ void xcd_barrier(const XcdBarrier& b) {
    asm volatile("s_waitcnt vmcnt(0)" ::: "memory");
    __syncthreads();
    if (threadIdx.x == 0) {
        unsigned* bar = b.bar;
        __builtin_amdgcn_s_waitcnt(0);
        unsigned nloc = b.st[0], nx = b.st[1];
        if (nloc == 0u) { xcd_barrier_complete(bar, b.x, nloc, nx); b.st[0] = nloc; b.st[1] = nx; }
        const unsigned old = xb_add(&bar[XB_XSUB(b.x)], 1u);
        const unsigned gen = old / nloc;
        if (old + 1u == (gen + 1u) * nloc) {
            __builtin_amdgcn_fence(__ATOMIC_RELEASE, "agent");
            asm volatile("s_waitcnt vmcnt(0)" ::: "memory");
            const unsigned og = xb_add(&bar[XB_TOP], 1u);
            const unsigned tg = og / nx;
            if (og + 1u == (tg + 1u) * nx) xb_add(&bar[XB_TOPGEN], 1u);
            else XB_SPIN(xb_ld(&bar[XB_TOPGEN]) == tg, bar);
            __builtin_amdgcn_fence(__ATOMIC_ACQUIRE, "agent");
            xb_add(&bar[XB_XGEN(b.x)], 1u);
            asm volatile("s_waitcnt vmcnt(0)" ::: "memory");
        } else {
            XB_SPIN(xb_ld(&bar[XB_XGEN(b.x)]) == gen, bar);
            __builtin_amdgcn_fence(__ATOMIC_ACQUIRE, "agent");
            asm volatile("s_waitcnt vmcnt(0)" ::: "memory");
        }
    }
    __syncthreads();
}

struct MapIdent { __device__ __forceinline__ int operator()(int c) const { return c; } };
struct MapGU { __device__ __forceinline__ int operator()(int c) const { const int j = c >> 1, up = c & 1; return ((j >> 7) << 8) + (up << 7) + (j & 127); } };
struct MapIn { __device__ __forceinline__ int operator()(int c) const {
    if (c < 768) return c;
    if (c < 772) return 5504 + (c - 768);
    if (c < 1028) return 1536 + (c - 772);
    if (c < 1284) return 1792 + (c - 1028);
    if (c < 1300) return -1;
    if (c < 1556) return 2048 + (c - 1300);
    if (c < 2324) return 768 + (c - 1556);
    return 2304 + (c - 2324);
} };
template <class RowMap>
__device__ __forceinline__ void transpose_item(const float* W, int K, int N, bf16* WT, LAS float* scr, int item, int lane, RowMap rm, int ldk = 0) {
    if (ldk == 0) ldk = K;
    const int nblk = (N + 31) / 32, kb = item / nblk, nb = item % nblk, k0 = 64 * kb, n0 = 32 * nb;
    const int nn = n0 + (lane & 31);
#pragma unroll 16
    for (int i = 0; i < 32; ++i) { const int kk = 2 * i + (lane >> 5); scr[kk * 33 + (lane & 31)] = nn < N ? W[(size_t)(k0 + kk) * N + nn] : 0.f; }
    asm volatile("s_waitcnt lgkmcnt(0)" ::: "memory");
    const int c = lane & 7;
#pragma unroll
    for (int j = 0; j < 4; ++j) { const int n = (lane >> 3) + 8 * j; const LAS float* s = scr + (8 * c) * 33 + n;
        const int row = (n0 + n < N) ? rm(n0 + n) : -1;
        if (row >= 0) { u32x4 o; o.x = cvt_pk_bf16(s[0 * 33], s[1 * 33]); o.y = cvt_pk_bf16(s[2 * 33], s[3 * 33]); o.z = cvt_pk_bf16(s[4 * 33], s[5 * 33]); o.w = cvt_pk_bf16(s[6 * 33], s[7 * 33]);
            *(u32x4*)(WT + (size_t)row * ldk + k0 + 8 * c) = o; } }
    asm volatile("s_waitcnt lgkmcnt(0)" ::: "memory");
}

struct Args { const float* in[18]; float* out; unsigned char* ws; int ph_lo, ph_hi; };

#define CAS __attribute__((address_space(4)))
#define KARG_IN(kp, i) (*(const float* const CAS*)((kp) + 8 * (i)))
#define KARG_OUT(kp) (*(float* const CAS*)((kp) + 144))
#define KARG_WS(kp) (*(unsigned char* const CAS*)((kp) + 152))
__device__ __forceinline__ void p0_prologue(const CAS unsigned char* kp, LAS unsigned char* lds, int vcu, int G, int tid) {
    const int lane = tid & 63, wave = tid >> 6;
    LAS float* scr = (LAS float*)(lds + wave * 16384);
    unsigned char* ws = KARG_WS(kp);
    const int gw = vcu * 8 + wave, NGW = G * 8;
    constexpr int I_IN = 16 * 169, I_BR = 4 * 32, I_OUT = 16 * 32, I_GU = 16 * 64, I_DN = 16 * 32;
    constexpr int PER_L = I_IN + 3 * I_BR + I_OUT + 32 * I_GU + 32 * I_DN;
    for (int it = gw; it < DEPTH * PER_L; it += NGW) {
        const int l = it / PER_L; int r = it % PER_L;
        if (r < I_IN) { transpose_item(KARG_IN(kp, 1) + (size_t)l * 1024 * D_IN, 1024, D_IN, (bf16*)(ws + WS_WIN) + (size_t)l * NIN * 1024, scr, r, lane, MapIn()); continue; } r -= I_IN;
        if (r < 3 * I_BR) { const int nb = r / I_BR; transpose_item(KARG_IN(kp, 6) + ((size_t)l * 3 + nb) * 256 * 1024, 256, 1024, (bf16*)(ws + WS_WBP) + ((size_t)l * 3 + nb) * 1024 * 768 + nb * 256, scr, r % I_BR, lane, MapIdent(), 768); continue; } r -= 3 * I_BR;
        if (r < I_OUT) { transpose_item(KARG_IN(kp, 7) + (size_t)l * 1024 * 1024, 1024, 1024, (bf16*)(ws + WS_WOUT) + (size_t)l * 1024 * 1024, scr, r, lane, MapIdent()); continue; } r -= I_OUT;
        if (r < 32 * I_GU) { const int e = r / I_GU; transpose_item(KARG_IN(kp, 12) + ((size_t)l * 32 + e) * 1024 * 2048, 1024, 2048, (bf16*)(ws + WS_WGU) + ((size_t)l * 32 + e) * 2048 * 1024, scr, r % I_GU, lane, MapGU()); continue; } r -= 32 * I_GU;
        { const int e = r / I_DN; transpose_item(KARG_IN(kp, 14) + ((size_t)l * 32 + e) * 1024 * 1024, 1024, 1024, (bf16*)(ws + WS_WDN) + ((size_t)l * 32 + e) * 1024 * 1024, scr, r % I_DN, lane, MapIdent()); }
    }
    const int gt = vcu * 512 + tid, NT = G * 512;
    for (int i = gt; i < DEPTH * 128 * 1024; i += NT) { const int l = i >> 17, j = (i >> 10) & 127, k = i & 1023;
        const float* wr_ = KARG_IN(kp, 1) + ((size_t)l * 1024 + k) * D_IN + 1284; const float* au = KARG_IN(kp, 3) + (size_t)l * 16 * 128 + j; float s = 0.f;
#pragma unroll
        for (int r = 0; r < 16; ++r) s += wr_[r] * au[r * 128];
        ((bf16*)(ws + WS_WIN))[((size_t)l * NIN + 5376 + j) * 1024 + k] = (bf16)(cvt_pk_bf16(s, 0.f) & 0xffffu); }
    for (int i = gt; i < DEPTH * 124 * 1024 / 8; i += NT) { const int l = i / (124 * 128), rr = i % (124 * 128);
        *(u32x4*)((bf16*)(ws + WS_WIN) + ((size_t)l * NIN + 5508) * 1024 + (size_t)rr * 8) = (u32x4){0u, 0u, 0u, 0u}; }
    for (int i = gt; i < DEPTH * 3 * 1024 * 2 * 32; i += NT) { const int ch = i & 31, kbsel = (i >> 5) & 1, d = (i >> 6) & 1023, lnb = i >> 16; const int nb = lnb % 3; const int kb = kbsel + (kbsel >= nb ? 1 : 0);
        *(u32x4*)((bf16*)(ws + WS_WBP) + ((size_t)lnb * 1024 + d) * 768 + kb * 256 + ch * 8) = (u32x4){0u, 0u, 0u, 0u}; }
    for (int i = gt; i < S * D / 8; i += NT) { const f32x4 v0 = *(const f32x4*)(KARG_IN(kp, 0) + (size_t)i * 8), v1 = *(const f32x4*)(KARG_IN(kp, 0) + (size_t)i * 8 + 4);
        u32x4 o; o.x = cvt_pk_bf16(v0[0], v0[1]); o.y = cvt_pk_bf16(v0[2], v0[3]); o.z = cvt_pk_bf16(v1[0], v1[1]); o.w = cvt_pk_bf16(v1[2], v1[3]);
        *(u32x4*)((bf16*)(ws + WS_XB) + (size_t)i * 8) = o; }
}

__device__ __forceinline__ void gla_local_unit(LAS unsigned char* lds, int tid, int ci, int h, const bf16* GQK, const bf16* GV, const float* LAp, float* U, float* DEC) {
    LAS float* kb = (LAS float*)lds;
    LAS float* vb = kb + 64 * 33;
    LAS float* bb = vb + 64 * 64;
    const int t0 = ci * 64; const int r = tid >> 3;
    { const int c4 = (tid & 7) * 4; const u32x2 w = *(const u32x2*)(GQK + (size_t)(t0 + r) * 256 + 128 + h * 32 + c4);
      kb[r * 33 + c4 + 0] = bf_lo(w.x); kb[r * 33 + c4 + 1] = bf_hi(w.x); kb[r * 33 + c4 + 2] = bf_lo(w.y); kb[r * 33 + c4 + 3] = bf_hi(w.y);
      const f32x4 a = *(const f32x4*)(LAp + (size_t)(t0 + r) * 128 + h * 32 + c4); *(LAS f32x4*)(bb + r * 32 + c4) = a; }
    { const int c8 = (tid & 7) * 8; const u32x4 w = *(const u32x4*)(GV + (size_t)(t0 + r) * 256 + h * 64 + c8);
      *(LAS f32x4*)(vb + r * 64 + c8) = (f32x4){bf_lo(w.x), bf_hi(w.x), bf_lo(w.y), bf_hi(w.y)}; *(LAS f32x4*)(vb + r * 64 + c8 + 4) = (f32x4){bf_lo(w.z), bf_hi(w.z), bf_lo(w.w), bf_hi(w.w)}; }
    __syncthreads();
    if (tid < 32) { float run = 0.f; for (int c = 0; c < 64; ++c) { run += bb[c * 32 + tid]; bb[c * 32 + tid] = run; } }
    __syncthreads();
    for (int idx = tid; idx < 2048; idx += 512) { const int c = idx >> 5, k = idx & 31; kb[c * 33 + k] *= __expf(bb[63 * 32 + k] - bb[c * 32 + k]); }
    __syncthreads();
    { const int k = tid >> 4, v0 = (tid & 15) * 4; f32x4 acc = (f32x4){0.f, 0.f, 0.f, 0.f};
#pragma unroll 8
      for (int c = 0; c < 64; ++c) { const float kk = kb[c * 33 + k]; const f32x4 vv = *(const LAS f32x4*)(vb + c * 64 + v0); acc += vv * kk; }
      *(f32x4*)(U + ((size_t)(ci * 4 + h) * 32 + k) * 64 + v0) = acc; }
    if (tid < 32) DEC[(ci * 4 + h) * 32 + tid] = __expf(bb[63 * 32 + tid]);
    __syncthreads();
}
__device__ __forceinline__ void gla_out_unit(LAS unsigned char* lds, int tid, int ci, int h, const bf16* GQK, const bf16* GV, const bf16* GR, const float* LAp, const float* SST, const float* ng, bf16* Y) {
    LAS float* qb = (LAS float*)lds;
    LAS float* kb = qb + 64 * 33;
    LAS float* vb = kb + 64 * 33;
    LAS float* bb = vb + 64 * 64;
    LAS float* Ab = bb + 64 * 32;
    LAS float* Sb = Ab + 64 * 65;
    const int t0 = ci * 64; const int r = tid >> 3;
    { const int c4 = (tid & 7) * 4; const u32x2 wq = *(const u32x2*)(GQK + (size_t)(t0 + r) * 256 + h * 32 + c4); const u32x2 wk = *(const u32x2*)(GQK + (size_t)(t0 + r) * 256 + 128 + h * 32 + c4);
      qb[r * 33 + c4 + 0] = bf_lo(wq.x); qb[r * 33 + c4 + 1] = bf_hi(wq.x); qb[r * 33 + c4 + 2] = bf_lo(wq.y); qb[r * 33 + c4 + 3] = bf_hi(wq.y);
      kb[r * 33 + c4 + 0] = bf_lo(wk.x); kb[r * 33 + c4 + 1] = bf_hi(wk.x); kb[r * 33 + c4 + 2] = bf_lo(wk.y); kb[r * 33 + c4 + 3] = bf_hi(wk.y);
      const f32x4 a = *(const f32x4*)(LAp + (size_t)(t0 + r) * 128 + h * 32 + c4); *(LAS f32x4*)(bb + r * 32 + c4) = a; }
    { const int c8 = (tid & 7) * 8; const u32x4 w = *(const u32x4*)(GV + (size_t)(t0 + r) * 256 + h * 64 + c8);
      *(LAS f32x4*)(vb + r * 64 + c8) = (f32x4){bf_lo(w.x), bf_hi(w.x), bf_lo(w.y), bf_hi(w.y)}; *(LAS f32x4*)(vb + r * 64 + c8 + 4) = (f32x4){bf_lo(w.z), bf_hi(w.z), bf_lo(w.w), bf_hi(w.w)}; }
    { const f32x4 s4 = *(const f32x4*)(SST + (size_t)(ci * 4 + h) * 2048 + tid * 4); *(LAS f32x4*)(Sb + tid * 4) = s4; }
    __syncthreads();
    if (tid < 32) { float run = 0.f; for (int c = 0; c < 64; ++c) { run += bb[c * 32 + tid]; bb[c * 32 + tid] = run; } }
    __syncthreads();
    for (int idx = tid; idx < 2048; idx += 512) { const int c = idx >> 5, k = idx & 31; const float b = bb[c * 32 + k];
        qb[c * 33 + k] *= 0.17677669529663687f * __expf(b); kb[c * 33 + k] *= __expf(-b); }
    __syncthreads();
    { const int t = tid >> 3, s0 = (tid & 7) * 8; float a[8];
#pragma unroll
      for (int i = 0; i < 8; ++i) a[i] = 0.f;
      for (int k = 0; k < 32; ++k) { const float qv = qb[t * 33 + k];
#pragma unroll
          for (int i = 0; i < 8; ++i) a[i] += qv * kb[(s0 + i) * 33 + k]; }
#pragma unroll
      for (int i = 0; i < 8; ++i) Ab[t * 65 + s0 + i] = (s0 + i <= t) ? a[i] : 0.f; }
    __syncthreads();
    { const int t = tid >> 3, v0 = (tid & 7) * 8; f32x4 o0 = (f32x4){0.f, 0.f, 0.f, 0.f}, o1 = o0;
      for (int s = 0; s < 64; ++s) { const float av = Ab[t * 65 + s]; o0 += *(const LAS f32x4*)(vb + s * 64 + v0) * av; o1 += *(const LAS f32x4*)(vb + s * 64 + v0 + 4) * av; }
      for (int k = 0; k < 32; ++k) { const float qv = qb[t * 33 + k]; o0 += *(const LAS f32x4*)(Sb + k * 64 + v0) * qv; o1 += *(const LAS f32x4*)(Sb + k * 64 + v0 + 4) * qv; }
      float ss = o0[0] * o0[0] + o0[1] * o0[1] + o0[2] * o0[2] + o0[3] * o0[3] + o1[0] * o1[0] + o1[1] * o1[1] + o1[2] * o1[2] + o1[3] * o1[3];
      ss += __shfl_xor(ss, 1); ss += __shfl_xor(ss, 2); ss += __shfl_xor(ss, 4);
      const float rinv = 1.0f / sqrtf(ss * (1.f / 64.f) + RMS_EPS);
      const size_t tok = (size_t)(t0 + t); const u32x4 gw = *(const u32x4*)(GR + tok * 256 + h * 64 + v0);
      const f32x4 g0 = *(const f32x4*)(ng + h * 64 + v0), g1 = *(const f32x4*)(ng + h * 64 + v0 + 4);
      float gr[8] = {bf_lo(gw.x), bf_hi(gw.x), bf_lo(gw.y), bf_hi(gw.y), bf_lo(gw.z), bf_hi(gw.z), bf_lo(gw.w), bf_hi(gw.w)}; float y[8];
#pragma unroll
      for (int i = 0; i < 4; ++i) { y[i] = o0[i] * rinv * g0[i] * (gr[i] * sigmoidf_(gr[i])); y[4 + i] = o1[i] * rinv * g1[i] * (gr[4 + i] * sigmoidf_(gr[4 + i])); }
      u32x4 w; w.x = cvt_pk_bf16(y[0], y[1]); w.y = cvt_pk_bf16(y[2], y[3]); w.z = cvt_pk_bf16(y[4], y[5]); w.w = cvt_pk_bf16(y[6], y[7]);
      *(u32x4*)(Y + tok * 768 + h * 64 + v0) = w; }
    __syncthreads();
}

__device__ __forceinline__ void soft_update(float& m, float& l, float (&o)[16], float s, bool valid, const float (&v)[16]) {
    if (valid && s > m) { const float corr = fast_exp2(m - s); l *= corr;
#pragma unroll
        for (int d = 0; d < 16; ++d) o[d] *= corr;
        m = s; }
    const float p = valid ? fast_exp2(s - m) : 0.f; l += p;
#pragma unroll
    for (int d = 0; d < 16; ++d) o[d] += p * v[d];
}
__device__ __forceinline__ void load16(const bf16* p, float (&v)[16]) {
    const u32x4 a = *(const u32x4*)p, b = *(const u32x4*)(p + 8);
    v[0] = bf_lo(a.x); v[1] = bf_hi(a.x); v[2] = bf_lo(a.y); v[3] = bf_hi(a.y); v[4] = bf_lo(a.z); v[5] = bf_hi(a.z); v[6] = bf_lo(a.w); v[7] = bf_hi(a.w);
    v[8] = bf_lo(b.x); v[9] = bf_hi(b.x); v[10] = bf_lo(b.y); v[11] = bf_hi(b.y); v[12] = bf_lo(b.z); v[13] = bf_hi(b.z); v[14] = bf_lo(b.w); v[15] = bf_hi(b.w);
}
__device__ __forceinline__ void store16(bf16* p, const float (&o)[16], float sc) {
    u32x4 a, b; a.x = cvt_pk_bf16(o[0] * sc, o[1] * sc); a.y = cvt_pk_bf16(o[2] * sc, o[3] * sc); a.z = cvt_pk_bf16(o[4] * sc, o[5] * sc); a.w = cvt_pk_bf16(o[6] * sc, o[7] * sc);
    b.x = cvt_pk_bf16(o[8] * sc, o[9] * sc); b.y = cvt_pk_bf16(o[10] * sc, o[11] * sc); b.z = cvt_pk_bf16(o[12] * sc, o[13] * sc); b.w = cvt_pk_bf16(o[14] * sc, o[15] * sc);
    *(u32x4*)p = a; *(u32x4*)(p + 8) = b;
}
__device__ __forceinline__ void fox_naive_unit(LAS unsigned char* lds, int tid, int h, int qb, const bf16* FQ, const bf16* FK, const bf16* FV, const float* CF, bf16* Y) {
    LAS float* Ks = (LAS float*)lds;
    LAS float* Vs = Ks + 4096;
    LAS float* cks = Vs + 4096;
    const int ql = tid >> 2, part = tid & 3, t = qb * 128 + ql;
    float q[16], o[16], m = -INFINITY, l = 0.f;
    load16(FQ + (size_t)t * 256 + h * 64 + part * 16, q);
#pragma unroll
    for (int d = 0; d < 16; ++d) o[d] = 0.f;
    const float cq = CF[(size_t)h * S + t];
    const int NT = (qb * 128 + 128) / 64;
    for (int kt = 0; kt < NT; ++kt) {
        __syncthreads();
        { const int r = tid >> 3, c8 = (tid & 7) * 8; const size_t off = (size_t)(kt * 64 + r) * 256 + h * 64 + c8;
          const u32x4 wk = *(const u32x4*)(FK + off), wv = *(const u32x4*)(FV + off);
          *(LAS f32x4*)(Ks + r * 64 + c8) = (f32x4){bf_lo(wk.x), bf_hi(wk.x), bf_lo(wk.y), bf_hi(wk.y)}; *(LAS f32x4*)(Ks + r * 64 + c8 + 4) = (f32x4){bf_lo(wk.z), bf_hi(wk.z), bf_lo(wk.w), bf_hi(wk.w)};
          *(LAS f32x4*)(Vs + r * 64 + c8) = (f32x4){bf_lo(wv.x), bf_hi(wv.x), bf_lo(wv.y), bf_hi(wv.y)}; *(LAS f32x4*)(Vs + r * 64 + c8 + 4) = (f32x4){bf_lo(wv.z), bf_hi(wv.z), bf_lo(wv.w), bf_hi(wv.w)};
          if (tid < 64) cks[tid] = CF[(size_t)h * S + kt * 64 + tid]; }
        __syncthreads();
        for (int j = 0; j < 64; ++j) {
            float kv[16], vv[16];
#pragma unroll
            for (int d4 = 0; d4 < 4; ++d4) { const f32x4 a = *(const LAS f32x4*)(Ks + j * 64 + part * 16 + d4 * 4); kv[d4 * 4] = a[0]; kv[d4 * 4 + 1] = a[1]; kv[d4 * 4 + 2] = a[2]; kv[d4 * 4 + 3] = a[3];
                const f32x4 b = *(const LAS f32x4*)(Vs + j * 64 + part * 16 + d4 * 4); vv[d4 * 4] = b[0]; vv[d4 * 4 + 1] = b[1]; vv[d4 * 4 + 2] = b[2]; vv[d4 * 4 + 3] = b[3]; }
            float s = 0.f;
#pragma unroll
            for (int d = 0; d < 16; ++d) s += q[d] * kv[d];
            s += __shfl_xor(s, 1); s += __shfl_xor(s, 2);
            s += cq - cks[j];
            soft_update(m, l, o, s, (kt * 64 + j) <= t, vv);
        }
    }
    store16(Y + (size_t)t * 768 + h * 64 + part * 16, o, 1.f / l);
    __syncthreads();
}
__device__ __forceinline__ void moba_naive_unit(int tid, int h, int tb, const bf16* MQ, const bf16* MK, const bf16* MV, const int* SEL, bf16* Y) {
    const int tl = tid >> 2, part = tid & 3, t = tb * 128 + tl, own = (tb * 128) >> 8, nsel = own < 3 ? own : 3;
    float q[16], o[16], m = -INFINITY, l = 0.f;
    load16(MQ + (size_t)t * 256 + h * 64 + part * 16, q);
#pragma unroll
    for (int d = 0; d < 16; ++d) o[d] = 0.f;
    for (int sg = 0; sg <= nsel; ++sg) {
        const int blk = (sg < nsel) ? SEL[((size_t)t * 4 + h) * 4 + sg] : own;
        const int nk = (sg < nsel) ? 256 : (tb * 128 + 128 - own * 256);
        for (int j = 0; j < nk; ++j) { const int key = blk * 256 + j; float kv[16], vv[16];
            load16(MK + (size_t)key * 256 + h * 64 + part * 16, kv); load16(MV + (size_t)key * 256 + h * 64 + part * 16, vv);
            float s = 0.f;
#pragma unroll
            for (int d = 0; d < 16; ++d) s += q[d] * kv[d];
            s += __shfl_xor(s, 1); s += __shfl_xor(s, 2);
            soft_update(m, l, o, s, key <= t, vv); }
    }
    store16(Y + (size_t)t * 768 + h * 64 + part * 16, o, 1.f / l);
}

__device__ __forceinline__ void moba_gate_batch(LAS unsigned char* lds, int tid, int b, const bf16* MQ, const float* KM, int* SEL, int* QL, unsigned* MCNT) {
    LAS float* km = (LAS float*)lds;
    LAS int* hist = (LAS int*)(lds + 65536);
    LAS int* base = hist + 256;
    const int own = (b * 128) >> 8, nsel = own < 3 ? own : 3;
    if (tid < 256) hist[tid] = 0;
    for (int i = tid; i < 4 * 64 * 16; i += 512) { const int hh = i >> 10, rem = i & 1023, j = rem >> 4; if (j < own) *(LAS f32x4*)(km + (size_t)i * 4) = *(const f32x4*)(KM + (size_t)i * 4); (void)hh; }
    __syncthreads();
    const int h = tid >> 7, tl = tid & 127, t = b * 128 + tl;
    int i0 = 0, i1 = 0, i2 = 0, r0 = 0, r1 = 0, r2 = 0;
    if (own > 0) {
        float q[64];
#pragma unroll
        for (int c = 0; c < 4; ++c) { float tmp[16]; load16(MQ + (size_t)t * 256 + h * 64 + c * 16, tmp);
#pragma unroll
            for (int d = 0; d < 16; ++d) q[c * 16 + d] = tmp[d]; }
        float v0 = -INFINITY, v1 = -INFINITY, v2 = -INFINITY;
        for (int n = 0; n < own; ++n) { const LAS float* kr = km + (h * 64 + n) * 64; float s = 0.f;
#pragma unroll
            for (int d4 = 0; d4 < 16; ++d4) { const f32x4 kk = *(const LAS f32x4*)(kr + d4 * 4); s += q[d4 * 4] * kk[0] + q[d4 * 4 + 1] * kk[1] + q[d4 * 4 + 2] * kk[2] + q[d4 * 4 + 3] * kk[3]; }
            if (s > v0) { v2 = v1; i2 = i1; v1 = v0; i1 = i0; v0 = s; i0 = n; }
            else if (s > v1) { v2 = v1; i2 = i1; v1 = s; i1 = n; }
            else if (s > v2) { v2 = s; i2 = n; } }
        if (nsel > 0) r0 = __hip_atomic_fetch_add(hist + h * 64 + i0, 1, __ATOMIC_RELAXED, __HIP_MEMORY_SCOPE_WORKGROUP);
        if (nsel > 1) r1 = __hip_atomic_fetch_add(hist + h * 64 + i1, 1, __ATOMIC_RELAXED, __HIP_MEMORY_SCOPE_WORKGROUP);
        if (nsel > 2) r2 = __hip_atomic_fetch_add(hist + h * 64 + i2, 1, __ATOMIC_RELAXED, __HIP_MEMORY_SCOPE_WORKGROUP);
        int* sp = SEL + ((size_t)t * 4 + h) * 4; sp[0] = i0; sp[1] = i1; sp[2] = i2;
    }
    __syncthreads();
    if (tid < 256) { const int c = hist[tid]; base[tid] = c > 0 ? (int)__hip_atomic_fetch_add(MCNT + tid, (unsigned)c, __ATOMIC_RELAXED, __HIP_MEMORY_SCOPE_AGENT) : 0; }
    __syncthreads();
    if (nsel > 0) QL[((size_t)h * 63 + i0) * 16384 + base[h * 64 + i0] + r0] = t * 4 + 0;
    if (nsel > 1) QL[((size_t)h * 63 + i1) * 16384 + base[h * 64 + i1] + r1] = t * 4 + 1;
    if (nsel > 2) QL[((size_t)h * 63 + i2) * 16384 + base[h * 64 + i2] + r2] = t * 4 + 2;
    __syncthreads();
}

__device__ __forceinline__ void moe_table(const unsigned* cntg, LAS int* tab, int tid) {
    if (tid < 64) { const int e = tid; const int c = e < 32 ? (int)__hip_atomic_load(cntg + e, __ATOMIC_RELAXED, __HIP_MEMORY_SCOPE_AGENT) : 0; const int nt = (c + 255) >> 8;
        int incl = nt;
#pragma unroll
        for (int o = 1; o < 64; o <<= 1) { const int y = __shfl_up(incl, o); if (e >= o) incl += y; }
        if (e < 32) { tab[e] = c; tab[32 + e] = incl - nt; }
        if (e == 31) { tab[64] = incl; tab[65] = incl; } }
    __syncthreads();
    const int ntl = tab[65];
    for (int m = tid; m < ntl; m += 512) { int e = 0;
        for (int j = 1; j < 32; ++j) if (tab[32 + j] <= m) e = j;
        tab[128 + m] = e; }
    __syncthreads();
}

__device__ __forceinline__ void ln1_router_block(LAS unsigned char* lds, int tid, int blk, const bf16* XB, const float* Y, const float* g1, const float* b1, const float* brt,
                                                 bf16* X1, unsigned* CNT, int* TOK, int* TE, int* TP, float* TG) {
    LAS float* WrT = (LAS float*)lds;
    LAS int* hist = (LAS int*)(lds + RT_OFF); LAS int* base = hist + 32; LAS int* sel_e = base + 32; LAS int* sel_r = sel_e + 256; LAS float* sel_g = (LAS float*)(sel_r + 256);
    LAS float* wsc = sel_g + 256;
    const int lane = tid & 63, wave = tid >> 6;
    if (tid < 32) hist[tid] = 0;
    __syncthreads();
    for (int rr = 0; rr < 8; ++rr) {
        const int tl = wave * 8 + rr; const size_t t = (size_t)blk * 64 + tl;
        f32x4 v[4]; float s = 0.f;
#pragma unroll
        for (int j = 0; j < 4; ++j) { const int c = 4 * lane + 256 * j; const f32x4 y = *(const f32x4*)(Y + t * 1024 + c); const u32x2 xw = *(const u32x2*)(XB + t * 1024 + c);
            v[j] = (f32x4){bf_lo(xw.x), bf_hi(xw.x), bf_lo(xw.y), bf_hi(xw.y)} * ALPHA + y; s += (v[j][0] + v[j][1]) + (v[j][2] + v[j][3]); }
        const float mean = wave_sum(s) * (1.f / 1024.f); float s2 = 0.f;
#pragma unroll
        for (int j = 0; j < 4; ++j) { v[j] = v[j] - mean; s2 += (v[j][0] * v[j][0] + v[j][1] * v[j][1]) + (v[j][2] * v[j][2] + v[j][3] * v[j][3]); }
        const float rstd = 1.f / sqrtf(wave_sum(s2) * (1.f / 1024.f) + LN_EPS);
#pragma unroll
        for (int j = 0; j < 4; ++j) { const int c = 4 * lane + 256 * j; const f32x4 g = *(const f32x4*)(g1 + c), b = *(const f32x4*)(b1 + c); v[j] = v[j] * rstd * g + b;
            u32x2 w; w.x = cvt_pk_bf16(v[j][0], v[j][1]); w.y = cvt_pk_bf16(v[j][2], v[j][3]); *(u32x2*)(X1 + t * 1024 + c) = w; }
        float a[32];
#pragma unroll
        for (int e = 0; e < 32; ++e) { float acc = 0.f;
#pragma unroll
            for (int j = 0; j < 4; ++j) { const f32x4 w = *(const LAS f32x4*)(WrT + e * 1024 + 256 * j + 4 * lane); acc += v[j][0] * w[0] + v[j][1] * w[1] + v[j][2] * w[2] + v[j][3] * w[3]; }
            a[e] = acc; }
        { float b16[16];
          { const bool up = (lane & 32) != 0;
#pragma unroll
            for (int i = 0; i < 16; ++i) { const float send = up ? a[i] : a[i + 16], keep = up ? a[i + 16] : a[i]; b16[i] = keep + __shfl_xor(send, 32); } }
          float b8[8];
          { const bool up = (lane & 16) != 0;
#pragma unroll
            for (int i = 0; i < 8; ++i) { const float send = up ? b16[i] : b16[i + 8], keep = up ? b16[i + 8] : b16[i]; b8[i] = keep + __shfl_xor(send, 16); } }
          float b4[4];
          { const bool up = (lane & 8) != 0;
#pragma unroll
            for (int i = 0; i < 4; ++i) { const float send = up ? b8[i] : b8[i + 4], keep = up ? b8[i + 4] : b8[i]; b4[i] = keep + __shfl_xor(send, 8); } }
          float b2[2];
          { const bool up = (lane & 4) != 0;
#pragma unroll
            for (int i = 0; i < 2; ++i) { const float send = up ? b4[i] : b4[i + 2], keep = up ? b4[i + 2] : b4[i]; b2[i] = keep + __shfl_xor(send, 4); } }
          float b1v;
          { const bool up = (lane & 2) != 0; const float send = up ? b2[0] : b2[1], keep = up ? b2[1] : b2[0]; b1v = keep + __shfl_xor(send, 2); }
          b1v += __shfl_xor(b1v, 1);
          const int e = (lane >> 1) & 31;
          if ((lane & 1) == 0) wsc[wave * 32 + e] = b1v + brt[e]; }
        asm volatile("s_waitcnt lgkmcnt(0)" ::: "memory");
        float lv[32];
#pragma unroll
        for (int e4 = 0; e4 < 8; ++e4) { const f32x4 x = *(const LAS f32x4*)(wsc + wave * 32 + e4 * 4); lv[e4 * 4] = x[0]; lv[e4 * 4 + 1] = x[1]; lv[e4 * 4 + 2] = x[2]; lv[e4 * 4 + 3] = x[3]; }
        float tv[4]; int ti[4];
#pragma unroll
        for (int k = 0; k < 4; ++k) { float bv = -INFINITY; int bi = 0;
#pragma unroll
            for (int e = 0; e < 32; ++e) { const bool taken = (k > 0 && ti[0] == e) || (k > 1 && ti[1] == e) || (k > 2 && ti[2] == e); if (!taken && lv[e] > bv) { bv = lv[e]; bi = e; } }
            tv[k] = bv; ti[k] = bi; }
        const float e1 = __expf(tv[1] - tv[0]), e2 = __expf(tv[2] - tv[0]), e3 = __expf(tv[3] - tv[0]); const float inv = 1.f / (1.f + e1 + e2 + e3);
        if (lane < 4) { const int ek = lane == 0 ? ti[0] : lane == 1 ? ti[1] : lane == 2 ? ti[2] : ti[3]; const float gk = (lane == 0 ? 1.f : lane == 1 ? e1 : lane == 2 ? e2 : e3) * inv;
            const int rk = __hip_atomic_fetch_add(hist + ek, 1, __ATOMIC_RELAXED, __HIP_MEMORY_SCOPE_WORKGROUP);
            sel_e[tl * 4 + lane] = ek; sel_r[tl * 4 + lane] = rk; sel_g[tl * 4 + lane] = gk; }
        asm volatile("s_waitcnt lgkmcnt(0)" ::: "memory");
    }
    __syncthreads();
    if (tid < 32) { const int c = hist[tid]; base[tid] = c > 0 ? (int)__hip_atomic_fetch_add(CNT + tid, (unsigned)c, __ATOMIC_RELAXED, __HIP_MEMORY_SCOPE_AGENT) : 0; }
    __syncthreads();
    if (tid < 256) { const int tl = tid >> 2; const int t = blk * 64 + tl; const int e = sel_e[tid], pos = base[e] + sel_r[tid];
        TOK[e * 16384 + pos] = t; TE[(size_t)t * 4 + (tid & 3)] = e; TP[(size_t)t * 4 + (tid & 3)] = pos; TG[(size_t)t * 4 + (tid & 3)] = sel_g[tid]; }
    __syncthreads();
}

__device__ __forceinline__ void ln2_row(int lane, size_t t, const bf16* X1, const bf16* YB, const LAS int* tab, const int* TE, const int* TP, const float* TG, const float* g2, const float* b2, bf16* XB, float* outp) {
    f32x4 v[4];
#pragma unroll
    for (int j = 0; j < 4; ++j) { const int c = 4 * lane + 256 * j; const u32x2 xw = *(const u32x2*)(X1 + t * 1024 + c); v[j] = (f32x4){bf_lo(xw.x), bf_hi(xw.x), bf_lo(xw.y), bf_hi(xw.y)} * ALPHA; }
#pragma unroll
    for (int k = 0; k < (DBG_NO_MOE ? 0 : 4); ++k) { const int e = TE[t * 4 + k], pos = TP[t * 4 + k]; const float g = TG[t * 4 + k]; const size_t slot = (size_t)tab[32 + e] * 256 + pos;
#pragma unroll
        for (int j = 0; j < 4; ++j) { const int c = 4 * lane + 256 * j; const u32x2 yw = *(const u32x2*)(YB + slot * 1024 + c); v[j] += (f32x4){bf_lo(yw.x), bf_hi(yw.x), bf_lo(yw.y), bf_hi(yw.y)} * g; } }
    float s = 0.f;
#pragma unroll
    for (int j = 0; j < 4; ++j) s += (v[j][0] + v[j][1]) + (v[j][2] + v[j][3]);
    const float mean = wave_sum(s) * (1.f / 1024.f); float s2 = 0.f;
#pragma unroll
    for (int j = 0; j < 4; ++j) { v[j] = v[j] - mean; s2 += (v[j][0] * v[j][0] + v[j][1] * v[j][1]) + (v[j][2] * v[j][2] + v[j][3] * v[j][3]); }
    const float rstd = 1.f / sqrtf(wave_sum(s2) * (1.f / 1024.f) + LN_EPS);
#pragma unroll
    for (int j = 0; j < 4; ++j) { const int c = 4 * lane + 256 * j; const f32x4 g = *(const f32x4*)(g2 + c), b = *(const f32x4*)(b2 + c); v[j] = v[j] * rstd * g + b;
        u32x2 w; w.x = cvt_pk_bf16(v[j][0], v[j][1]); w.y = cvt_pk_bf16(v[j][2], v[j][3]); *(u32x2*)(XB + t * 1024 + c) = w;
        if (outp) *(f32x4*)(outp + t * 1024 + c) = v[j]; }
}


__device__ __forceinline__ void dbg_dump(int id, unsigned char* ws, float* out, int vcu, int G, int tid) {
    const bf16* PROJ = (const bf16*)(ws + WS_PROJ);
    for (size_t i = (size_t)vcu * 512 + tid; i < (size_t)S * 1024; i += (size_t)G * 512) { const size_t t = i >> 10; const int c = (int)(i & 1023); float v = 0.f;
        if (id == 1) v = bf2f(PROJ[(size_t)(c >> 8) * S * 256 + t * 256 + (c & 255)]);
        else if (id == 2) v = bf2f(PROJ[(size_t)(4 + (c >> 8)) * S * 256 + t * 256 + (c & 255)]);
        else if (id == 3) v = c < 256 ? bf2f(PROJ[(size_t)8 * S * 256 + t * 256 + c]) : bf2f(((const bf16*)(ws + WS_SG))[t * 3072 + (c - 256) * 4]);
        else if (id == 4) v = c < 128 ? ((const float*)(ws + WS_LA))[t * 128 + c] : c < 132 ? ((const float*)(ws + WS_FFL))[t * 4 + (c - 128)] : c < 136 ? ((const float*)(ws + WS_CF))[(size_t)(c - 132) * S + t] : 0.f;
        else if (id == 5) v = c < 768 ? bf2f(((const bf16*)(ws + WS_YS))[t * 768 + c]) : 0.f;
        else if (id == 6) v = bf2f(((const bf16*)(ws + WS_MRG))[i]);
        else if (id == 7) v = ((const float*)(ws + WS_Y))[i];
        else if (id == 8) v = bf2f(((const bf16*)(ws + WS_X1))[i]);
        else if (id == 9) v = bf2f(((const bf16*)(ws + WS_XB))[i]);
        else if (id == 10) v = c < 256 ? bf2f(((const bf16*)(ws + WS_YS))[t * 256 + c]) : 0.f;
        else if (id == 11) v = c < 256 ? bf2f(((const bf16*)(ws + WS_YS))[(size_t)S * 256 + t * 256 + c]) : 0.f;
        else if (id == 14) v = bf2f(((const bf16*)(ws + WS_SG))[t * 3072 + 2048 + c]);
        else if (id == 12) v = c < 256 ? bf2f(((const bf16*)(ws + WS_YS))[(size_t)2 * S * 256 + t * 256 + c]) : 0.f;
        out[i] = v; }
}
__global__ void __launch_bounds__(512, 2) mk_fwd(Args args_in_kernarg) {
    extern __shared__ __attribute__((aligned(16))) unsigned char lds_raw[];
    LAS unsigned char* lds = (LAS unsigned char*)lds_raw;
    const int tid0 = threadIdx.x;
    const int G = gridDim.x; const int bx = blockIdx.x; const int vcu = (G % 8 == 0) ? (bx % 8) * (G / 8) + bx / 8 : bx;
    const CAS unsigned char* const kargs = (const CAS unsigned char*)__builtin_amdgcn_kernarg_segment_ptr();
    for (int u = tid0; u < (LDS_BYTES - LDSCTL_OFF) / 4; u += 512) ((LAS unsigned*)(lds + LDSCTL_OFF))[u] = 0u;
    __syncthreads();
    const int lo = *(const CAS int*)(kargs + 160), hi = *(const CAS int*)(kargs + 164);
    XcdBarrier bar; bar.bar = (unsigned*)KARG_WS(kargs) + CW_BAR; bar.x = 0; bar.st = nullptr;
    if (hi - lo > 1) bar = xcd_barrier_post((unsigned*)KARG_WS(kargs) + CW_BAR, (volatile LAS unsigned*)(lds + MISC_OFF) + 8);
#define IN(k) (lo <= (k) && (k) < hi)
#define SEAM(k) do { if (IN(k) && IN((k) + 1)) xcd_barrier(bar); } while (0)
#define PHASE_PTRS() const CAS unsigned char* kp = kargs; asm volatile("" : "+s"(kp)); unsigned char* const ws = KARG_WS(kp); (void)ws; \
    int tid = threadIdx.x; asm volatile("" : "+v"(tid)); const int lane = tid & 63, wave = __builtin_amdgcn_readfirstlane(tid >> 6); (void)lane; (void)wave
#define PROJ_ ((bf16*)(ws + WS_PROJ))
#define FQ_ (PROJ_)
#define FK_ (PROJ_ + (size_t)1 * S * 256)
#define FV_ (PROJ_ + (size_t)2 * S * 256)
#define MQ_ (PROJ_ + (size_t)3 * S * 256)
#define MK_ (PROJ_ + (size_t)4 * S * 256)
#define MV_ (PROJ_ + (size_t)5 * S * 256)
#define GQK_ (PROJ_ + (size_t)6 * S * 256)
#define GV_ (PROJ_ + (size_t)7 * S * 256)
#define GR_ (PROJ_ + (size_t)8 * S * 256)
    LAS int* const tab = (LAS int*)(lds + TAB_OFF);

#if DBG_DUMP
    if (lo == 999) { PHASE_PTRS(); dbg_dump(DBG_DUMP, ws, KARG_OUT(kp), vcu, G, tid); return; }
#endif
    if (IN(0)) { PHASE_PTRS(); p0_prologue(kp, lds, vcu, G, tid); }
    SEAM(0);

    for (int l = 0; l < DEPTH; ++l) {
        const int pb = 1 + l * NPH;
        if (hi <= pb || lo >= pb + NPH) continue;
        if (IN(pb + 0)) { PHASE_PTRS();
            pg8::DenseOrder So; So.init(S, NIN, 1024, (const bf16*)(ws + WS_WIN) + (size_t)l * NIN * 1024, G, bx);
            pg8::EpiIn E{PROJ_, (bf16*)(ws + WS_SG), (float*)(ws + WS_LA), (float*)(ws + WS_FFL), KARG_IN(kp, 4) + l * 128, KARG_IN(kp, 2) + l * 4};
            pg8::gemm_phase<pg8::EpiIn, pg8::DenseOrder, true, false>(lds, (const bf16*)(ws + WS_XB), 1024, So, E);
        }
        SEAM(pb + 0);
#if DBG_DUMP
        if (l == 0 && DBG_AFTER == 0 && hi - lo > 1) { PHASE_PTRS(); dbg_dump(DBG_DUMP, ws, KARG_OUT(kp), vcu, G, tid); return; }
#endif
        if (IN(pb + 1)) { PHASE_PTRS();
            const bf16* MK = MK_; float* KM = (float*)(ws + WS_KM);
            for (int job = vcu; job < 1024 + 256; job += G) {
                if (job < 1024) gla_local_unit(lds, tid, job >> 2, job & 3, GQK_, GV_, (const float*)(ws + WS_LA), (float*)(ws + WS_U), (float*)(ws + WS_DEC));
                else { const int hj = job - 1024, h = hj >> 6, j = hj & 63; LAS float* red = (LAS float*)lds; const int d = tid & 63, part = tid >> 6; float s = 0.f;
                    for (int i = 0; i < 32; ++i) s += bf2f(MK[(size_t)(j * 256 + part * 32 + i) * 256 + h * 64 + d]);
                    red[part * 64 + d] = s; __syncthreads();
                    if (tid < 64) { float tot = 0.f;
#pragma unroll
                        for (int p = 0; p < 8; ++p) tot += red[p * 64 + tid];
                        KM[(size_t)(h * 64 + j) * 64 + tid] = tot * (1.f / 256.f); }
                    __syncthreads(); }
            }
        }
        SEAM(pb + 1);
#if DBG_DUMP
        if (l == 0 && DBG_AFTER == 1 && hi - lo > 1) { PHASE_PTRS(); dbg_dump(DBG_DUMP, ws, KARG_OUT(kp), vcu, G, tid); return; }
#endif
        if (IN(pb + 2)) { PHASE_PTRS();
            for (int job = vcu; job < 16 + 4 + 128; job += G) {
                if (job < 16) { const float* DEC = (const float*)(ws + WS_DEC); const float* Ub = (const float*)(ws + WS_U); float* SST = (float*)(ws + WS_SST);
                    const int e = job * 512 + tid; float s = 0.f;
                    for (int i = 0; i < 256; i += 8) { float d[8], u[8];
#pragma unroll
                        for (int k = 0; k < 8; ++k) { d[k] = DEC[(i + k) * 128 + (e >> 6)]; u[k] = Ub[(size_t)(i + k) * 8192 + e]; }
#pragma unroll
                        for (int k = 0; k < 8; ++k) { SST[(size_t)(i + k) * 8192 + e] = s; s = s * d[k] + u[k]; } } }
                else if (job < 20) { const float* FFL = (const float*)(ws + WS_FFL); float* CF = (float*)(ws + WS_CF);
                    const int h = job - 16; LAS float* wt = (LAS float*)lds; float sum = 0.f;
                    for (int i = 0; i < 32; ++i) sum += FFL[(size_t)(tid * 32 + i) * 4 + h];
                    float x = sum;
#pragma unroll
                    for (int o = 1; o < 64; o <<= 1) { const float y = __shfl_up(x, o); if (lane >= o) x += y; }
                    if (lane == 63) wt[wave] = x;
                    __syncthreads();
                    float pre = x - sum;
                    for (int w = 0; w < wave; ++w) pre += wt[w];
                    float run = pre;
                    for (int i = 0; i < 32; ++i) { run += FFL[(size_t)(tid * 32 + i) * 4 + h]; CF[(size_t)h * S + tid * 32 + i] = run * LOG2E; }
                    __syncthreads(); }
                else moba_gate_batch(lds, tid, job - 20, MQ_, (const float*)(ws + WS_KM), (int*)(ws + WS_SEL), (int*)(ws + WS_QL), (unsigned*)ws + CW_MCNT + l * 256);
            }
        }
        SEAM(pb + 2);
#if DBG_DUMP
        if (l == 0 && DBG_AFTER == 2 && hi - lo > 1) { PHASE_PTRS(); dbg_dump(DBG_DUMP, ws, KARG_OUT(kp), vcu, G, tid); return; }
#endif
        if (IN(pb + 3)) { PHASE_PTRS();
            bf16* const YS = (bf16*)(ws + WS_YS);
            for (int p = vcu; p < 256; p += G) { const int h = p >> 6, s = p & 63;
                fox_naive_unit(lds, tid, h, s, FQ_, FK_, FV_, (const float*)(ws + WS_CF), YS);
                fox_naive_unit(lds, tid, h, 127 - s, FQ_, FK_, FV_, (const float*)(ws + WS_CF), YS); }
            for (int u = vcu; u < 512; u += G) moba_naive_unit(tid, u & 3, u >> 2, MQ_, MK_, MV_, (const int*)(ws + WS_SEL), YS + 512);
            for (int u = vcu; u < 1024; u += G) gla_out_unit(lds, tid, u >> 2, u & 3, GQK_, GV_, GR_, (const float*)(ws + WS_LA), (const float*)(ws + WS_SST), KARG_IN(kp, 5) + l * 256, YS + 256);
        }
        SEAM(pb + 3);
#if DBG_DUMP
        if (l == 0 && DBG_AFTER == 3 && hi - lo > 1) { PHASE_PTRS(); dbg_dump(DBG_DUMP, ws, KARG_OUT(kp), vcu, G, tid); return; }
#endif
        if (IN(pb + 4)) {
            for (int nb = 0; nb < 3; ++nb) { PHASE_PTRS();
                pg8::DenseOrder So; So.init(S, 1024, 768, (const bf16*)(ws + WS_WBP) + ((size_t)l * 3 + nb) * 1024 * 768, G, bx);
                pg8::EpiLift E{(const bf16*)(ws + WS_SG), (float*)(ws + WS_T), (float*)(ws + WS_Y), (bf16*)(ws + WS_MRG), nb};
                pg8::gemm_phase<pg8::EpiLift, pg8::DenseOrder, true, false>(lds, (const bf16*)(ws + WS_YS), 768, So, E);
                asm volatile("s_waitcnt vmcnt(0)" ::: "memory"); __syncthreads();
            }
        }
        SEAM(pb + 4);
#if DBG_DUMP
        if (l == 0 && DBG_AFTER == 4 && hi - lo > 1) { PHASE_PTRS(); dbg_dump(DBG_DUMP, ws, KARG_OUT(kp), vcu, G, tid); return; }
#endif
        if (IN(pb + 5)) { PHASE_PTRS();
            pg8::DenseOrder So; So.init(S, 1024, 1024, (const bf16*)(ws + WS_WOUT) + (size_t)l * 1024 * 1024, G, bx);
            pg8::EpiF32 E{(float*)(ws + WS_Y)};
            pg8::gemm_phase<pg8::EpiF32, pg8::DenseOrder, true, false>(lds, (const bf16*)(ws + WS_MRG), 1024, So, E);
        }
        SEAM(pb + 5);
#if DBG_DUMP
        if (l == 0 && DBG_AFTER == 5 && hi - lo > 1) { PHASE_PTRS(); dbg_dump(DBG_DUMP, ws, KARG_OUT(kp), vcu, G, tid); return; }
#endif
        if (IN(pb + 6)) { PHASE_PTRS();
            LAS float* WrT = (LAS float*)lds; const float* wr_ = KARG_IN(kp, 10) + (size_t)l * 1024 * 32;
            for (int i = tid; i < 32768; i += 512) { const int e = i & 31, d = i >> 5; WrT[e * 1024 + d] = wr_[i]; }
            __syncthreads();
            for (int blk = vcu; blk < S / 64; blk += G)
                ln1_router_block(lds, tid, blk, (const bf16*)(ws + WS_XB), (const float*)(ws + WS_Y), KARG_IN(kp, 8) + l * 1024, KARG_IN(kp, 9) + l * 1024, KARG_IN(kp, 11) + l * 32, (bf16*)(ws + WS_X1),
                                 (unsigned*)ws + CW_CNT + l * 64, (int*)(ws + WS_TOK), (int*)(ws + WS_TE), (int*)(ws + WS_TP), (float*)(ws + WS_TG));
        }
        SEAM(pb + 6);
#if DBG_DUMP
        if (l == 0 && DBG_AFTER == 6 && hi - lo > 1) { PHASE_PTRS(); dbg_dump(DBG_DUMP, ws, KARG_OUT(kp), vcu, G, tid); return; }
#endif
        if (IN(pb + 7)) { PHASE_PTRS();
            moe_table((const unsigned*)ws + CW_CNT + l * 64, tab, tid);
            pg8::MoeOrder So{G, vcu, 8, tab[65], tab, (const int*)(ws + WS_TOK), (const char*)((const bf16*)(ws + WS_WGU) + (size_t)l * 32 * 2048 * 1024), (size_t)2048 * 1024 * 2, 1024};
            pg8::EpiMoe1 E{(bf16*)(ws + WS_ACT), KARG_IN(kp, 13) + (size_t)l * 32 * 2048};
            pg8::gemm_phase<pg8::EpiMoe1, pg8::MoeOrder, true, true>(lds, (const bf16*)(ws + WS_X1), 1024, So, E);
        }
        SEAM(pb + 7);
#if DBG_DUMP
        if (l == 0 && DBG_AFTER == 7 && hi - lo > 1) { PHASE_PTRS(); dbg_dump(DBG_DUMP, ws, KARG_OUT(kp), vcu, G, tid); return; }
#endif
        if (IN(pb + 8)) { PHASE_PTRS();
            moe_table((const unsigned*)ws + CW_CNT + l * 64, tab, tid);
            pg8::MoeOrder So{G, vcu, 4, tab[65], tab, nullptr, (const char*)((const bf16*)(ws + WS_WDN) + (size_t)l * 32 * 1024 * 1024), (size_t)1024 * 1024 * 2, 1024};
            pg8::EpiMoe2 E{(bf16*)(ws + WS_YB), KARG_IN(kp, 15) + (size_t)l * 32 * 1024};
            pg8::gemm_phase<pg8::EpiMoe2, pg8::MoeOrder, true, false>(lds, (const bf16*)(ws + WS_ACT), 1024, So, E);
        }
        SEAM(pb + 8);
#if DBG_DUMP
        if (l == 0 && DBG_AFTER == 8 && hi - lo > 1) { PHASE_PTRS(); dbg_dump(DBG_DUMP, ws, KARG_OUT(kp), vcu, G, tid); return; }
#endif
        if (IN(pb + 9)) { PHASE_PTRS();
            moe_table((const unsigned*)ws + CW_CNT + l * 64, tab, tid);
            float* outp = (l == DEPTH - 1) ? KARG_OUT(kp) : nullptr;
            for (int t = vcu * 8 + wave; t < S; t += G * 8) ln2_row(lane, (size_t)t, (const bf16*)(ws + WS_X1), (const bf16*)(ws + WS_YB), tab, (const int*)(ws + WS_TE), (const int*)(ws + WS_TP), (const float*)(ws + WS_TG),
                                                                     KARG_IN(kp, 16) + l * 1024, KARG_IN(kp, 17) + l * 1024, (bf16*)(ws + WS_XB), outp);
        }
        SEAM(pb + 9);
#if DBG_DUMP
        if (l == 0 && DBG_AFTER == 9 && hi - lo > 1) { PHASE_PTRS(); dbg_dump(DBG_DUMP, ws, KARG_OUT(kp), vcu, G, tid); return; }
#endif
    }
#undef IN
#undef SEAM
}

extern "C" void kernel_launch(void* const* d_in, const int* in_sizes, int n_in, void* d_out, int out_size, void* d_ws, size_t ws_size, hipStream_t stream) {
    static int grid = 0;
    if (grid == 0) {
        if (n_in != 18 || out_size != S * D || ws_size < WS_END) { fprintf(stderr, "kernel_launch: unexpected shapes (n_in %d out %d ws %zu, need %zu)\n", n_in, out_size, ws_size, (size_t)WS_END); grid = -1; return; }
        int dev = 0, cus = 0, per_cu = 0;
        if (hipGetDevice(&dev) != hipSuccess || hipDeviceGetAttribute(&cus, hipDeviceAttributeMultiprocessorCount, dev) != hipSuccess) { grid = -1; return; }
        if (hipFuncSetAttribute((const void*)mk_fwd, hipFuncAttributeMaxDynamicSharedMemorySize, LDS_BYTES) != hipSuccess) { fprintf(stderr, "kernel_launch: hipFuncSetAttribute failed\n"); grid = -1; return; }
        if (hipOccupancyMaxActiveBlocksPerMultiprocessor(&per_cu, (const void*)mk_fwd, 512, LDS_BYTES) != hipSuccess || per_cu < 1) fprintf(stderr, "kernel_launch: occupancy query says %d\n", per_cu);
        (void)hipGetLastError();
        grid = cus;
    }
    if (grid < 0) return;
    (void)hipMemsetAsync((char*)d_ws + WS_CTL, 0, CTL_ZERO_BYTES, stream);
    Args a{};
    for (int i = 0; i < 18; ++i) a.in[i] = (const float*)d_in[i];
    a.out = (float*)d_out; a.ws = (unsigned char*)d_ws;
#if MK_PER_PHASE
#if DBG_DUMP
    for (int p = 0; p <= 1 + DBG_AFTER; ++p) { a.ph_lo = p; a.ph_hi = p + 1; hipLaunchKernelGGL(mk_fwd, dim3(grid), dim3(512), LDS_BYTES, stream, a); }
    a.ph_lo = 999; a.ph_hi = 1000; hipLaunchKernelGGL(mk_fwd, dim3(grid), dim3(512), LDS_BYTES, stream, a);
#else
    for (int p = 0; p < NPHASE; ++p) { a.ph_lo = p; a.ph_hi = p + 1; hipLaunchKernelGGL(mk_fwd, dim3(grid), dim3(512), LDS_BYTES, stream, a); }
#endif
#else
    a.ph_lo = 0; a.ph_hi = NPHASE;
    hipLaunchKernelGGL(mk_fwd, dim3(grid), dim3(512), LDS_BYTES, stream, a);
#endif
}
```

```cpp
#include <hip/hip_runtime.h>
#include <cstdio>
#include <cstdint>

#ifndef MK_PER_PHASE
#define MK_PER_PHASE 0
#endif

#ifndef DBG_DUMP
#define DBG_DUMP 0
#endif
#define DBG_AFTER (DBG_DUMP <= 4 ? (DBG_DUMP == 4 ? 2 : 0) : DBG_DUMP == 5 ? 3 : DBG_DUMP == 6 ? 4 : DBG_DUMP == 7 ? 4 : DBG_DUMP == 8 ? 6 : DBG_DUMP == 9 ? 9 : DBG_DUMP == 14 ? 4 : 3)
#ifndef DBG_NO_MOE
#define DBG_NO_MOE 0
#endif
#define LAS __attribute__((address_space(3)))
#define GAS __attribute__((address_space(1)))
typedef unsigned short bf16;
typedef short bf16x8 __attribute__((ext_vector_type(8)));
typedef float f32x4 __attribute__((ext_vector_type(4)));
typedef float f32x2 __attribute__((ext_vector_type(2)));
typedef unsigned u32x4 __attribute__((ext_vector_type(4)));
typedef unsigned u32x2 __attribute__((ext_vector_type(2)));

constexpr int S = 16384, D = 1024, DEPTH = 4;
constexpr int D_IN = 5396, NIN = 5632;
constexpr int NE = 32;
constexpr int NSLOT = 73728;
constexpr float ALPHA = 1.6817928305074290f;
constexpr float LOG2E = 1.4426950408889634f;
constexpr float C2 = 0.125f * LOG2E;
constexpr float LN_EPS = 1e-5f, RMS_EPS = 1e-6f;
constexpr int NPH = 11;
constexpr int NPHASE = 1 + DEPTH * NPH;

constexpr size_t MiB = 1ull << 20;
constexpr size_t WS_CTL = 0, CTL_ZERO_BYTES = 1 * MiB;
constexpr size_t WS_WIN = 1 * MiB;
constexpr size_t WS_WBR = WS_WIN + 44 * MiB;
constexpr size_t WS_WOUT = WS_WBR + 6 * MiB;
constexpr size_t WS_WGU = WS_WOUT + 8 * MiB;
constexpr size_t WS_WDN = WS_WGU + 512 * MiB;
constexpr size_t WS_XB = WS_WDN + 256 * MiB;
constexpr size_t WS_X1 = WS_XB + 32 * MiB;
constexpr size_t WS_PROJ = WS_X1 + 32 * MiB;
constexpr size_t WS_SG = WS_PROJ + 72 * MiB;
constexpr size_t WS_LA = WS_SG + 96 * MiB;
constexpr size_t WS_FFL = WS_LA + 8 * MiB;
constexpr size_t WS_CF = WS_FFL + 1 * MiB;
constexpr size_t WS_YS = WS_CF + 1 * MiB;
constexpr size_t WS_T = WS_YS + 24 * MiB;
constexpr size_t WS_MRG = WS_T + 64 * MiB;
constexpr size_t WS_Y = WS_MRG + 32 * MiB;
constexpr size_t WS_ACT = WS_Y + 64 * MiB;
constexpr size_t WS_YB = WS_ACT + 144 * MiB;
constexpr size_t WS_U = WS_YB + 144 * MiB;
constexpr size_t WS_SST = WS_U + 8 * MiB;
constexpr size_t WS_DEC = WS_SST + 8 * MiB;
constexpr size_t WS_KM = WS_DEC + 1 * MiB;
constexpr size_t WS_SEL = WS_KM + 1 * MiB;
constexpr size_t WS_QL = WS_SEL + 1 * MiB;
constexpr size_t WS_TOK = WS_QL + 16 * MiB;
constexpr size_t WS_TE = WS_TOK + 2 * MiB;
constexpr size_t WS_TP = WS_TE + 1 * MiB;
constexpr size_t WS_TG = WS_TP + 1 * MiB;
constexpr size_t WS_POF = WS_TG + 1 * MiB;
constexpr size_t WS_LSF = WS_POF + 64 * MiB;
constexpr size_t WS_POM = WS_LSF + 2 * MiB;
constexpr size_t WS_LSM = WS_POM + 32 * MiB;
constexpr size_t WS_WBP = WS_LSM + 1 * MiB;
constexpr size_t WS_END = WS_WBP + 20 * MiB;
constexpr int CW_BAR = 4096;
constexpr int CW_CNT = 16384;
constexpr int CW_MCNT = 20480;
constexpr int CW_Q = 24576;

constexpr int RING_BYTES = 131072;
constexpr int LDSCTL_OFF = RING_BYTES, MISC_OFF = LDSCTL_OFF + 320;
constexpr int TAB_OFF = RING_BYTES + 1024;
constexpr int RT_OFF = RING_BYTES + 4096;
constexpr int LDS_BYTES = 147456;

__device__ __forceinline__ float bf_lo(unsigned w) { return __uint_as_float(w << 16); }
__device__ __forceinline__ float bf_hi(unsigned w) { return __uint_as_float(w & 0xffff0000u); }
__device__ __forceinline__ float bf2f(bf16 b) { return __uint_as_float((unsigned)b << 16); }
typedef __bf16 bf16x2_t __attribute__((ext_vector_type(2)));
__device__ __forceinline__ unsigned cvt_pk_bf16(float lo, float hi) { f32x2 v = {lo, hi}; bf16x2_t b = __builtin_convertvector(v, bf16x2_t); return __builtin_bit_cast(unsigned, b); }
__device__ __forceinline__ float fast_exp2(float x) { return __builtin_amdgcn_exp2f(x); }
__device__ __forceinline__ float fast_rcp(float x) { return __builtin_amdgcn_rcpf(x); }
__device__ __forceinline__ float sigmoidf_(float x) { return fast_rcp(1.f + fast_exp2(-x * LOG2E)); }
__device__ __forceinline__ float logsigmoidf_(float x) { return fminf(x, 0.f) - __logf(1.f + __expf(-fabsf(x))); }
__device__ __forceinline__ float wave_sum(float v) {
#pragma unroll
    for (int o = 1; o < 64; o <<= 1) v += __shfl_xor(v, o);
    return v;
}

namespace pg8 {
constexpr int BM = 256, BK = 64, HALF = 128, HTB = HALF * BK * 2, NXCD = 8, WGM = 8;
__device__ __forceinline__ int lds_byte(int r, int c) { const int st = (r >> 4) * 2 + (c >> 5), rr = r & 15, cc = c & 31, ob = rr * 64 + cc * 2; return st * 1024 + (ob ^ (((ob >> 9) & 1) << 5)); }
__device__ __forceinline__ void stage_rc(int b, int& R, int& C) { const int st = b / 1024, sb = b % 1024, swz = sb ^ (((sb >> 9) & 1) << 5); R = (st >> 1) * 16 + swz / 64; C = (st & 1) * 32 + (swz % 64) / 2; }
__device__ __forceinline__ int perm32(int rho) { const int n = rho >> 4, i = rho & 15; return 8 * (i >> 2) + 4 * n + (i & 3); }

struct Unit { int pm, pn, e; };

struct DenseOrder {
    int nM, nN, nwg, G, c; const char* Bt; int K;
    __device__ void init(int M, int N, int K_, const bf16* Bt_, int G_, int c_) { nM = M / BM; nN = N / BM; nwg = nM * nN; G = G_; c = c_; Bt = (const char*)Bt_; K = K_; }
    __device__ bool next(int i, Unit& u) const {
        const long L = (long)i * G + c; if (L >= nwg) return false;
        int wgid = (int)L; { const int q = nwg / NXCD, r = nwg % NXCD, xcd = wgid % NXCD, off = wgid / NXCD; wgid = (xcd < r ? xcd * (q + 1) : r * (q + 1) + (xcd - r) * q) + off; }
        const int nig = WGM * nN, gid = wgid / nig, fm = gid * WGM, gsz = (nM - fm) < WGM ? (nM - fm) : WGM;
        u.pm = fm + ((wgid % nig) % gsz); u.pn = (wgid % nig) / gsz; u.e = 0; return true;
    }
    __device__ __forceinline__ unsigned arow(const Unit& u, int r) const { return (unsigned)(u.pm * BM + r); }
    __device__ __forceinline__ const char* bbase(const Unit& u) const { return Bt + (size_t)u.pn * BM * K * 2; }
};

struct MoeOrder {
    int G, c, NN, ntiles; const LAS int* tab; const int* toklist; const char* Bt; size_t ebytes; int K;
    __device__ bool next(int i, Unit& u) const {
        const int L = i * G + c; if (L >= ntiles * NN) return false;
        u.pm = L / NN; u.pn = L % NN; u.e = tab[128 + u.pm]; return true;
    }
    __device__ __forceinline__ unsigned arow(const Unit& u, int r) const {
        if (!toklist) return (unsigned)(u.pm * BM + r);
        const int rr = (u.pm - tab[32 + u.e]) * BM + r;
        return rr < tab[u.e] ? (unsigned)toklist[u.e * 16384 + rr] : 0u;
    }
    __device__ __forceinline__ const char* bbase(const Unit& u) const { return Bt + (size_t)u.e * ebytes + (size_t)u.pn * BM * K * 2; }
};

template <class Epi, class Sched, bool ALIGN_EPI, bool GATHER>
__device__ __forceinline__ void gemm_phase(LAS unsigned char* lds, const bf16* Abase, const int K, const Sched& S, const Epi& E) {
    int tid_ = threadIdx.x; asm volatile("" : "+v"(tid_));
    const int tid = tid_, wid = __builtin_amdgcn_readfirstlane(tid >> 6), lane = tid & 63, wr = wid >> 2, wc = wid & 3, fr = lane & 15, fq = lane >> 4;
    const int nt = K / BK;
    unsigned voffA[2], voffB[2];
#pragma unroll
    for (int i = 0; i < 2; ++i) { int R, C; stage_rc(tid * 16 + i * 8192, R, C); const int Rb = Epi::PERM ? ((R & ~31) + perm32(R & 31)) : R;
        voffA[i] = (unsigned)(R * K + C) * 2u; voffB[i] = (unsigned)(Rb * K + C) * 2u; }
    LAS u32x4* const stash = (LAS u32x4*)(lds + RING_BYTES + 8192) + tid;
    const size_t kstep = (size_t)(BK * 2);
    const size_t hstep = (size_t)HALF * K * 2;
    const unsigned ldsw = (unsigned)wid * 1024u;
    const int aoff = lds_byte(wr * 64 + fr, fq * 8), boff = lds_byte(wc * 32 + fr, fq * 8);
    const char* gA = (const char*)Abase;
#define PG8_SA(b, h) (((b) * 2 + (h)) * HTB)
#define PG8_SB(b, h) ((4 + (b) * 2 + (h)) * HTB)
#define PG8_STAGE(bufoff, gbase, voff) do { _Pragma("unroll") for (int _i = 0; _i < 2; ++_i) \
        __builtin_amdgcn_global_load_lds((const unsigned*)((const char*)(gbase) + (voff)[_i]), (LAS unsigned*)(lds + (bufoff) + ldsw + _i * 8192), 16, 0, 0); } while (0)
#define PG8_LDA(dst, b, h) do { _Pragma("unroll") for (int m = 0; m < 4; ++m) _Pragma("unroll") for (int k = 0; k < 2; ++k) dst[m][k] = *(const LAS bf16x8*)(lds + PG8_SA(b, h) + aoff + m * 2048 + k * 1024); } while (0)
#define PG8_LDB(dst, b, h) do { _Pragma("unroll") for (int n = 0; n < 2; ++n) _Pragma("unroll") for (int k = 0; k < 2; ++k) dst[n][k] = *(const LAS bf16x8*)(lds + PG8_SB(b, h) + boff + n * 2048 + k * 1024); } while (0)
#define PG8_MMA(ai, bj, At, Bt) do { __builtin_amdgcn_s_setprio(1); _Pragma("unroll") for (int m = 0; m < 4; ++m) _Pragma("unroll") for (int n = 0; n < 2; ++n) _Pragma("unroll") for (int k = 0; k < 2; ++k) \
        acc[ai][bj][m][n] = __builtin_amdgcn_mfma_f32_16x16x32_bf16(Bt[n][k], At[m][k], acc[ai][bj][m][n], 0, 0, 0); __builtin_amdgcn_s_setprio(0); } while (0)
#define PG8_WAIT_V(n) asm volatile("s_waitcnt vmcnt(" #n ")" ::: "memory")
#define PG8_WAIT_L(n) asm volatile("s_waitcnt lgkmcnt(" #n ")" ::: "memory")
#define PG8_BAR __builtin_amdgcn_s_barrier()
#define PG8_SCHED __builtin_amdgcn_sched_barrier(0)
#define PG8_AOFF(dst, u) do { _Pragma("unroll") for (int _h = 0; _h < 2; ++_h) _Pragma("unroll") for (int _i = 0; _i < 2; ++_i) { int _R, _C; stage_rc(tid * 16 + _i * 8192, _R, _C); \
        dst[_h][_i] = (S.arow(u, _h * HALF + _R) * (unsigned)K + (unsigned)_C) * 2u; } } while (0)
    Unit cur, nxt; int ui = 0;
    if (!S.next(0, cur)) return;
    f32x4 acc[2][2][4][2];
#pragma unroll
    for (int a = 0; a < 2; ++a)
#pragma unroll
        for (int b = 0; b < 2; ++b)
#pragma unroll
            for (int m = 0; m < 4; ++m)
#pragma unroll
                for (int n = 0; n < 2; ++n) acc[a][b][m][n] = (f32x4){0.f, 0.f, 0.f, 0.f};
    bf16x8 At[4][2], B0[2][2], B1[2][2];
    unsigned curA[2][2];
    const char* cA = gA;
    if constexpr (GATHER) { PG8_AOFF(curA, cur); }
    else { cA = gA + (size_t)S.arow(cur, 0) * K * 2; }
#define PG8_STA(bufoff, ptr, h) do { if constexpr (GATHER) { PG8_STAGE(bufoff, ptr, curA[h]); } else { PG8_STAGE(bufoff, (ptr) + (h) * hstep, voffA); } } while (0)
    const char* cB = S.bbase(cur);
    PG8_STAGE(PG8_SB(0, 0), cB, voffB); PG8_STAGE(PG8_SB(0, 1), cB + hstep, voffB); PG8_STA(PG8_SA(0, 0), cA, 0); PG8_STA(PG8_SA(0, 1), cA, 1);
    if (wr == 1) PG8_BAR;
    PG8_WAIT_V(2); PG8_BAR;
    PG8_STAGE(PG8_SB(1, 0), cB + kstep, voffB); PG8_STA(PG8_SA(1, 0), cA + kstep, 0); PG8_STAGE(PG8_SB(1, 1), cB + hstep + kstep, voffB);
    PG8_WAIT_V(6); PG8_BAR;
    for (;;) {
        const bool has_next = S.next(ui + 1, nxt);
        const char* nB = cB; const char* nA = cA;
        if (has_next) { nB = S.bbase(nxt);
            if constexpr (GATHER) { unsigned na[2][2]; PG8_AOFF(na, nxt); *stash = (u32x4){na[0][0], na[0][1], na[1][0], na[1][1]}; }
            else nA = gA + (size_t)S.arow(nxt, 0) * K * 2; }
        for (int t = 0; t < nt; t += 2) {
            const bool last = (t == nt - 2);
            const char* a1 = cA + (size_t)(t + 1) * kstep;
            const char* a2 = last ? nA : cA + (size_t)(t + 2) * kstep; const char* b2 = last ? nB : cB + (size_t)(t + 2) * kstep;
            const char* a3 = a2 + kstep; const char* b3 = b2 + kstep;
            PG8_LDB(B0, 0, 0); PG8_LDB(B1, 0, 1); PG8_SCHED; PG8_LDA(At, 0, 0); PG8_STA(PG8_SA(1, 1), a1, 1);
            if constexpr (GATHER) { if (last && has_next) { const u32x4 na = *stash; curA[0][0] = na.x; curA[0][1] = na.y; curA[1][0] = na.z; curA[1][1] = na.w; } }
            PG8_WAIT_V(8); PG8_WAIT_L(0); PG8_BAR; PG8_MMA(0, 0, At, B0); PG8_MMA(0, 1, At, B1); PG8_BAR; PG8_SCHED;
            PG8_LDA(At, 0, 1); PG8_STAGE(PG8_SB(0, 0), b2, voffB); PG8_STAGE(PG8_SB(0, 1), b2 + hstep, voffB); PG8_STA(PG8_SA(0, 0), a2, 0);
            PG8_WAIT_V(8); PG8_WAIT_L(0); PG8_BAR; PG8_MMA(1, 0, At, B0); PG8_MMA(1, 1, At, B1); PG8_BAR; PG8_SCHED;
            PG8_LDB(B0, 1, 0); PG8_LDB(B1, 1, 1); PG8_SCHED; PG8_LDA(At, 1, 0); PG8_STA(PG8_SA(0, 1), a2, 1);
            PG8_WAIT_V(8); PG8_WAIT_L(0); PG8_BAR; PG8_MMA(0, 0, At, B0); PG8_MMA(0, 1, At, B1); PG8_BAR; PG8_SCHED;
            PG8_LDA(At, 1, 1); PG8_STAGE(PG8_SB(1, 0), b3, voffB); PG8_STAGE(PG8_SB(1, 1), b3 + hstep, voffB); PG8_STA(PG8_SA(1, 0), a3, 0);
            PG8_WAIT_V(8); PG8_WAIT_L(0); PG8_BAR; PG8_MMA(1, 0, At, B0); PG8_MMA(1, 1, At, B1); PG8_BAR; PG8_SCHED;
        }
        if constexpr (ALIGN_EPI) { if (wr == 0) PG8_BAR; }
        E(acc, cur, wr, wc, fr, fq);
        if (!has_next) break;
#pragma unroll
        for (int a = 0; a < 2; ++a)
#pragma unroll
            for (int b = 0; b < 2; ++b)
#pragma unroll
                for (int m = 0; m < 4; ++m)
#pragma unroll
                    for (int n = 0; n < 2; ++n) acc[a][b][m][n] = (f32x4){0.f, 0.f, 0.f, 0.f};
        cur = nxt; cB = nB; cA = nA; ++ui;
        if constexpr (ALIGN_EPI) { if (wr == 1) PG8_BAR; }
    }
    PG8_WAIT_V(0);
    if constexpr (!ALIGN_EPI) { if (wr == 0) PG8_BAR; }
    PG8_BAR;
#undef PG8_SA
#undef PG8_SB
#undef PG8_STAGE
#undef PG8_LDA
#undef PG8_LDB
#undef PG8_MMA
#undef PG8_WAIT_V
#undef PG8_WAIT_L
#undef PG8_BAR
#undef PG8_SCHED
#undef PG8_AOFF
#undef PG8_STA
}

struct EpiIn {
    static constexpr bool PERM = false;
    bf16* proj; bf16* sg; float* la; float* ffl; const float* a_b; const float* fb;
    __device__ __forceinline__ void operator()(const f32x4 (&acc)[2][2][4][2], const Unit& u, int wr, int wc, int fr, int fq) const {
        const int pn = u.pn, rowb = u.pm * BM + wr * 64 + fr, cl0 = wc * 32 + 4 * fq;
        if (pn < 9) {
            bf16* base = proj + (size_t)pn * S * 256; const float sc = (pn == 0 || pn == 3) ? C2 : 1.f;
#pragma unroll
            for (int ai = 0; ai < 2; ++ai)
#pragma unroll
                for (int m = 0; m < 4; ++m) { bf16* rowp = base + (size_t)(rowb + ai * HALF + m * 16) * 256 + cl0;
#pragma unroll
                    for (int bj = 0; bj < 2; ++bj)
#pragma unroll
                        for (int n = 0; n < 2; ++n) { const f32x4 v = acc[ai][bj][m][n] * sc; u32x2 w; w.x = cvt_pk_bf16(v[0], v[1]); w.y = cvt_pk_bf16(v[2], v[3]); *(u32x2*)(rowp + bj * HALF + n * 16) = w; } }
        } else if (pn < 21) {
            bf16* base = sg + (size_t)(pn - 9) * 256;
#pragma unroll
            for (int ai = 0; ai < 2; ++ai)
#pragma unroll
                for (int m = 0; m < 4; ++m) { bf16* rowp = base + (size_t)(rowb + ai * HALF + m * 16) * 3072 + cl0;
#pragma unroll
                    for (int bj = 0; bj < 2; ++bj)
#pragma unroll
                        for (int n = 0; n < 2; ++n) { const f32x4 v = acc[ai][bj][m][n]; u32x2 w; w.x = cvt_pk_bf16(sigmoidf_(v[0]), sigmoidf_(v[1])); w.y = cvt_pk_bf16(sigmoidf_(v[2]), sigmoidf_(v[3])); *(u32x2*)(rowp + bj * HALF + n * 16) = w; } }
        } else {
#pragma unroll
            for (int n = 0; n < 2; ++n) { const f32x4 bv = *(const f32x4*)(a_b + cl0 + n * 16);
#pragma unroll
                for (int ai = 0; ai < 2; ++ai)
#pragma unroll
                    for (int m = 0; m < 4; ++m) { const f32x4 v = acc[ai][0][m][n] + bv; f32x4 o;
                        o[0] = logsigmoidf_(v[0]) * 0.0625f; o[1] = logsigmoidf_(v[1]) * 0.0625f; o[2] = logsigmoidf_(v[2]) * 0.0625f; o[3] = logsigmoidf_(v[3]) * 0.0625f;
                        *(f32x4*)(la + (size_t)(rowb + ai * HALF + m * 16) * 128 + cl0 + n * 16) = o; } }
            if (wc == 0 && fq == 0) { const f32x4 bv = *(const f32x4*)fb;
#pragma unroll
                for (int ai = 0; ai < 2; ++ai)
#pragma unroll
                    for (int m = 0; m < 4; ++m) { const f32x4 v = acc[ai][1][m][0] + bv; f32x4 o;
                        o[0] = logsigmoidf_(v[0]); o[1] = logsigmoidf_(v[1]); o[2] = logsigmoidf_(v[2]); o[3] = logsigmoidf_(v[3]);
                        *(f32x4*)(ffl + (size_t)(rowb + ai * HALF + m * 16) * 4) = o; } }
        }
    }
};
struct EpiLift {
    static constexpr bool PERM = false;
    const bf16* sg; float* T; float* T2; bf16* mrg; int nb;
    __device__ __forceinline__ void operator()(const f32x4 (&acc)[2][2][4][2], const Unit& u, int wr, int wc, int fr, int fq) const {
        const int rowb = u.pm * BM + wr * 64 + fr, col0 = u.pn * BM + wc * 32 + 4 * fq;
#pragma unroll
        for (int ai = 0; ai < 2; ++ai)
#pragma unroll
            for (int m = 0; m < 4; ++m) { const size_t row = (size_t)(rowb + ai * HALF + m * 16);
#pragma unroll
                for (int bj = 0; bj < 2; ++bj)
#pragma unroll
                    for (int n = 0; n < 2; ++n) { const int c = col0 + bj * HALF + n * 16;
                        const u32x2 gw = *(const u32x2*)(sg + row * 3072 + nb * 1024 + c);
                        f32x4 g; g[0] = bf_lo(gw.x); g[1] = bf_hi(gw.x); g[2] = bf_lo(gw.y); g[3] = bf_hi(gw.y);
                        f32x4 v = acc[ai][bj][m][n] * g;
                        if (nb == 2) v += *(const f32x4*)(T + row * 1024 + c) + *(const f32x4*)(T2 + row * 1024 + c);
                        if (nb == 0) *(f32x4*)(T + row * 1024 + c) = v;
                        else if (nb == 1) *(f32x4*)(T2 + row * 1024 + c) = v;
                        else { u32x2 w; w.x = cvt_pk_bf16(v[0], v[1]); w.y = cvt_pk_bf16(v[2], v[3]); *(u32x2*)(mrg + row * 1024 + c) = w; } } }
    }
};
struct EpiF32G {
    static constexpr bool PERM = false;
    float* C; const bf16* sg; int nb;
    __device__ __forceinline__ void operator()(const f32x4 (&acc)[2][2][4][2], const Unit& u, int wr, int wc, int fr, int fq) const {
        const int rowb = u.pm * BM + wr * 64 + fr, col0 = u.pn * BM + wc * 32 + 4 * fq;
#pragma unroll
        for (int ai = 0; ai < 2; ++ai)
#pragma unroll
            for (int m = 0; m < 4; ++m) { const size_t row = (size_t)(rowb + ai * HALF + m * 16);
#pragma unroll
                for (int bj = 0; bj < 2; ++bj)
#pragma unroll
                    for (int n = 0; n < 2; ++n) { const int c = col0 + bj * HALF + n * 16;
                        const u32x2 gw = *(const u32x2*)(sg + row * 3072 + nb * 1024 + c);
                        f32x4 g; g[0] = bf_lo(gw.x); g[1] = bf_hi(gw.x); g[2] = bf_lo(gw.y); g[3] = bf_hi(gw.y);
                        *(f32x4*)(C + row * 1024 + c) = acc[ai][bj][m][n] * g; } }
    }
};
struct EpiF32 {
    static constexpr bool PERM = false;
    float* C;
    __device__ __forceinline__ void operator()(const f32x4 (&acc)[2][2][4][2], const Unit& u, int wr, int wc, int fr, int fq) const {
        const int rowb = u.pm * BM + wr * 64 + fr, col0 = u.pn * BM + wc * 32 + 4 * fq;
#pragma unroll
        for (int ai = 0; ai < 2; ++ai)
#pragma unroll
            for (int m = 0; m < 4; ++m) { float* rowp = C + (size_t)(rowb + ai * HALF + m * 16) * 1024 + col0;
#pragma unroll
                for (int bj = 0; bj < 2; ++bj)
#pragma unroll
                    for (int n = 0; n < 2; ++n) *(f32x4*)(rowp + bj * HALF + n * 16) = acc[ai][bj][m][n]; }
    }
};
struct EpiMoe1 {
    static constexpr bool PERM = false;
    bf16* act; const float* b_gu;
    __device__ __forceinline__ void operator()(const f32x4 (&acc)[2][2][4][2], const Unit& u, int wr, int wc, int fr, int fq) const {
        const int rowb = u.pm * BM + wr * 64 + fr; const float* bb = b_gu + (size_t)u.e * 2048;
#pragma unroll
        for (int n = 0; n < 2; ++n) { const int j = u.pn * HALF + wc * 32 + n * 16 + 4 * fq;
            const f32x4 b0 = *(const f32x4*)(bb + 2 * j), b1 = *(const f32x4*)(bb + 2 * j + 4);
            const f32x4 bg = (f32x4){b0[0], b0[2], b1[0], b1[2]}, bu = (f32x4){b0[1], b0[3], b1[1], b1[3]};
#pragma unroll
            for (int ai = 0; ai < 2; ++ai)
#pragma unroll
                for (int m = 0; m < 4; ++m) { const f32x4 hg = acc[ai][0][m][n] + bg, hu = acc[ai][1][m][n] + bu; float o[4];
#pragma unroll
                    for (int i = 0; i < 4; ++i) { const float g = fminf(hg[i], 7.f), uu = fminf(fmaxf(hu[i], -7.f), 7.f); o[i] = (uu + 1.f) * (g * sigmoidf_(1.702f * g)); }
                    u32x2 w; w.x = cvt_pk_bf16(o[0], o[1]); w.y = cvt_pk_bf16(o[2], o[3]);
                    *(u32x2*)(act + (size_t)(rowb + ai * HALF + m * 16) * 1024 + j) = w; } }
    }
};
struct EpiMoe2 {
    static constexpr bool PERM = false;
    bf16* yb; const float* b_dn;
    __device__ __forceinline__ void operator()(const f32x4 (&acc)[2][2][4][2], const Unit& u, int wr, int wc, int fr, int fq) const {
        const int rowb = u.pm * BM + wr * 64 + fr, col0 = u.pn * BM + wc * 32 + 4 * fq; const float* bb = b_dn + (size_t)u.e * 1024;
#pragma unroll
        for (int bj = 0; bj < 2; ++bj)
#pragma unroll
            for (int n = 0; n < 2; ++n) { const int c = col0 + bj * HALF + n * 16; const f32x4 bv = *(const f32x4*)(bb + c);
#pragma unroll
                for (int ai = 0; ai < 2; ++ai)
#pragma unroll
                    for (int m = 0; m < 4; ++m) { const f32x4 v = acc[ai][bj][m][n] + bv; u32x2 w; w.x = cvt_pk_bf16(v[0], v[1]); w.y = cvt_pk_bf16(v[2], v[3]);
                        *(u32x2*)(yb + (size_t)(rowb + ai * HALF + m * 16) * 1024 + c) = w; } }
    }
};
}

#define XB_TMO      128
#define XB_XCNT(j)  (256  + 64 * (j))
#define XB_XSUB(j)  (1280 + 64 * (j))
#define XB_XGEN(j)  (2304 + 64 * (j))
#define XB_TOP      3328
#define XB_TOPGEN   3392
#define XCD_BAR_WORDS 3456
#define XB_SPIN_CAP (1u << 22)
__device__ __forceinline__ unsigned xb_ld(unsigned* p)              { return __hip_atomic_load(p, __ATOMIC_RELAXED, __HIP_MEMORY_SCOPE_AGENT); }
__device__ __forceinline__ unsigned xb_add(unsigned* p, unsigned v) { return __hip_atomic_fetch_add(p, v, __ATOMIC_RELAXED, __HIP_MEMORY_SCOPE_AGENT); }
__device__ __forceinline__ unsigned xb_xcc_id() { return (unsigned)__builtin_amdgcn_s_getreg((3 << 11) | 20) & 0xFu; }
#define XB_SPIN(cond, bar) do { unsigned _sp = 0; while (cond) { __builtin_amdgcn_s_sleep(1); \
    if ((++_sp & 255u) == 0u) { if (xb_ld(&(bar)[XB_TMO])) break; if (_sp > XB_SPIN_CAP) { atomicAdd(&(bar)[XB_TMO], 1u); break; } } } } while (0)
struct XcdBarrier { unsigned* bar; unsigned x; volatile LAS unsigned* st; };
__device__ __forceinline__ XcdBarrier xcd_barrier_post(unsigned* bar, volatile LAS unsigned* st) {
    XcdBarrier b; b.bar = bar; b.x = xb_xcc_id(); b.st = st;
    if (threadIdx.x == 0) (void)xb_add(&bar[XB_XCNT(b.x)], 1u);
    return b;
}
__device__ __forceinline__ void xcd_barrier_complete(unsigned* bar, unsigned x, unsigned& nloc, unsigned& nx) {
    const unsigned G = gridDim.x * gridDim.y * gridDim.z;
    unsigned sum, cnt, mine, sp = 0u;
    for (;;) {
        sum = 0u; cnt = 0u; mine = 0u;
#pragma unroll
        for (unsigned j = 0; j < 16; ++j) { const unsigned c = xb_ld(&bar[XB_XCNT(j)]); sum += c; cnt += (c > 0u) ? 1u : 0u; mine = (j == x) ? c : mine; }
        if (sum == G) break;
        __builtin_amdgcn_s_sleep(1);
        if ((++sp & 255u) == 0u) { if (xb_ld(&bar[XB_TMO])) break; if (sp > XB_SPIN_CAP) { atomicAdd(&bar[XB_TMO], 1u); break; } }
    }
    nloc = mine > 0u ? mine : 1u; nx = cnt > 0u ? cnt : 1u;
}
__device__ __forceinline__ void xcd_barrier(const XcdBarrier& b) {
    asm volatile("s_waitcnt vmcnt(0)" ::: "memory");
    __syncthreads();
    if (threadIdx.x == 0) {
        unsigned* bar = b.bar;
        __builtin_amdgcn_s_waitcnt(0);
        unsigned nloc = b.st[0], nx = b.st[1];
        if (nloc == 0u) { xcd_barrier_complete(bar, b.x, nloc, nx); b.st[0] = nloc; b.st[1] = nx; }
        const unsigned old = xb_add(&bar[XB_XSUB(b.x)], 1u);
        const unsigned gen = old / nloc;
        if (old + 1u == (gen + 1u) * nloc) {
            __builtin_amdgcn_fence(__ATOMIC_RELEASE, "agent");
            asm volatile("s_waitcnt vmcnt(0)" ::: "memory");
            const unsigned og = xb_add(&bar[XB_TOP], 1u);
            const unsigned tg = og / nx;
            if (og + 1u == (tg + 1u) * nx) xb_add(&bar[XB_TOPGEN], 1u);
            else XB_SPIN(xb_ld(&bar[XB_TOPGEN]) == tg, bar);
            __builtin_amdgcn_fence(__ATOMIC_ACQUIRE, "agent");
            xb_add(&bar[XB_XGEN(b.x)], 1u);
            asm volatile("s_waitcnt vmcnt(0)" ::: "memory");
        } else {
            XB_SPIN(xb_ld(&bar[XB_XGEN(b.x)]) == gen, bar);
            __builtin_amdgcn_fence(__ATOMIC_ACQUIRE, "agent");
            asm volatile("s_waitcnt vmcnt(0)" ::: "memory");
        }
    }
    __syncthreads();
}

struct MapIdent { __device__ __forceinline__ int operator()(int c) const { return c; } };
struct MapGU { __device__ __forceinline__ int operator()(int c) const { const int j = c >> 1, up = c & 1; return ((j >> 7) << 8) + (up << 7) + (j & 127); } };
struct MapIn { __device__ __forceinline__ int operator()(int c) const {
    if (c < 768) return c;
    if (c < 772) return 5504 + (c - 768);
    if (c < 1028) return 1536 + (c - 772);
    if (c < 1284) return 1792 + (c - 1028);
    if (c < 1300) return -1;
    if (c < 1556) return 2048 + (c - 1300);
    if (c < 2324) return 768 + (c - 1556);
    return 2304 + (c - 2324);
} };
template <class RowMap>
__device__ __forceinline__ void transpose_item(const float* W, int K, int N, bf16* WT, LAS float* scr, int item, int lane, RowMap rm, int ldk = 0) {
    if (ldk == 0) ldk = K;
    const int nblk = (N + 31) / 32, kb = item / nblk, nb = item % nblk, k0 = 64 * kb, n0 = 32 * nb;
    const int nn = n0 + (lane & 31);
#pragma unroll 16
    for (int i = 0; i < 32; ++i) { const int kk = 2 * i + (lane >> 5); scr[kk * 33 + (lane & 31)] = nn < N ? W[(size_t)(k0 + kk) * N + nn] : 0.f; }
    asm volatile("s_waitcnt lgkmcnt(0)" ::: "memory");
    const int c = lane & 7;
#pragma unroll
    for (int j = 0; j < 4; ++j) { const int n = (lane >> 3) + 8 * j; const LAS float* s = scr + (8 * c) * 33 + n;
        const int row = (n0 + n < N) ? rm(n0 + n) : -1;
        if (row >= 0) { u32x4 o; o.x = cvt_pk_bf16(s[0 * 33], s[1 * 33]); o.y = cvt_pk_bf16(s[2 * 33], s[3 * 33]); o.z = cvt_pk_bf16(s[4 * 33], s[5 * 33]); o.w = cvt_pk_bf16(s[6 * 33], s[7 * 33]);
            *(u32x4*)(WT + (size_t)row * ldk + k0 + 8 * c) = o; } }
    asm volatile("s_waitcnt lgkmcnt(0)" ::: "memory");
}

struct Args { const float* in[18]; float* out; unsigned char* ws; int ph_lo, ph_hi; };

#define CAS __attribute__((address_space(4)))
#define KARG_IN(kp, i) (*(const float* const CAS*)((kp) + 8 * (i)))
#define KARG_OUT(kp) (*(float* const CAS*)((kp) + 144))
#define KARG_WS(kp) (*(unsigned char* const CAS*)((kp) + 152))
__device__ __forceinline__ void p0_prologue(const CAS unsigned char* kp, LAS unsigned char* lds, int vcu, int G, int tid) {
    const int lane = tid & 63, wave = tid >> 6;
    LAS float* scr = (LAS float*)(lds + wave * 16384);
    unsigned char* ws = KARG_WS(kp);
    const int gw = vcu * 8 + wave, NGW = G * 8;
    constexpr int I_IN = 16 * 169, I_BR = 4 * 32, I_OUT = 16 * 32, I_GU = 16 * 64, I_DN = 16 * 32;
    constexpr int PER_L = I_IN + 3 * I_BR + I_OUT + 32 * I_GU + 32 * I_DN;
    for (int it = gw; it < DEPTH * PER_L; it += NGW) {
        const int l = it / PER_L; int r = it % PER_L;
        if (r < I_IN) { transpose_item(KARG_IN(kp, 1) + (size_t)l * 1024 * D_IN, 1024, D_IN, (bf16*)(ws + WS_WIN) + (size_t)l * NIN * 1024, scr, r, lane, MapIn()); continue; } r -= I_IN;
        if (r < 3 * I_BR) { const int nb = r / I_BR; transpose_item(KARG_IN(kp, 6) + ((size_t)l * 3 + nb) * 256 * 1024, 256, 1024, (bf16*)(ws + WS_WBP) + ((size_t)l * 3 + nb) * 1024 * 768 + nb * 256, scr, r % I_BR, lane, MapIdent(), 768); continue; } r -= 3 * I_BR;
        if (r < I_OUT) { transpose_item(KARG_IN(kp, 7) + (size_t)l * 1024 * 1024, 1024, 1024, (bf16*)(ws + WS_WOUT) + (size_t)l * 1024 * 1024, scr, r, lane, MapIdent()); continue; } r -= I_OUT;
        if (r < 32 * I_GU) { const int e = r / I_GU; transpose_item(KARG_IN(kp, 12) + ((size_t)l * 32 + e) * 1024 * 2048, 1024, 2048, (bf16*)(ws + WS_WGU) + ((size_t)l * 32 + e) * 2048 * 1024, scr, r % I_GU, lane, MapGU()); continue; } r -= 32 * I_GU;
        { const int e = r / I_DN; transpose_item(KARG_IN(kp, 14) + ((size_t)l * 32 + e) * 1024 * 1024, 1024, 1024, (bf16*)(ws + WS_WDN) + ((size_t)l * 32 + e) * 1024 * 1024, scr, r % I_DN, lane, MapIdent()); }
    }
    const int gt = vcu * 512 + tid, NT = G * 512;
    for (int i = gt; i < DEPTH * 128 * 1024; i += NT) { const int l = i >> 17, j = (i >> 10) & 127, k = i & 1023;
        const float* wr_ = KARG_IN(kp, 1) + ((size_t)l * 1024 + k) * D_IN + 1284; const float* au = KARG_IN(kp, 3) + (size_t)l * 16 * 128 + j; float s = 0.f;
#pragma unroll
        for (int r = 0; r < 16; ++r) s += wr_[r] * au[r * 128];
        ((bf16*)(ws + WS_WIN))[((size_t)l * NIN + 5376 + j) * 1024 + k] = (bf16)(cvt_pk_bf16(s, 0.f) & 0xffffu); }
    for (int i = gt; i < DEPTH * 124 * 1024 / 8; i += NT) { const int l = i / (124 * 128), rr = i % (124 * 128);
        *(u32x4*)((bf16*)(ws + WS_WIN) + ((size_t)l * NIN + 5508) * 1024 + (size_t)rr * 8) = (u32x4){0u, 0u, 0u, 0u}; }
    for (int i = gt; i < DEPTH * 3 * 1024 * 2 * 32; i += NT) { const int ch = i & 31, kbsel = (i >> 5) & 1, d = (i >> 6) & 1023, lnb = i >> 16; const int nb = lnb % 3; const int kb = kbsel + (kbsel >= nb ? 1 : 0);
        *(u32x4*)((bf16*)(ws + WS_WBP) + ((size_t)lnb * 1024 + d) * 768 + kb * 256 + ch * 8) = (u32x4){0u, 0u, 0u, 0u}; }
    for (int i = gt; i < S * D / 8; i += NT) { const f32x4 v0 = *(const f32x4*)(KARG_IN(kp, 0) + (size_t)i * 8), v1 = *(const f32x4*)(KARG_IN(kp, 0) + (size_t)i * 8 + 4);
        u32x4 o; o.x = cvt_pk_bf16(v0[0], v0[1]); o.y = cvt_pk_bf16(v0[2], v0[3]); o.z = cvt_pk_bf16(v1[0], v1[1]); o.w = cvt_pk_bf16(v1[2], v1[3]);
        *(u32x4*)((bf16*)(ws + WS_XB) + (size_t)i * 8) = o; }
}

__device__ __forceinline__ void gla_local_unit(LAS unsigned char* lds, int tid, int ci, int h, const bf16* GQK, const bf16* GV, const float* LAp, float* U, float* DEC) {
    LAS float* kb = (LAS float*)lds;
    LAS float* vb = kb + 64 * 33;
    LAS float* bb = vb + 64 * 64;
    const int t0 = ci * 64; const int r = tid >> 3;
    { const int c4 = (tid & 7) * 4; const u32x2 w = *(const u32x2*)(GQK + (size_t)(t0 + r) * 256 + 128 + h * 32 + c4);
      kb[r * 33 + c4 + 0] = bf_lo(w.x); kb[r * 33 + c4 + 1] = bf_hi(w.x); kb[r * 33 + c4 + 2] = bf_lo(w.y); kb[r * 33 + c4 + 3] = bf_hi(w.y);
      const f32x4 a = *(const f32x4*)(LAp + (size_t)(t0 + r) * 128 + h * 32 + c4); *(LAS f32x4*)(bb + r * 32 + c4) = a; }
    { const int c8 = (tid & 7) * 8; const u32x4 w = *(const u32x4*)(GV + (size_t)(t0 + r) * 256 + h * 64 + c8);
      *(LAS f32x4*)(vb + r * 64 + c8) = (f32x4){bf_lo(w.x), bf_hi(w.x), bf_lo(w.y), bf_hi(w.y)}; *(LAS f32x4*)(vb + r * 64 + c8 + 4) = (f32x4){bf_lo(w.z), bf_hi(w.z), bf_lo(w.w), bf_hi(w.w)}; }
    __syncthreads();
    if (tid < 32) { float run = 0.f; for (int c = 0; c < 64; ++c) { run += bb[c * 32 + tid]; bb[c * 32 + tid] = run; } }
    __syncthreads();
    for (int idx = tid; idx < 2048; idx += 512) { const int c = idx >> 5, k = idx & 31; kb[c * 33 + k] *= __expf(bb[63 * 32 + k] - bb[c * 32 + k]); }
    __syncthreads();
    { const int k = tid >> 4, v0 = (tid & 15) * 4; f32x4 acc = (f32x4){0.f, 0.f, 0.f, 0.f};
#pragma unroll 8
      for (int c = 0; c < 64; ++c) { const float kk = kb[c * 33 + k]; const f32x4 vv = *(const LAS f32x4*)(vb + c * 64 + v0); acc += vv * kk; }
      *(f32x4*)(U + ((size_t)(ci * 4 + h) * 32 + k) * 64 + v0) = acc; }
    if (tid < 32) DEC[(ci * 4 + h) * 32 + tid] = __expf(bb[63 * 32 + tid]);
    __syncthreads();
}
__device__ __forceinline__ void gla_out_unit(LAS unsigned char* lds, int tid, int ci, int h, const bf16* GQK, const bf16* GV, const bf16* GR, const float* LAp, const float* SST, const float* ng, bf16* Y) {
    LAS float* qb = (LAS float*)lds;
    LAS float* kb = qb + 64 * 33;
    LAS float* vb = kb + 64 * 33;
    LAS float* bb = vb + 64 * 64;
    LAS float* Ab = bb + 64 * 32;
    LAS float* Sb = Ab + 64 * 65;
    const int t0 = ci * 64; const int r = tid >> 3;
    { const int c4 = (tid & 7) * 4; const u32x2 wq = *(const u32x2*)(GQK + (size_t)(t0 + r) * 256 + h * 32 + c4); const u32x2 wk = *(const u32x2*)(GQK + (size_t)(t0 + r) * 256 + 128 + h * 32 + c4);
      qb[r * 33 + c4 + 0] = bf_lo(wq.x); qb[r * 33 + c4 + 1] = bf_hi(wq.x); qb[r * 33 + c4 + 2] = bf_lo(wq.y); qb[r * 33 + c4 + 3] = bf_hi(wq.y);
      kb[r * 33 + c4 + 0] = bf_lo(wk.x); kb[r * 33 + c4 + 1] = bf_hi(wk.x); kb[r * 33 + c4 + 2] = bf_lo(wk.y); kb[r * 33 + c4 + 3] = bf_hi(wk.y);
      const f32x4 a = *(const f32x4*)(LAp + (size_t)(t0 + r) * 128 + h * 32 + c4); *(LAS f32x4*)(bb + r * 32 + c4) = a; }
    { const int c8 = (tid & 7) * 8; const u32x4 w = *(const u32x4*)(GV + (size_t)(t0 + r) * 256 + h * 64 + c8);
      *(LAS f32x4*)(vb + r * 64 + c8) = (f32x4){bf_lo(w.x), bf_hi(w.x), bf_lo(w.y), bf_hi(w.y)}; *(LAS f32x4*)(vb + r * 64 + c8 + 4) = (f32x4){bf_lo(w.z), bf_hi(w.z), bf_lo(w.w), bf_hi(w.w)}; }
    { const f32x4 s4 = *(const f32x4*)(SST + (size_t)(ci * 4 + h) * 2048 + tid * 4); *(LAS f32x4*)(Sb + tid * 4) = s4; }
    __syncthreads();
    if (tid < 32) { float run = 0.f; for (int c = 0; c < 64; ++c) { run += bb[c * 32 + tid]; bb[c * 32 + tid] = run; } }
    __syncthreads();
    for (int idx = tid; idx < 2048; idx += 512) { const int c = idx >> 5, k = idx & 31; const float b = bb[c * 32 + k];
        qb[c * 33 + k] *= 0.17677669529663687f * __expf(b); kb[c * 33 + k] *= __expf(-b); }
    __syncthreads();
    { const int t = tid >> 3, s0 = (tid & 7) * 8; float a[8];
#pragma unroll
      for (int i = 0; i < 8; ++i) a[i] = 0.f;
      for (int k = 0; k < 32; ++k) { const float qv = qb[t * 33 + k];
#pragma unroll
          for (int i = 0; i < 8; ++i) a[i] += qv * kb[(s0 + i) * 33 + k]; }
#pragma unroll
      for (int i = 0; i < 8; ++i) Ab[t * 65 + s0 + i] = (s0 + i <= t) ? a[i] : 0.f; }
    __syncthreads();
    { const int t = tid >> 3, v0 = (tid & 7) * 8; f32x4 o0 = (f32x4){0.f, 0.f, 0.f, 0.f}, o1 = o0;
      for (int s = 0; s < 64; ++s) { const float av = Ab[t * 65 + s]; o0 += *(const LAS f32x4*)(vb + s * 64 + v0) * av; o1 += *(const LAS f32x4*)(vb + s * 64 + v0 + 4) * av; }
      for (int k = 0; k < 32; ++k) { const float qv = qb[t * 33 + k]; o0 += *(const LAS f32x4*)(Sb + k * 64 + v0) * qv; o1 += *(const LAS f32x4*)(Sb + k * 64 + v0 + 4) * qv; }
      float ss = o0[0] * o0[0] + o0[1] * o0[1] + o0[2] * o0[2] + o0[3] * o0[3] + o1[0] * o1[0] + o1[1] * o1[1] + o1[2] * o1[2] + o1[3] * o1[3];
      ss += __shfl_xor(ss, 1); ss += __shfl_xor(ss, 2); ss += __shfl_xor(ss, 4);
      const float rinv = 1.0f / sqrtf(ss * (1.f / 64.f) + RMS_EPS);
      const size_t tok = (size_t)(t0 + t); const u32x4 gw = *(const u32x4*)(GR + tok * 256 + h * 64 + v0);
      const f32x4 g0 = *(const f32x4*)(ng + h * 64 + v0), g1 = *(const f32x4*)(ng + h * 64 + v0 + 4);
      float gr[8] = {bf_lo(gw.x), bf_hi(gw.x), bf_lo(gw.y), bf_hi(gw.y), bf_lo(gw.z), bf_hi(gw.z), bf_lo(gw.w), bf_hi(gw.w)}; float y[8];
#pragma unroll
      for (int i = 0; i < 4; ++i) { y[i] = o0[i] * rinv * g0[i] * (gr[i] * sigmoidf_(gr[i])); y[4 + i] = o1[i] * rinv * g1[i] * (gr[4 + i] * sigmoidf_(gr[4 + i])); }
      u32x4 w; w.x = cvt_pk_bf16(y[0], y[1]); w.y = cvt_pk_bf16(y[2], y[3]); w.z = cvt_pk_bf16(y[4], y[5]); w.w = cvt_pk_bf16(y[6], y[7]);
      *(u32x4*)(Y + tok * 768 + h * 64 + v0) = w; }
    __syncthreads();
}

__device__ __forceinline__ void soft_update(float& m, float& l, float (&o)[16], float s, bool valid, const float (&v)[16]) {
    if (valid && s > m) { const float corr = fast_exp2(m - s); l *= corr;
#pragma unroll
        for (int d = 0; d < 16; ++d) o[d] *= corr;
        m = s; }
    const float p = valid ? fast_exp2(s - m) : 0.f; l += p;
#pragma unroll
    for (int d = 0; d < 16; ++d) o[d] += p * v[d];
}
__device__ __forceinline__ void load16(const bf16* p, float (&v)[16]) {
    const u32x4 a = *(const u32x4*)p, b = *(const u32x4*)(p + 8);
    v[0] = bf_lo(a.x); v[1] = bf_hi(a.x); v[2] = bf_lo(a.y); v[3] = bf_hi(a.y); v[4] = bf_lo(a.z); v[5] = bf_hi(a.z); v[6] = bf_lo(a.w); v[7] = bf_hi(a.w);
    v[8] = bf_lo(b.x); v[9] = bf_hi(b.x); v[10] = bf_lo(b.y); v[11] = bf_hi(b.y); v[12] = bf_lo(b.z); v[13] = bf_hi(b.z); v[14] = bf_lo(b.w); v[15] = bf_hi(b.w);
}
__device__ __forceinline__ void store16(bf16* p, const float (&o)[16], float sc) {
    u32x4 a, b; a.x = cvt_pk_bf16(o[0] * sc, o[1] * sc); a.y = cvt_pk_bf16(o[2] * sc, o[3] * sc); a.z = cvt_pk_bf16(o[4] * sc, o[5] * sc); a.w = cvt_pk_bf16(o[6] * sc, o[7] * sc);
    b.x = cvt_pk_bf16(o[8] * sc, o[9] * sc); b.y = cvt_pk_bf16(o[10] * sc, o[11] * sc); b.z = cvt_pk_bf16(o[12] * sc, o[13] * sc); b.w = cvt_pk_bf16(o[14] * sc, o[15] * sc);
    *(u32x4*)p = a; *(u32x4*)(p + 8) = b;
}
__device__ __forceinline__ void fox_naive_unit(LAS unsigned char* lds, int tid, int h, int qb, const bf16* FQ, const bf16* FK, const bf16* FV, const float* CF, bf16* Y) {
    LAS float* Ks = (LAS float*)lds;
    LAS float* Vs = Ks + 4096;
    LAS float* cks = Vs + 4096;
    const int ql = tid >> 2, part = tid & 3, t = qb * 128 + ql;
    float q[16], o[16], m = -INFINITY, l = 0.f;
    load16(FQ + (size_t)t * 256 + h * 64 + part * 16, q);
#pragma unroll
    for (int d = 0; d < 16; ++d) o[d] = 0.f;
    const float cq = CF[(size_t)h * S + t];
    const int NT = (qb * 128 + 128) / 64;
    for (int kt = 0; kt < NT; ++kt) {
        __syncthreads();
        { const int r = tid >> 3, c8 = (tid & 7) * 8; const size_t off = (size_t)(kt * 64 + r) * 256 + h * 64 + c8;
          const u32x4 wk = *(const u32x4*)(FK + off), wv = *(const u32x4*)(FV + off);
          *(LAS f32x4*)(Ks + r * 64 + c8) = (f32x4){bf_lo(wk.x), bf_hi(wk.x), bf_lo(wk.y), bf_hi(wk.y)}; *(LAS f32x4*)(Ks + r * 64 + c8 + 4) = (f32x4){bf_lo(wk.z), bf_hi(wk.z), bf_lo(wk.w), bf_hi(wk.w)};
          *(LAS f32x4*)(Vs + r * 64 + c8) = (f32x4){bf_lo(wv.x), bf_hi(wv.x), bf_lo(wv.y), bf_hi(wv.y)}; *(LAS f32x4*)(Vs + r * 64 + c8 + 4) = (f32x4){bf_lo(wv.z), bf_hi(wv.z), bf_lo(wv.w), bf_hi(wv.w)};
          if (tid < 64) cks[tid] = CF[(size_t)h * S + kt * 64 + tid]; }
        __syncthreads();
        for (int j = 0; j < 64; ++j) {
            float kv[16], vv[16];
#pragma unroll
            for (int d4 = 0; d4 < 4; ++d4) { const f32x4 a = *(const LAS f32x4*)(Ks + j * 64 + part * 16 + d4 * 4); kv[d4 * 4] = a[0]; kv[d4 * 4 + 1] = a[1]; kv[d4 * 4 + 2] = a[2]; kv[d4 * 4 + 3] = a[3];
                const f32x4 b = *(const LAS f32x4*)(Vs + j * 64 + part * 16 + d4 * 4); vv[d4 * 4] = b[0]; vv[d4 * 4 + 1] = b[1]; vv[d4 * 4 + 2] = b[2]; vv[d4 * 4 + 3] = b[3]; }
            float s = 0.f;
#pragma unroll
            for (int d = 0; d < 16; ++d) s += q[d] * kv[d];
            s += __shfl_xor(s, 1); s += __shfl_xor(s, 2);
            s += cq - cks[j];
            soft_update(m, l, o, s, (kt * 64 + j) <= t, vv);
        }
    }
    store16(Y + (size_t)t * 768 + h * 64 + part * 16, o, 1.f / l);
    __syncthreads();
}
__device__ __forceinline__ void moba_naive_unit(int tid, int h, int tb, const bf16* MQ, const bf16* MK, const bf16* MV, const int* SEL, bf16* Y) {
    const int tl = tid >> 2, part = tid & 3, t = tb * 128 + tl, own = (tb * 128) >> 8, nsel = own < 3 ? own : 3;
    float q[16], o[16], m = -INFINITY, l = 0.f;
    load16(MQ + (size_t)t * 256 + h * 64 + part * 16, q);
#pragma unroll
    for (int d = 0; d < 16; ++d) o[d] = 0.f;
    for (int sg = 0; sg <= nsel; ++sg) {
        const int blk = (sg < nsel) ? SEL[((size_t)t * 4 + h) * 4 + sg] : own;
        const int nk = (sg < nsel) ? 256 : (tb * 128 + 128 - own * 256);
        for (int j = 0; j < nk; ++j) { const int key = blk * 256 + j; float kv[16], vv[16];
            load16(MK + (size_t)key * 256 + h * 64 + part * 16, kv); load16(MV + (size_t)key * 256 + h * 64 + part * 16, vv);
            float s = 0.f;
#pragma unroll
            for (int d = 0; d < 16; ++d) s += q[d] * kv[d];
            s += __shfl_xor(s, 1); s += __shfl_xor(s, 2);
            soft_update(m, l, o, s, key <= t, vv); }
    }
    store16(Y + (size_t)t * 768 + h * 64 + part * 16, o, 1.f / l);
}


namespace attn {
using s16x4 = __attribute__((ext_vector_type(4))) short;
using f32x16 = __attribute__((ext_vector_type(16))) float;
constexpr int DM = 256;
constexpr int NW = 8, QBLK = 32, KVBLK = 64;
constexpr int NSLOT = 3, SLOTB = 8192;
constexpr int LDS_K = 0, LDS_V = NSLOT * SLOTB, LDS_WS = 2 * NSLOT * SLOTB, LDS_OST = LDS_WS + NW * 64 * 4, LDS_CK = LDS_OST + NW * 4096, LDS_ENT = LDS_CK + 8192, LDS_BYTES = LDS_ENT + NW * 128;
__device__ __forceinline__ int crow(int r, int hi) { return (r & 3) + 8 * (r >> 2) + 4 * hi; }
#define SBAR() __builtin_amdgcn_sched_barrier(0)
__device__ __forceinline__ void cmask(f32x16& p0, f32x16& p1, int jb, int qrel, int hi) {
  const float NEG = -INFINITY; int kb = 64 * jb + 4 * hi;
#pragma unroll
  for (int r = 0; r < 16; ++r) { int kv = kb + (r & 3) + 8 * (r >> 2); if (kv > qrel) p0[r] = NEG; if (kv + 32 > qrel) p1[r] = NEG; }
}
__device__ __forceinline__ void glds16(const void* gbase, unsigned voff, unsigned lds_dst) { unsigned keep;
  asm volatile("s_mov_b32 %0, m0\n\ts_mov_b32 m0, %3\n\ts_nop 0\n\tglobal_load_lds_dwordx4 %1, %2\n\ts_mov_b32 m0, %0" : "=&s"(keep) : "v"(voff), "s"(gbase), "s"(lds_dst) : "memory"); }
__device__ __forceinline__ float max3f(float a, float b, float c) { float r; asm("v_max3_f32 %0, %1, %2, %3" : "=v"(r) : "v"(a), "v"(b), "v"(c)); return r; }
__device__ __forceinline__ float max2f(float a, float b) { float r; asm("v_max_f32_e32 %0, %1, %2" : "=v"(r) : "v"(a), "v"(b)); return r; }
__device__ __forceinline__ float fadd_s(float a, float b) { float r; asm("v_add_f32_e32 %0, %1, %2" : "=v"(r) : "v"(a), "v"(b)); return r; }
__device__ __forceinline__ float fsub_s(float a, float b) { float r; asm("v_sub_f32_e32 %0, %1, %2" : "=v"(r) : "v"(a), "v"(b)); return r; }
__device__ __forceinline__ unsigned cvtpk_s(float lo, float hi) { f32x2 v = {lo, hi}; bf16x2_t b = __builtin_convertvector(v, bf16x2_t); return __builtin_bit_cast(unsigned, b); }
#define WAIT_BAR(N) asm volatile("s_waitcnt vmcnt(" #N ") lgkmcnt(0)\n\ts_barrier" ::: "memory")
typedef __attribute__((address_space(3))) const char* lds_cptr;
typedef short v4i16_t __attribute__((ext_vector_type(4)));
__device__ __forceinline__ void qkt(f32x16& p0, f32x16& p1, const char* Kslot, const bf16x8* qr, int r32, int hi) {
  const char* kb = Kslot + hi * 1024 + r32 * 16;
#pragma unroll
  for (int d0 = 0; d0 < 4; ++d0) {
    const bf16x8 b0 = *reinterpret_cast<const bf16x8*>(kb + d0 * 2048);
    const bf16x8 b1 = *reinterpret_cast<const bf16x8*>(kb + d0 * 2048 + 512);
    p0 = __builtin_amdgcn_mfma_f32_32x32x16_bf16(b0, qr[d0], p0, 0, 0, 0); p1 = __builtin_amdgcn_mfma_f32_32x32x16_bf16(b1, qr[d0], p1, 0, 0, 0); }
}
__device__ __forceinline__ void kload8(bf16x8* kf, lds_cptr kp) {
  kf[0] = *(const LAS bf16x8*)(kp);        kf[1] = *(const LAS bf16x8*)(kp + 512);
  kf[2] = *(const LAS bf16x8*)(kp + 2048); kf[3] = *(const LAS bf16x8*)(kp + 2560);
  kf[4] = *(const LAS bf16x8*)(kp + 4096); kf[5] = *(const LAS bf16x8*)(kp + 4608);
  kf[6] = *(const LAS bf16x8*)(kp + 6144); kf[7] = *(const LAS bf16x8*)(kp + 6656);
}
__device__ __forceinline__ void kload2(bf16x8* kf, lds_cptr kp, int j) { kf[2 * j] = *(const LAS bf16x8*)(kp + j * 2048); kf[2 * j + 1] = *(const LAS bf16x8*)(kp + j * 2048 + 512); }
__device__ __forceinline__ s16x4 vtr(lds_cptr p) { return __builtin_bit_cast(s16x4, __builtin_amdgcn_ds_read_tr16_b64_v4i16((LAS v4i16_t*)p)); }
__device__ __forceinline__ float rowmax(const f32x16& p0, const f32x16& p1) {
  float a = max3f(p0[0], p0[1], p1[0]), b = max3f(p0[2], p0[3], p1[1]); a = max3f(a, p1[2], p1[3]);
#pragma unroll
  for (int r = 4; r < 16; r += 4) { a = max3f(a, p0[r], p0[r + 1]); b = max3f(b, p0[r + 2], p0[r + 3]); a = max3f(a, p1[r], p1[r + 1]); b = max3f(b, p1[r + 2], p1[r + 3]); }
  const float m = max2f(a, b);
  auto rr = __builtin_amdgcn_permlane32_swap(__float_as_uint(m), __float_as_uint(m), false, false);
  return max2f(__uint_as_float(rr[0]), __uint_as_float(rr[1]));
}
__device__ __forceinline__ void pv(f32x16* o, int vb, bf16x8 pa0, bf16x8 pa1, bf16x8 pa2, bf16x8 pa3) {
#pragma unroll
  for (int d0 = 0; d0 < 2; ++d0) { s16x4 lo[4], hi[4];
#pragma unroll
    for (int ks = 0; ks < 4; ++ks) {
      asm volatile("ds_read_b64_tr_b16 %0,%1 offset:%c2" : "=&v"(lo[ks]) : "v"(vb), "i"(d0 * 4096 + ks * 1024) : "memory");
      asm volatile("ds_read_b64_tr_b16 %0,%1 offset:%c2" : "=&v"(hi[ks]) : "v"(vb), "i"(d0 * 4096 + ks * 1024 + 512) : "memory"); }
    asm volatile("s_waitcnt lgkmcnt(0)" ::: "memory"); SBAR();
#define PK(k) (bf16x8){lo[k][0], lo[k][1], lo[k][2], lo[k][3], hi[k][0], hi[k][1], hi[k][2], hi[k][3]}
    o[d0] = __builtin_amdgcn_mfma_f32_32x32x16_bf16(pa0, PK(0), o[d0], 0, 0, 0);
    o[d0] = __builtin_amdgcn_mfma_f32_32x32x16_bf16(pa1, PK(1), o[d0], 0, 0, 0);
    o[d0] = __builtin_amdgcn_mfma_f32_32x32x16_bf16(pa2, PK(2), o[d0], 0, 0, 0);
    o[d0] = __builtin_amdgcn_mfma_f32_32x32x16_bf16(pa3, PK(3), o[d0], 0, 0, 0);
#undef PK
  }
}

template <int THRL> __device__ __forceinline__ void attn_unit(const bf16* Qrow, const bf16* __restrict__ Kh, const bf16* __restrict__ Vh, const int NT, const bool band,
                                                             const float cq, const float* ckg, const int dest, bf16* PO, float* LSEp, char* shm, const int tid) {
  const int lane = tid & 63, r32 = lane & 31, hi = lane >> 5; const int wid = __builtin_amdgcn_readfirstlane(tid >> 6);
  const unsigned lds0 = (unsigned)(uintptr_t)shm;
  float* wsf = (float*)(shm + LDS_WS) + wid * 64;
  f32x4 ckv = (f32x4){0.f, 0.f, 0.f, 0.f};
  if (ckg && tid * 4 < NT * 64) ckv = *(const f32x4*)(ckg + tid * 4);
  const unsigned koff = (unsigned)(lane * DM + wid * 8) * 2u;
  const unsigned voff = (unsigned)((16 * (wid & 3) + (lane >> 2)) * DM + (wid >> 2) * 32 + (lane & 3) * 8) * 2u;
  const unsigned kdst = lds0 + LDS_K + wid * 1024, vdst = lds0 + LDS_V + wid * 1024;
#define DMA_K(t, slot) glds16(Kh + (long)(t) * KVBLK * DM, koff, (unsigned)__builtin_amdgcn_readfirstlane(kdst + (slot)))
#define DMA_V(t, slot) glds16(Vh + (long)(t) * KVBLK * DM, voff, (unsigned)__builtin_amdgcn_readfirstlane(vdst + (slot)))
  const int vb0 = (int)(lds0 + LDS_V) + ((lane >> 4) & 1) * 32 + (lane & 3) * 8 + (4 * hi + ((lane & 15) >> 2)) * 64;
  const char* Kbase = shm + LDS_K; bf16x8 kf[8];
  const lds_cptr shm3 = (lds_cptr)shm; const lds_cptr kp0 = shm3 + LDS_K + hi * 1024 + r32 * 16; const lds_cptr vp0 = shm3 + LDS_V + ((lane >> 4) & 1) * 32 + (lane & 3) * 8 + (4 * hi + ((lane & 15) >> 2)) * 64;
  const LAS f32x4* ck4 = (const LAS f32x4*)(shm3 + LDS_CK) + hi;
  DMA_K(0, 0); DMA_V(0, 0); DMA_K(1, SLOTB);
  bf16x8 qr[4];
#pragma unroll
  for (int d0 = 0; d0 < 4; ++d0) qr[d0] = *reinterpret_cast<const bf16x8*>(&Qrow[d0 * 16 + hi * 8]);
  *(LAS f32x4*)((LAS char*)shm3 + LDS_CK + tid * 16) = ckv;
  if (hi == 0) *(LAS int*)((LAS char*)shm3 + LDS_ENT + wid * 128 + r32 * 4) = dest;
  float mhat = 0.f, l_reg = 0.f, nb = cq; f32x16 o[2]; o[0] = f32x16{}; o[1] = f32x16{};
  const int qrel = wid * QBLK + r32;
#define CMASK(P0, P1, t) do { int jb_ = (t) - (NT - 4); if (band && jb_ >= 0) cmask(P0, P1, jb_, qrel, hi); } while (0)
#define BINIT(P0, P1, t) do { _Pragma("unroll") for (int g_ = 0; g_ < 4; ++g_) { const f32x4 a_ = ck4[16 * (t) + 2 * g_], b_ = ck4[16 * (t) + 8 + 2 * g_]; \
      _Pragma("unroll") for (int i_ = 0; i_ < 4; ++i_) { P0[4 * g_ + i_] = nb - a_[i_]; P1[4 * g_ + i_] = nb - b_[i_]; } } } while (0)
  bool resc = false;
#define START(P0, P1) do { const float rm = rowmax(P0, P1); resc = false; \
    { const float dl = rm; mhat = fadd_s(mhat, dl); nb = fsub_s(nb, dl); \
      _Pragma("unroll") for (int r = 0; r < 16; ++r) { P0[r] = fsub_s(P0[r], dl); P1[r] = fsub_s(P1[r], dl); } } \
    _Pragma("unroll") for (int r = 0; r < 16; ++r) P0[r] = __builtin_amdgcn_exp2f(P0[r]); } while (0)
#define RESC() do { if (resc) { asm volatile("s_waitcnt lgkmcnt(0)" ::: "memory"); \
      _Pragma("unroll") for (int d_ = 0; d_ < 2; ++d_) _Pragma("unroll") for (int r = 0; r < 16; ++r) o[d_][r] *= wsf[crow(r, hi)]; } } while (0)
  f32x16 pA0, pA1, pB0, pB1;
  int sl_prev = 0, sl_cur = 0, sl_next = SLOTB;
#define ROT() do { sl_prev = sl_cur; sl_cur = sl_next; sl_next = (sl_next == (NSLOT - 1) * SLOTB) ? 0 : sl_next + SLOTB; } while (0)
  DMA_K(2, 2 * SLOTB);
  WAIT_BAR(3);
  BINIT(pA0, pA1, 0);
  qkt(pA0, pA1, Kbase, qr, r32, hi); asm volatile("s_nop 15\n\ts_nop 7" : "+v"(pA0), "+v"(pA1)); CMASK(pA0, pA1, 0);
  START(pA0, pA1);
  _Pragma("unroll") for (int r = 0; r < 16; ++r) pA1[r] = __builtin_amdgcn_exp2f(pA1[r]);
  BINIT(pB0, pB1, 1);
  WAIT_BAR(0);
  DMA_K(3, 0); DMA_V(1, SLOTB);
  ROT();
  kload8(kf, kp0 + sl_cur);
  WAIT_BAR(2);
  s16x4 vlo[8], vhi[8]; u32x4 pw0, pw1, pw2, pw3;
#define PKW(P, B) cvtpk_s(P[B], P[B + 1])
#define PAF(k) __builtin_bit_cast(bf16x8, pw##k)
#define VFR(i) (bf16x8){vlo[i][0], vlo[i][1], vlo[i][2], vlo[i][3], vhi[i][0], vhi[i][1], vhi[i][2], vhi[i][3]}
#define PIN(x) asm volatile("" : "+v"(x))
#define MX3(a, b, c) __builtin_fmaxf(__builtin_fmaxf((a), (b)), (c))
#define GAPA(MF, A0, A1, A2, A3, W0, W1, PW) do { MF; sacc += A0; sacc += A1; sacc += A2; sacc += A3; PIN(sacc); W0; W1; PIN(PW); SBAR(); } while (0)
#define EX(v) __builtin_amdgcn_exp2f(v)
#define GAPB(MF, X, B) do { MF; X[B] = EX(X[B]); X[B + 1] = EX(X[B + 1]); X[B + 2] = EX(X[B + 2]); X[B + 3] = EX(X[B + 3]); PIN(X); SBAR(); } while (0)
#define VRD(i) do { vlo[i] = vtr(vp_ + (((i) >> 2) * 4096 + ((i) & 3) * 1024)); vhi[i] = vtr(vp_ + (((i) >> 2) * 4096 + ((i) & 3) * 1024 + 512)); } while (0)
#define KRD(G, j) do { if (G) { kload2(kf, kp0 + sl_next, j); SBAR(); } } while (0)
#define BRD(G, P0, P1, t, g) do { if (G) { const f32x4 a_ = ck4[16 * ((t) + 1) + 2 * (g)], b_ = ck4[16 * ((t) + 1) + 8 + 2 * (g)]; \
      P0[4 * (g)] = a_[0]; P0[4 * (g) + 1] = a_[1]; P0[4 * (g) + 2] = a_[2]; P0[4 * (g) + 3] = a_[3]; P1[4 * (g)] = b_[0]; P1[4 * (g) + 1] = b_[1]; P1[4 * (g) + 2] = b_[2]; P1[4 * (g) + 3] = b_[3]; SBAR(); } } while (0)
#define BSB(G, P0, P1) do { if (G) { _Pragma("unroll") for (int r = 0; r < 16; ++r) { P0[r] = nb - P0[r]; P1[r] = nb - P1[r]; } PIN(P0); PIN(P1); SBAR(); } } while (0)
#define STEP(C0, C1, P0, P1, t, GK, GV, GL) do { SBAR(); \
    const lds_cptr vp_ = vp0 + sl_prev; \
    VRD(0); SBAR(); float sacc = (P0[0] + P0[1]); \
    GAPA(C0 = __builtin_amdgcn_mfma_f32_32x32x16_bf16(kf[0], qr[0], C0, 0, 0, 0), P0[2], P0[3], P0[4], P0[5],     pw0[0] = PKW(P0, 0), pw0[1] = PKW(P0, 2), pw0); \
    VRD(4); SBAR(); GAPA(C1 = __builtin_amdgcn_mfma_f32_32x32x16_bf16(kf[1], qr[0], C1, 0, 0, 0), P0[6], P0[7], P0[8], P0[9],     pw0[2] = PKW(P0, 4), pw0[3] = PKW(P0, 6), pw0); \
    VRD(1); SBAR(); GAPA(C0 = __builtin_amdgcn_mfma_f32_32x32x16_bf16(kf[2], qr[1], C0, 0, 0, 0),   P0[10], P0[11], P0[12], P0[13], pw1[0] = PKW(P0, 8), pw1[1] = PKW(P0, 10), pw1); \
    VRD(5); SBAR(); GAPA(C1 = __builtin_amdgcn_mfma_f32_32x32x16_bf16(kf[3], qr[1], C1, 0, 0, 0),   P0[14], P0[15], P1[0], P1[1],   pw1[2] = PKW(P0, 12), pw1[3] = PKW(P0, 14), pw1); \
    VRD(2); SBAR(); GAPA(C0 = __builtin_amdgcn_mfma_f32_32x32x16_bf16(kf[4], qr[2], C0, 0, 0, 0),   P1[2], P1[3], P1[4], P1[5],     pw2[0] = PKW(P1, 0), pw2[1] = PKW(P1, 2), pw2); \
    VRD(6); SBAR(); GAPA(C1 = __builtin_amdgcn_mfma_f32_32x32x16_bf16(kf[5], qr[2], C1, 0, 0, 0),   P1[6], P1[7], P1[8], P1[9],     pw2[2] = PKW(P1, 4), pw2[3] = PKW(P1, 6), pw2); \
    VRD(3); SBAR(); GAPA(C0 = __builtin_amdgcn_mfma_f32_32x32x16_bf16(kf[6], qr[3], C0, 0, 0, 0),   P1[10], P1[11], P1[12], P1[13], pw3[0] = PKW(P1, 8), pw3[1] = PKW(P1, 10), pw3); \
    VRD(7); SBAR(); GAPA(C1 = __builtin_amdgcn_mfma_f32_32x32x16_bf16(kf[7], qr[3], C1, 0, 0, 0),   P1[14], P1[15], 0.f, 0.f,       pw3[2] = PKW(P1, 12), pw3[3] = PKW(P1, 14), pw3); \
    l_reg += sacc; \
    if (GK) { DMA_K((t) + 3, sl_cur); } if (GV) { DMA_V((t) + 1, sl_next); } \
    CMASK(C0, C1, t); \
    { float a = MX3(C0[0], C0[1], C1[0]), b = MX3(C0[2], C0[3], C1[1]); a = MX3(a, C1[2], C1[3]); \
      _Pragma("unroll") for (int r = 4; r < 16; r += 4) { a = MX3(a, C0[r], C0[r + 1]); b = MX3(b, C0[r + 2], C0[r + 3]); a = MX3(a, C1[r], C1[r + 1]); b = MX3(b, C1[r + 2], C1[r + 3]); } \
      float rm = __builtin_fmaxf(a, b); { auto rr = __builtin_amdgcn_permlane32_swap(__float_as_uint(rm), __float_as_uint(rm), false, false); rm = __builtin_fmaxf(__uint_as_float(rr[0]), __uint_as_float(rr[1])); } \
      resc = false; \
      if (__builtin_expect(__any(rm > (float)THRL), 0)) { const float dl = __builtin_fmaxf(rm, 0.f); mhat += dl; nb -= dl; \
        _Pragma("unroll") for (int r = 0; r < 16; ++r) { C0[r] -= dl; C1[r] -= dl; } \
        const float f = __builtin_amdgcn_exp2f(-dl); l_reg *= f; if (hi == 0) wsf[r32] = f; resc = true; } } \
    SBAR(); \
    BRD(GL, P0, P1, t, 0); BRD(GL, P0, P1, t, 1); \
    GAPB(o[0] = __builtin_amdgcn_mfma_f32_32x32x16_bf16(PAF(0), VFR(0), o[0], 0, 0, 0), C0, 0); \
    BRD(GL, P0, P1, t, 2); BRD(GL, P0, P1, t, 3); \
    GAPB(o[1] = __builtin_amdgcn_mfma_f32_32x32x16_bf16(PAF(0), VFR(4), o[1], 0, 0, 0), C0, 4); \
    KRD(GL, 0); GAPB(o[0] = __builtin_amdgcn_mfma_f32_32x32x16_bf16(PAF(1), VFR(1), o[0], 0, 0, 0), C0, 8); \
    KRD(GL, 1); GAPB(o[1] = __builtin_amdgcn_mfma_f32_32x32x16_bf16(PAF(1), VFR(5), o[1], 0, 0, 0), C0, 12); \
    KRD(GL, 2); GAPB(o[0] = __builtin_amdgcn_mfma_f32_32x32x16_bf16(PAF(2), VFR(2), o[0], 0, 0, 0), C1, 0); \
    KRD(GL, 3); GAPB(o[1] = __builtin_amdgcn_mfma_f32_32x32x16_bf16(PAF(2), VFR(6), o[1], 0, 0, 0), C1, 4); \
    GAPB(o[0] = __builtin_amdgcn_mfma_f32_32x32x16_bf16(PAF(3), VFR(3), o[0], 0, 0, 0), C1, 8); \
    GAPB(o[1] = __builtin_amdgcn_mfma_f32_32x32x16_bf16(PAF(3), VFR(7), o[1], 0, 0, 0), C1, 12); \
    BSB(GL, P0, P1); \
    } while (0)
  int t = 1;
#undef CMASK
#define CMASK(P0, P1, t) do {} while (0)
  for (; t + 5 < NT; t += 2) {
    STEP(pB0, pB1, pA0, pA1, t, true, true, true);     WAIT_BAR(2); RESC(); ROT();
    STEP(pA0, pA1, pB0, pB1, t + 1, true, true, true); WAIT_BAR(2); RESC(); ROT();
  }
#undef CMASK
#define CMASK(P0, P1, t) do { int jb_ = (t) - (NT - 4); if (band && jb_ >= 0) cmask(P0, P1, jb_, qrel, hi); } while (0)
#define ENDW(tt) do { if ((tt) + 3 < NT) { WAIT_BAR(2); } else if ((tt) + 2 < NT) { WAIT_BAR(1); } else { WAIT_BAR(0); } } while (0)
  for (; t + 1 < NT; t += 2) {
    STEP(pB0, pB1, pA0, pA1, t, (t + 3 < NT), (t + 1 < NT), (t + 1 < NT));         ENDW(t);     RESC(); ROT();
    STEP(pA0, pA1, pB0, pB1, t + 1, (t + 4 < NT), (t + 2 < NT), (t + 2 < NT));     ENDW(t + 1); RESC(); ROT();
  }
  STEP(pB0, pB1, pA0, pA1, NT - 1, false, false, false); RESC();
  { float sacc = pB0[0] + pB0[1]; _Pragma("unroll") for (int r = 2; r < 16; ++r) sacc += pB0[r]; _Pragma("unroll") for (int r = 0; r < 16; ++r) sacc += pB1[r]; l_reg += sacc;
    pw0 = (u32x4){PKW(pB0, 0), PKW(pB0, 2), PKW(pB0, 4), PKW(pB0, 6)}; pw1 = (u32x4){PKW(pB0, 8), PKW(pB0, 10), PKW(pB0, 12), PKW(pB0, 14)}; pw2 = (u32x4){PKW(pB1, 0), PKW(pB1, 2), PKW(pB1, 4), PKW(pB1, 6)}; pw3 = (u32x4){PKW(pB1, 8), PKW(pB1, 10), PKW(pB1, 12), PKW(pB1, 14)};
    SBAR(); pv(o, vb0 + sl_cur, PAF(0), PAF(1), PAF(2), PAF(3)); }
#undef PKW
#undef PAF
#undef VFR
#undef PIN
#undef MX3
#undef GAPA
#undef GAPB
#undef EX
#undef VRD
#undef KRD
#undef BRD
#undef BSB
#undef STEP
#undef ENDW
  { auto rr = __builtin_amdgcn_permlane32_swap(__float_as_uint(l_reg), __float_as_uint(l_reg), false, false); l_reg = __uint_as_float(rr[0]) + __uint_as_float(rr[1]); }
  if (hi == 0) { wsf[32 + r32] = l_reg; const int de0 = *(const LAS int*)((LAS char*)shm3 + LDS_ENT + wid * 128 + r32 * 4); if (de0 >= 0) LSEp[de0] = mhat + __builtin_amdgcn_logf(l_reg); }
  asm volatile("s_waitcnt lgkmcnt(0)" ::: "memory");
  float rli[16];
#pragma unroll
  for (int r = 0; r < 16; ++r) rli[r] = __builtin_amdgcn_rcpf(wsf[32 + crow(r, hi)]);
  { bf16* stg = (bf16*)(shm + LDS_OST) + wid * 2048;
#pragma unroll
    for (int r = 0; r < 16; ++r) { const int orow = crow(r, hi);
#pragma unroll
      for (int d0 = 0; d0 < 2; ++d0) stg[orow * 64 + d0 * 32 + r32] = (bf16)(cvtpk_s(o[d0][r] * rli[r], 0.f) & 0xffffu); }
    asm volatile("s_waitcnt lgkmcnt(0)" ::: "memory");
    const LAS int* ents = (const LAS int*)((LAS char*)shm3 + LDS_ENT + wid * 128);
#pragma unroll
    for (int i = 0; i < 4; ++i) { const int row = i * 8 + (lane >> 3), ch = lane & 7; const u32x4 v = *(const u32x4*)(stg + row * 64 + ch * 8); const int de = ents[row];
      if (de >= 0) *(u32x4*)(PO + (size_t)de * 64 + ch * 8) = v; } }
  asm volatile("s_waitcnt lgkmcnt(0)\n\ts_barrier" ::: "memory");
#undef DMA_K
#undef DMA_V
#undef CMASK
#undef BINIT
#undef START
#undef RESC
#undef ROT
}
#undef SBAR
#undef WAIT_BAR
}

__device__ __forceinline__ void moba_gate_batch(LAS unsigned char* lds, int tid, int b, const bf16* MQ, const float* KM, int* SEL, int* QL, unsigned* MCNT) {
    LAS float* km = (LAS float*)lds;
    LAS int* hist = (LAS int*)(lds + 65536);
    LAS int* base = hist + 256;
    const int own = (b * 128) >> 8, nsel = own < 3 ? own : 3;
    if (tid < 256) hist[tid] = 0;
    for (int i = tid; i < 4 * 64 * 16; i += 512) { const int hh = i >> 10, rem = i & 1023, j = rem >> 4; if (j < own) *(LAS f32x4*)(km + (size_t)i * 4) = *(const f32x4*)(KM + (size_t)i * 4); (void)hh; }
    __syncthreads();
    const int h = tid >> 7, tl = tid & 127, t = b * 128 + tl;
    int i0 = 0, i1 = 0, i2 = 0, r0 = 0, r1 = 0, r2 = 0;
    if (own > 0) {
        float q[64];
#pragma unroll
        for (int c = 0; c < 4; ++c) { float tmp[16]; load16(MQ + (size_t)t * 256 + h * 64 + c * 16, tmp);
#pragma unroll
            for (int d = 0; d < 16; ++d) q[c * 16 + d] = tmp[d]; }
        float v0 = -INFINITY, v1 = -INFINITY, v2 = -INFINITY;
        for (int n = 0; n < own; ++n) { const LAS float* kr = km + (h * 64 + n) * 64; float s = 0.f;
#pragma unroll
            for (int d4 = 0; d4 < 16; ++d4) { const f32x4 kk = *(const LAS f32x4*)(kr + d4 * 4); s += q[d4 * 4] * kk[0] + q[d4 * 4 + 1] * kk[1] + q[d4 * 4 + 2] * kk[2] + q[d4 * 4 + 3] * kk[3]; }
            if (s > v0) { v2 = v1; i2 = i1; v1 = v0; i1 = i0; v0 = s; i0 = n; }
            else if (s > v1) { v2 = v1; i2 = i1; v1 = s; i1 = n; }
            else if (s > v2) { v2 = s; i2 = n; } }
        if (nsel > 0) r0 = __hip_atomic_fetch_add(hist + h * 64 + i0, 1, __ATOMIC_RELAXED, __HIP_MEMORY_SCOPE_WORKGROUP);
        if (nsel > 1) r1 = __hip_atomic_fetch_add(hist + h * 64 + i1, 1, __ATOMIC_RELAXED, __HIP_MEMORY_SCOPE_WORKGROUP);
        if (nsel > 2) r2 = __hip_atomic_fetch_add(hist + h * 64 + i2, 1, __ATOMIC_RELAXED, __HIP_MEMORY_SCOPE_WORKGROUP);
        int* sp = SEL + ((size_t)t * 4 + h) * 4; sp[0] = i0; sp[1] = i1; sp[2] = i2;
    }
    __syncthreads();
    if (tid < 256) { const int c = hist[tid]; base[tid] = c > 0 ? (int)__hip_atomic_fetch_add(MCNT + tid, (unsigned)c, __ATOMIC_RELAXED, __HIP_MEMORY_SCOPE_AGENT) : 0; }
    __syncthreads();
    if (nsel > 0) QL[((size_t)h * 63 + i0) * 16384 + base[h * 64 + i0] + r0] = t * 4 + 0;
    if (nsel > 1) QL[((size_t)h * 63 + i1) * 16384 + base[h * 64 + i1] + r1] = t * 4 + 1;
    if (nsel > 2) QL[((size_t)h * 63 + i2) * 16384 + base[h * 64 + i2] + r2] = t * 4 + 2;
    __syncthreads();
}

__device__ __forceinline__ void moe_table(const unsigned* cntg, LAS int* tab, int tid) {
    if (tid < 64) { const int e = tid; const int c = e < 32 ? (int)__hip_atomic_load(cntg + e, __ATOMIC_RELAXED, __HIP_MEMORY_SCOPE_AGENT) : 0; const int nt = (c + 255) >> 8;
        int incl = nt;
#pragma unroll
        for (int o = 1; o < 64; o <<= 1) { const int y = __shfl_up(incl, o); if (e >= o) incl += y; }
        if (e < 32) { tab[e] = c; tab[32 + e] = incl - nt; }
        if (e == 31) { tab[64] = incl; tab[65] = incl; } }
    __syncthreads();
    const int ntl = tab[65];
    for (int m = tid; m < ntl; m += 512) { int e = 0;
        for (int j = 1; j < 32; ++j) if (tab[32 + j] <= m) e = j;
        tab[128 + m] = e; }
    __syncthreads();
}

__device__ __forceinline__ void ln1_router_block(LAS unsigned char* lds, int tid, int blk, const bf16* XB, const float* Y, const float* g1, const float* b1, const float* brt,
                                                 bf16* X1, unsigned* CNT, int* TOK, int* TE, int* TP, float* TG) {
    LAS float* WrT = (LAS float*)lds;
    LAS int* hist = (LAS int*)(lds + RT_OFF); LAS int* base = hist + 32; LAS int* sel_e = base + 32; LAS int* sel_r = sel_e + 256; LAS float* sel_g = (LAS float*)(sel_r + 256);
    LAS float* wsc = sel_g + 256;
    const int lane = tid & 63, wave = tid >> 6;
    if (tid < 32) hist[tid] = 0;
    __syncthreads();
    for (int rr = 0; rr < 8; ++rr) {
        const int tl = wave * 8 + rr; const size_t t = (size_t)blk * 64 + tl;
        f32x4 v[4]; float s = 0.f;
#pragma unroll
        for (int j = 0; j < 4; ++j) { const int c = 4 * lane + 256 * j; const f32x4 y = *(const f32x4*)(Y + t * 1024 + c); const u32x2 xw = *(const u32x2*)(XB + t * 1024 + c);
            v[j] = (f32x4){bf_lo(xw.x), bf_hi(xw.x), bf_lo(xw.y), bf_hi(xw.y)} * ALPHA + y; s += (v[j][0] + v[j][1]) + (v[j][2] + v[j][3]); }
        const float mean = wave_sum(s) * (1.f / 1024.f); float s2 = 0.f;
#pragma unroll
        for (int j = 0; j < 4; ++j) { v[j] = v[j] - mean; s2 += (v[j][0] * v[j][0] + v[j][1] * v[j][1]) + (v[j][2] * v[j][2] + v[j][3] * v[j][3]); }
        const float rstd = 1.f / sqrtf(wave_sum(s2) * (1.f / 1024.f) + LN_EPS);
#pragma unroll
        for (int j = 0; j < 4; ++j) { const int c = 4 * lane + 256 * j; const f32x4 g = *(const f32x4*)(g1 + c), b = *(const f32x4*)(b1 + c); v[j] = v[j] * rstd * g + b;
            u32x2 w; w.x = cvt_pk_bf16(v[j][0], v[j][1]); w.y = cvt_pk_bf16(v[j][2], v[j][3]); *(u32x2*)(X1 + t * 1024 + c) = w; }
        float a[32];
#pragma unroll
        for (int e = 0; e < 32; ++e) { float acc = 0.f;
#pragma unroll
            for (int j = 0; j < 4; ++j) { const f32x4 w = *(const LAS f32x4*)(WrT + e * 1024 + 256 * j + 4 * lane); acc += v[j][0] * w[0] + v[j][1] * w[1] + v[j][2] * w[2] + v[j][3] * w[3]; }
            a[e] = acc; }
        { float b16[16];
          { const bool up = (lane & 32) != 0;
#pragma unroll
            for (int i = 0; i < 16; ++i) { const float send = up ? a[i] : a[i + 16], keep = up ? a[i + 16] : a[i]; b16[i] = keep + __shfl_xor(send, 32); } }
          float b8[8];
          { const bool up = (lane & 16) != 0;
#pragma unroll
            for (int i = 0; i < 8; ++i) { const float send = up ? b16[i] : b16[i + 8], keep = up ? b16[i + 8] : b16[i]; b8[i] = keep + __shfl_xor(send, 16); } }
          float b4[4];
          { const bool up = (lane & 8) != 0;
#pragma unroll
            for (int i = 0; i < 4; ++i) { const float send = up ? b8[i] : b8[i + 4], keep = up ? b8[i + 4] : b8[i]; b4[i] = keep + __shfl_xor(send, 8); } }
          float b2[2];
          { const bool up = (lane & 4) != 0;
#pragma unroll
            for (int i = 0; i < 2; ++i) { const float send = up ? b4[i] : b4[i + 2], keep = up ? b4[i + 2] : b4[i]; b2[i] = keep + __shfl_xor(send, 4); } }
          float b1v;
          { const bool up = (lane & 2) != 0; const float send = up ? b2[0] : b2[1], keep = up ? b2[1] : b2[0]; b1v = keep + __shfl_xor(send, 2); }
          b1v += __shfl_xor(b1v, 1);
          const int e = (lane >> 1) & 31;
          if ((lane & 1) == 0) wsc[wave * 32 + e] = b1v + brt[e]; }
        asm volatile("s_waitcnt lgkmcnt(0)" ::: "memory");
        float lv[32];
#pragma unroll
        for (int e4 = 0; e4 < 8; ++e4) { const f32x4 x = *(const LAS f32x4*)(wsc + wave * 32 + e4 * 4); lv[e4 * 4] = x[0]; lv[e4 * 4 + 1] = x[1]; lv[e4 * 4 + 2] = x[2]; lv[e4 * 4 + 3] = x[3]; }
        float tv[4]; int ti[4];
#pragma unroll
        for (int k = 0; k < 4; ++k) { float bv = -INFINITY; int bi = 0;
#pragma unroll
            for (int e = 0; e < 32; ++e) { const bool taken = (k > 0 && ti[0] == e) || (k > 1 && ti[1] == e) || (k > 2 && ti[2] == e); if (!taken && lv[e] > bv) { bv = lv[e]; bi = e; } }
            tv[k] = bv; ti[k] = bi; }
        const float e1 = __expf(tv[1] - tv[0]), e2 = __expf(tv[2] - tv[0]), e3 = __expf(tv[3] - tv[0]); const float inv = 1.f / (1.f + e1 + e2 + e3);
        if (lane < 4) { const int ek = lane == 0 ? ti[0] : lane == 1 ? ti[1] : lane == 2 ? ti[2] : ti[3]; const float gk = (lane == 0 ? 1.f : lane == 1 ? e1 : lane == 2 ? e2 : e3) * inv;
            const int rk = __hip_atomic_fetch_add(hist + ek, 1, __ATOMIC_RELAXED, __HIP_MEMORY_SCOPE_WORKGROUP);
            sel_e[tl * 4 + lane] = ek; sel_r[tl * 4 + lane] = rk; sel_g[tl * 4 + lane] = gk; }
        asm volatile("s_waitcnt lgkmcnt(0)" ::: "memory");
    }
    __syncthreads();
    if (tid < 32) { const int c = hist[tid]; base[tid] = c > 0 ? (int)__hip_atomic_fetch_add(CNT + tid, (unsigned)c, __ATOMIC_RELAXED, __HIP_MEMORY_SCOPE_AGENT) : 0; }
    __syncthreads();
    if (tid < 256) { const int tl = tid >> 2; const int t = blk * 64 + tl; const int e = sel_e[tid], pos = base[e] + sel_r[tid];
        TOK[e * 16384 + pos] = t; TE[(size_t)t * 4 + (tid & 3)] = e; TP[(size_t)t * 4 + (tid & 3)] = pos; TG[(size_t)t * 4 + (tid & 3)] = sel_g[tid]; }
    __syncthreads();
}

__device__ __forceinline__ void ln2_row(int lane, size_t t, const bf16* X1, const bf16* YB, const LAS int* tab, const int* TE, const int* TP, const float* TG, const float* g2, const float* b2, bf16* XB, float* outp) {
    f32x4 v[4];
#pragma unroll
    for (int j = 0; j < 4; ++j) { const int c = 4 * lane + 256 * j; const u32x2 xw = *(const u32x2*)(X1 + t * 1024 + c); v[j] = (f32x4){bf_lo(xw.x), bf_hi(xw.x), bf_lo(xw.y), bf_hi(xw.y)} * ALPHA; }
#pragma unroll
    for (int k = 0; k < (DBG_NO_MOE ? 0 : 4); ++k) { const int e = TE[t * 4 + k], pos = TP[t * 4 + k]; const float g = TG[t * 4 + k]; const size_t slot = (size_t)tab[32 + e] * 256 + pos;
#pragma unroll
        for (int j = 0; j < 4; ++j) { const int c = 4 * lane + 256 * j; const u32x2 yw = *(const u32x2*)(YB + slot * 1024 + c); v[j] += (f32x4){bf_lo(yw.x), bf_hi(yw.x), bf_lo(yw.y), bf_hi(yw.y)} * g; } }
    float s = 0.f;
#pragma unroll
    for (int j = 0; j < 4; ++j) s += (v[j][0] + v[j][1]) + (v[j][2] + v[j][3]);
    const float mean = wave_sum(s) * (1.f / 1024.f); float s2 = 0.f;
#pragma unroll
    for (int j = 0; j < 4; ++j) { v[j] = v[j] - mean; s2 += (v[j][0] * v[j][0] + v[j][1] * v[j][1]) + (v[j][2] * v[j][2] + v[j][3] * v[j][3]); }
    const float rstd = 1.f / sqrtf(wave_sum(s2) * (1.f / 1024.f) + LN_EPS);
#pragma unroll
    for (int j = 0; j < 4; ++j) { const int c = 4 * lane + 256 * j; const f32x4 g = *(const f32x4*)(g2 + c), b = *(const f32x4*)(b2 + c); v[j] = v[j] * rstd * g + b;
        u32x2 w; w.x = cvt_pk_bf16(v[j][0], v[j][1]); w.y = cvt_pk_bf16(v[j][2], v[j][3]); *(u32x2*)(XB + t * 1024 + c) = w;
        if (outp) *(f32x4*)(outp + t * 1024 + c) = v[j]; }
}


__device__ __forceinline__ void dbg_dump(int id, unsigned char* ws, float* out, int vcu, int G, int tid) {
    const bf16* PROJ = (const bf16*)(ws + WS_PROJ);
    for (size_t i = (size_t)vcu * 512 + tid; i < (size_t)S * 1024; i += (size_t)G * 512) { const size_t t = i >> 10; const int c = (int)(i & 1023); float v = 0.f;
        if (id == 1) v = bf2f(PROJ[(size_t)(c >> 8) * S * 256 + t * 256 + (c & 255)]);
        else if (id == 2) v = bf2f(PROJ[(size_t)(4 + (c >> 8)) * S * 256 + t * 256 + (c & 255)]);
        else if (id == 3) v = c < 256 ? bf2f(PROJ[(size_t)8 * S * 256 + t * 256 + c]) : bf2f(((const bf16*)(ws + WS_SG))[t * 3072 + (c - 256) * 4]);
        else if (id == 4) v = c < 128 ? ((const float*)(ws + WS_LA))[t * 128 + c] : c < 132 ? ((const float*)(ws + WS_FFL))[t * 4 + (c - 128)] : c < 136 ? ((const float*)(ws + WS_CF))[(size_t)(c - 132) * S + t] : 0.f;
        else if (id == 5) v = c < 768 ? bf2f(((const bf16*)(ws + WS_YS))[t * 768 + c]) : 0.f;
        else if (id == 6) v = bf2f(((const bf16*)(ws + WS_MRG))[i]);
        else if (id == 7) v = ((const float*)(ws + WS_Y))[i];
        else if (id == 8) v = bf2f(((const bf16*)(ws + WS_X1))[i]);
        else if (id == 9) v = bf2f(((const bf16*)(ws + WS_XB))[i]);
        else if (id == 10) v = c < 256 ? bf2f(((const bf16*)(ws + WS_YS))[t * 256 + c]) : 0.f;
        else if (id == 11) v = c < 256 ? bf2f(((const bf16*)(ws + WS_YS))[(size_t)S * 256 + t * 256 + c]) : 0.f;
        else if (id == 14) v = bf2f(((const bf16*)(ws + WS_SG))[t * 3072 + 2048 + c]);
        else if (id == 12) v = c < 256 ? bf2f(((const bf16*)(ws + WS_YS))[(size_t)2 * S * 256 + t * 256 + c]) : 0.f;
        out[i] = v; }
}

constexpr int NFOX_FULL = 928, NFOX = 1152;
__device__ __forceinline__ void fox_item(int idx, int& h, int& qb, int& p, int& NT, bool& band) {
    if (idx < NFOX_FULL) { h = idx / 232; const int k = idx % 232; int pp = 0, base = 0;
#pragma unroll
        for (int j = 0; j < 7; ++j) { const int cnt = 57 - 8 * j; if (k >= base + cnt && pp == j) { base += cnt; pp = j + 1; } }
        p = pp; qb = 8 * pp + 7 + (k - base); NT = 32; band = (8 * (pp + 1) == qb + 1); }
    else { const int i2 = idx - NFOX_FULL, cls = i2 >> 5, w = i2 & 31, r = 7 - cls; h = w >> 3; p = w & 7; qb = 8 * p + r - 1; NT = 4 * r; band = true; }
}
__device__ __forceinline__ void attn_item(int item, int nsel_items, const LAS int* mpre, unsigned char* ws, const unsigned* mcnt, char* shm, const int tid) {
    const int lane = tid & 63, r32 = lane & 31; const int wid = __builtin_amdgcn_readfirstlane(tid >> 6);
    const bf16* PROJ = (const bf16*)(ws + WS_PROJ);
    const int rw = wid * 32 + r32;
    int h, NT, tok, dest, kv0, tq; bool band; float cq = 0.f; const float* ckg = nullptr; bf16* PO; float* LSEp;
    if (item < NFOX) { int qb, p; fox_item(item, h, qb, p, NT, band);
        const float* CF = (const float*)(ws + WS_CF) + (size_t)h * S;
        tok = qb * 256 + rw; kv0 = p * 2048; cq = CF[tok]; ckg = CF + kv0; dest = (tok * 4 + h) * 8 + p; tq = 0;
        PO = (bf16*)(ws + WS_POF); LSEp = (float*)(ws + WS_LSF);
    } else { int j; NT = 4; tq = 3; PO = (bf16*)(ws + WS_POM); LSEp = (float*)(ws + WS_LSM);
        if (item < NFOX + nsel_items) { const int k = item - NFOX; int lo = 0, hi_ = 252;
            while (hi_ - lo > 1) { const int mid = (lo + hi_) >> 1; if (mpre[mid] <= k) lo = mid; else hi_ = mid; }
            const int hj = lo, c = k - mpre[hj]; h = hj / 63; j = hj % 63; const int n = (int)mcnt[h * 64 + j] - c * 256;
            const int e = rw < n ? ((const int*)(ws + WS_QL))[((size_t)h * 63 + j) * 16384 + c * 256 + rw] : -1;
            tok = e < 0 ? 0 : (e >> 2); dest = e < 0 ? -1 : (tok * 4 + h) * 4 + (e & 3); band = false; }
        else { const int k = item - NFOX - nsel_items; h = k >> 6; j = k & 63; tok = j * 256 + rw; dest = (tok * 4 + h) * 4 + 3; band = true; }
        kv0 = j * 256; }
    attn::attn_unit<8>(PROJ + (size_t)tq * S * 256 + (size_t)tok * 256 + h * 64, PROJ + (size_t)(tq + 1) * S * 256 + (size_t)kv0 * 256 + h * 64, PROJ + (size_t)(tq + 2) * S * 256 + (size_t)kv0 * 256 + h * 64,
                       NT, band, cq, ckg, dest, PO, LSEp, shm, tid);
}
__device__ __forceinline__ void combine_token(int lane, int tok, unsigned char* ws) {
    const int h = lane >> 4, d4 = (lane & 15) * 4; bf16* YS = (bf16*)(ws + WS_YS);
    { const int np = (tok >> 11) + 1; const float* L = (const float*)(ws + WS_LSF) + ((size_t)tok * 4 + h) * 8; const bf16* P = (const bf16*)(ws + WS_POF) + ((size_t)tok * 4 + h) * 8 * 64 + d4;
      float m = -INFINITY;
      for (int p = 0; p < np; ++p) m = fmaxf(m, L[p]);
      float den = 0.f; f32x4 acc = (f32x4){0.f, 0.f, 0.f, 0.f};
      for (int p = 0; p < np; ++p) { const float w = fast_exp2(L[p] - m); const u32x2 x = *(const u32x2*)(P + p * 64); den += w; acc += (f32x4){bf_lo(x.x), bf_hi(x.x), bf_lo(x.y), bf_hi(x.y)} * w; }
      const float inv = 1.f / den; u32x2 o; o.x = cvt_pk_bf16(acc[0] * inv, acc[1] * inv); o.y = cvt_pk_bf16(acc[2] * inv, acc[3] * inv);
      *(u32x2*)(YS + (size_t)tok * 768 + h * 64 + d4) = o; }
    { const int own = tok >> 8, nsel = own < 3 ? own : 3; const float* L = (const float*)(ws + WS_LSM) + ((size_t)tok * 4 + h) * 4; const bf16* P = (const bf16*)(ws + WS_POM) + ((size_t)tok * 4 + h) * 4 * 64 + d4;
      float m = L[3];
      for (int s = 0; s < nsel; ++s) m = fmaxf(m, L[s]);
      float den = 0.f; f32x4 acc = (f32x4){0.f, 0.f, 0.f, 0.f};
      for (int s = 0; s < 4; ++s) { if (s < nsel || s == 3) { const float w = fast_exp2(L[s] - m); const u32x2 x = *(const u32x2*)(P + s * 64); den += w; acc += (f32x4){bf_lo(x.x), bf_hi(x.x), bf_lo(x.y), bf_hi(x.y)} * w; } }
      const float inv = 1.f / den; u32x2 o; o.x = cvt_pk_bf16(acc[0] * inv, acc[1] * inv); o.y = cvt_pk_bf16(acc[2] * inv, acc[3] * inv);
      *(u32x2*)(YS + (size_t)tok * 768 + 512 + h * 64 + d4) = o; }
}
__global__ void __launch_bounds__(512, 2) mk_fwd(Args args_in_kernarg) {
    extern __shared__ __attribute__((aligned(16))) unsigned char lds_raw[];
    LAS unsigned char* lds = (LAS unsigned char*)lds_raw;
    const int tid0 = threadIdx.x;
    const int G = gridDim.x; const int bx = blockIdx.x; const int vcu = (G % 8 == 0) ? (bx % 8) * (G / 8) + bx / 8 : bx;
    const CAS unsigned char* const kargs = (const CAS unsigned char*)__builtin_amdgcn_kernarg_segment_ptr();
    for (int u = tid0; u < (LDS_BYTES - LDSCTL_OFF) / 4; u += 512) ((LAS unsigned*)(lds + LDSCTL_OFF))[u] = 0u;
    __syncthreads();
    const int lo = *(const CAS int*)(kargs + 160), hi = *(const CAS int*)(kargs + 164);
    XcdBarrier bar; bar.bar = (unsigned*)KARG_WS(kargs) + CW_BAR; bar.x = 0; bar.st = nullptr;
    if (hi - lo > 1) bar = xcd_barrier_post((unsigned*)KARG_WS(kargs) + CW_BAR, (volatile LAS unsigned*)(lds + MISC_OFF) + 8);
#define IN(k) (lo <= (k) && (k) < hi)
#define SEAM(k) do { if (IN(k) && IN((k) + 1)) xcd_barrier(bar); } while (0)
#define PHASE_PTRS() const CAS unsigned char* kp = kargs; asm volatile("" : "+s"(kp)); unsigned char* const ws = KARG_WS(kp); (void)ws; \
    int tid = threadIdx.x; asm volatile("" : "+v"(tid)); const int lane = tid & 63, wave = __builtin_amdgcn_readfirstlane(tid >> 6); (void)lane; (void)wave
#define PROJ_ ((bf16*)(ws + WS_PROJ))
#define FQ_ (PROJ_)
#define FK_ (PROJ_ + (size_t)1 * S * 256)
#define FV_ (PROJ_ + (size_t)2 * S * 256)
#define MQ_ (PROJ_ + (size_t)3 * S * 256)
#define MK_ (PROJ_ + (size_t)4 * S * 256)
#define MV_ (PROJ_ + (size_t)5 * S * 256)
#define GQK_ (PROJ_ + (size_t)6 * S * 256)
#define GV_ (PROJ_ + (size_t)7 * S * 256)
#define GR_ (PROJ_ + (size_t)8 * S * 256)
    LAS int* const tab = (LAS int*)(lds + TAB_OFF);

#if DBG_DUMP
    if (lo == 999) { PHASE_PTRS(); dbg_dump(DBG_DUMP, ws, KARG_OUT(kp), vcu, G, tid); return; }
#endif
    if (IN(0)) { PHASE_PTRS(); p0_prologue(kp, lds, vcu, G, tid); }
    SEAM(0);

    for (int l = 0; l < DEPTH; ++l) {
        const int pb = 1 + l * NPH;
        if (hi <= pb || lo >= pb + NPH) continue;
        if (IN(pb + 0)) { PHASE_PTRS();
            pg8::DenseOrder So; So.init(S, NIN, 1024, (const bf16*)(ws + WS_WIN) + (size_t)l * NIN * 1024, G, bx);
            pg8::EpiIn E{PROJ_, (bf16*)(ws + WS_SG), (float*)(ws + WS_LA), (float*)(ws + WS_FFL), KARG_IN(kp, 4) + l * 128, KARG_IN(kp, 2) + l * 4};
            pg8::gemm_phase<pg8::EpiIn, pg8::DenseOrder, true, false>(lds, (const bf16*)(ws + WS_XB), 1024, So, E);
        }
        SEAM(pb + 0);
#if DBG_DUMP
        if (l == 0 && DBG_AFTER == 0 && hi - lo > 1) { PHASE_PTRS(); dbg_dump(DBG_DUMP, ws, KARG_OUT(kp), vcu, G, tid); return; }
#endif
        if (IN(pb + 1)) { PHASE_PTRS();
            const bf16* MK = MK_; float* KM = (float*)(ws + WS_KM);
            for (int job = vcu; job < 1024 + 256; job += G) {
                if (job < 1024) gla_local_unit(lds, tid, job >> 2, job & 3, GQK_, GV_, (const float*)(ws + WS_LA), (float*)(ws + WS_U), (float*)(ws + WS_DEC));
                else { const int hj = job - 1024, h = hj >> 6, j = hj & 63; LAS float* red = (LAS float*)lds; const int d = tid & 63, part = tid >> 6; float s = 0.f;
                    for (int i = 0; i < 32; ++i) s += bf2f(MK[(size_t)(j * 256 + part * 32 + i) * 256 + h * 64 + d]);
                    red[part * 64 + d] = s; __syncthreads();
                    if (tid < 64) { float tot = 0.f;
#pragma unroll
                        for (int p = 0; p < 8; ++p) tot += red[p * 64 + tid];
                        KM[(size_t)(h * 64 + j) * 64 + tid] = tot * (1.f / 256.f); }
                    __syncthreads(); }
            }
        }
        SEAM(pb + 1);
#if DBG_DUMP
        if (l == 0 && DBG_AFTER == 1 && hi - lo > 1) { PHASE_PTRS(); dbg_dump(DBG_DUMP, ws, KARG_OUT(kp), vcu, G, tid); return; }
#endif
        if (IN(pb + 2)) { PHASE_PTRS();
            for (int job = vcu; job < 16 + 4 + 128; job += G) {
                if (job < 16) { const float* DEC = (const float*)(ws + WS_DEC); const float* Ub = (const float*)(ws + WS_U); float* SST = (float*)(ws + WS_SST);
                    const int e = job * 512 + tid; float s = 0.f;
                    for (int i = 0; i < 256; i += 8) { float d[8], u[8];
#pragma unroll
                        for (int k = 0; k < 8; ++k) { d[k] = DEC[(i + k) * 128 + (e >> 6)]; u[k] = Ub[(size_t)(i + k) * 8192 + e]; }
#pragma unroll
                        for (int k = 0; k < 8; ++k) { SST[(size_t)(i + k) * 8192 + e] = s; s = s * d[k] + u[k]; } } }
                else if (job < 20) { const float* FFL = (const float*)(ws + WS_FFL); float* CF = (float*)(ws + WS_CF);
                    const int h = job - 16; LAS float* wt = (LAS float*)lds; float sum = 0.f;
                    for (int i = 0; i < 32; ++i) sum += FFL[(size_t)(tid * 32 + i) * 4 + h];
                    float x = sum;
#pragma unroll
                    for (int o = 1; o < 64; o <<= 1) { const float y = __shfl_up(x, o); if (lane >= o) x += y; }
                    if (lane == 63) wt[wave] = x;
                    __syncthreads();
                    float pre = x - sum;
                    for (int w = 0; w < wave; ++w) pre += wt[w];
                    float run = pre;
                    for (int i = 0; i < 32; ++i) { run += FFL[(size_t)(tid * 32 + i) * 4 + h]; CF[(size_t)h * S + tid * 32 + i] = run * LOG2E; }
                    __syncthreads(); }
                else moba_gate_batch(lds, tid, job - 20, MQ_, (const float*)(ws + WS_KM), (int*)(ws + WS_SEL), (int*)(ws + WS_QL), (unsigned*)ws + CW_MCNT + l * 256);
            }
        }
        SEAM(pb + 2);
#if DBG_DUMP
        if (l == 0 && DBG_AFTER == 2 && hi - lo > 1) { PHASE_PTRS(); dbg_dump(DBG_DUMP, ws, KARG_OUT(kp), vcu, G, tid); return; }
#endif
        if (IN(pb + 3)) { PHASE_PTRS();
            bf16* const YS = (bf16*)(ws + WS_YS);
            for (int u = vcu; u < 1024; u += G) gla_out_unit(lds, tid, u >> 2, u & 3, GQK_, GV_, GR_, (const float*)(ws + WS_LA), (const float*)(ws + WS_SST), KARG_IN(kp, 5) + l * 256, YS + 256);
            LAS int* const mpre = (LAS int*)(lds + RT_OFF); LAS int* const qslot = mpre + 256;
            const unsigned* mcnt = (const unsigned*)ws + CW_MCNT + l * 256; unsigned* qhead = (unsigned*)ws + CW_Q + l * 64;
            if (tid < 64) { int c4[4]; int s4 = 0;
#pragma unroll
                for (int i = 0; i < 4; ++i) { const int hj = tid * 4 + i; const int c = hj < 252 ? (int)__hip_atomic_load(mcnt + (hj / 63) * 64 + hj % 63, __ATOMIC_RELAXED, __HIP_MEMORY_SCOPE_AGENT) : 0; c4[i] = (c + 255) >> 8; s4 += c4[i]; }
                int incl = s4;
#pragma unroll
                for (int o = 1; o < 64; o <<= 1) { const int y = __shfl_up(incl, o); if (tid >= o) incl += y; }
                int run = incl - s4;
#pragma unroll
                for (int i = 0; i < 4; ++i) { if (tid * 4 + i <= 252) mpre[tid * 4 + i] = run; run += c4[i]; } }
            if (tid == 0) qslot[0] = (int)__hip_atomic_fetch_add(qhead, 1u, __ATOMIC_RELAXED, __HIP_MEMORY_SCOPE_AGENT);
            __syncthreads();
            const int nsel_items = mpre[252], total = NFOX + nsel_items + 256;
            int cur = qslot[0];
            __syncthreads();
            while (cur < total) {
                int nxt = 0;
                if (tid == 0) nxt = (int)__hip_atomic_fetch_add(qhead, 1u, __ATOMIC_RELAXED, __HIP_MEMORY_SCOPE_AGENT);
                attn_item(cur, nsel_items, mpre, ws, mcnt, (char*)lds_raw, tid);
                if (tid == 0) qslot[0] = nxt;
                __syncthreads();
                cur = qslot[0];
                __syncthreads();
            }
        }
        SEAM(pb + 3);
        if (IN(pb + 4)) { PHASE_PTRS();
            for (int t = vcu * 8 + wave; t < S; t += G * 8) combine_token(lane, t, ws);
        }
        SEAM(pb + 4);
        if (IN(pb + 5)) {
            for (int nb = 0; nb < 3; ++nb) { PHASE_PTRS();
                pg8::DenseOrder So; So.init(S, 1024, 768, (const bf16*)(ws + WS_WBP) + ((size_t)l * 3 + nb) * 1024 * 768, G, bx);
                pg8::EpiLift E{(const bf16*)(ws + WS_SG), (float*)(ws + WS_T), (float*)(ws + WS_Y), (bf16*)(ws + WS_MRG), nb};
                pg8::gemm_phase<pg8::EpiLift, pg8::DenseOrder, true, false>(lds, (const bf16*)(ws + WS_YS), 768, So, E);
                asm volatile("s_waitcnt vmcnt(0)" ::: "memory"); __syncthreads();
            }
        }
        SEAM(pb + 5);
#if DBG_DUMP
        if (l == 0 && DBG_AFTER == 5 && hi - lo > 1) { PHASE_PTRS(); dbg_dump(DBG_DUMP, ws, KARG_OUT(kp), vcu, G, tid); return; }
#endif
        if (IN(pb + 6)) { PHASE_PTRS();
            pg8::DenseOrder So; So.init(S, 1024, 1024, (const bf16*)(ws + WS_WOUT) + (size_t)l * 1024 * 1024, G, bx);
            pg8::EpiF32 E{(float*)(ws + WS_Y)};
            pg8::gemm_phase<pg8::EpiF32, pg8::DenseOrder, true, false>(lds, (const bf16*)(ws + WS_MRG), 1024, So, E);
        }
        SEAM(pb + 6);
#if DBG_DUMP
        if (l == 0 && DBG_AFTER == 6 && hi - lo > 1) { PHASE_PTRS(); dbg_dump(DBG_DUMP, ws, KARG_OUT(kp), vcu, G, tid); return; }
#endif
        if (IN(pb + 7)) { PHASE_PTRS();
            LAS float* WrT = (LAS float*)lds; const float* wr_ = KARG_IN(kp, 10) + (size_t)l * 1024 * 32;
            for (int i = tid; i < 32768; i += 512) { const int e = i & 31, d = i >> 5; WrT[e * 1024 + d] = wr_[i]; }
            __syncthreads();
            for (int blk = vcu; blk < S / 64; blk += G)
                ln1_router_block(lds, tid, blk, (const bf16*)(ws + WS_XB), (const float*)(ws + WS_Y), KARG_IN(kp, 8) + l * 1024, KARG_IN(kp, 9) + l * 1024, KARG_IN(kp, 11) + l * 32, (bf16*)(ws + WS_X1),
                                 (unsigned*)ws + CW_CNT + l * 64, (int*)(ws + WS_TOK), (int*)(ws + WS_TE), (int*)(ws + WS_TP), (float*)(ws + WS_TG));
        }
        SEAM(pb + 7);
#if DBG_DUMP
        if (l == 0 && DBG_AFTER == 7 && hi - lo > 1) { PHASE_PTRS(); dbg_dump(DBG_DUMP, ws, KARG_OUT(kp), vcu, G, tid); return; }
#endif
        if (IN(pb + 8)) { PHASE_PTRS();
            moe_table((const unsigned*)ws + CW_CNT + l * 64, tab, tid);
            pg8::MoeOrder So{G, vcu, 8, tab[65], tab, (const int*)(ws + WS_TOK), (const char*)((const bf16*)(ws + WS_WGU) + (size_t)l * 32 * 2048 * 1024), (size_t)2048 * 1024 * 2, 1024};
            pg8::EpiMoe1 E{(bf16*)(ws + WS_ACT), KARG_IN(kp, 13) + (size_t)l * 32 * 2048};
            pg8::gemm_phase<pg8::EpiMoe1, pg8::MoeOrder, true, true>(lds, (const bf16*)(ws + WS_X1), 1024, So, E);
        }
        SEAM(pb + 8);
#if DBG_DUMP
        if (l == 0 && DBG_AFTER == 8 && hi - lo > 1) { PHASE_PTRS(); dbg_dump(DBG_DUMP, ws, KARG_OUT(kp), vcu, G, tid); return; }
#endif
        if (IN(pb + 9)) { PHASE_PTRS();
            moe_table((const unsigned*)ws + CW_CNT + l * 64, tab, tid);
            pg8::MoeOrder So{G, vcu, 4, tab[65], tab, nullptr, (const char*)((const bf16*)(ws + WS_WDN) + (size_t)l * 32 * 1024 * 1024), (size_t)1024 * 1024 * 2, 1024};
            pg8::EpiMoe2 E{(bf16*)(ws + WS_YB), KARG_IN(kp, 15) + (size_t)l * 32 * 1024};
            pg8::gemm_phase<pg8::EpiMoe2, pg8::MoeOrder, true, false>(lds, (const bf16*)(ws + WS_ACT), 1024, So, E);
        }
        SEAM(pb + 9);
#if DBG_DUMP
        if (l == 0 && DBG_AFTER == 9 && hi - lo > 1) { PHASE_PTRS(); dbg_dump(DBG_DUMP, ws, KARG_OUT(kp), vcu, G, tid); return; }
#endif
        if (IN(pb + 10)) { PHASE_PTRS();
            moe_table((const unsigned*)ws + CW_CNT + l * 64, tab, tid);
            float* outp = (l == DEPTH - 1) ? KARG_OUT(kp) : nullptr;
            for (int t = vcu * 8 + wave; t < S; t += G * 8) ln2_row(lane, (size_t)t, (const bf16*)(ws + WS_X1), (const bf16*)(ws + WS_YB), tab, (const int*)(ws + WS_TE), (const int*)(ws + WS_TP), (const float*)(ws + WS_TG),
                                                                     KARG_IN(kp, 16) + l * 1024, KARG_IN(kp, 17) + l * 1024, (bf16*)(ws + WS_XB), outp);
        }
        SEAM(pb + 10);
#if DBG_DUMP
        if (l == 0 && DBG_AFTER == 10 && hi - lo > 1) { PHASE_PTRS(); dbg_dump(DBG_DUMP, ws, KARG_OUT(kp), vcu, G, tid); return; }
#endif
    }
#undef IN
#undef SEAM
}

extern "C" void kernel_launch(void* const* d_in, const int* in_sizes, int n_in, void* d_out, int out_size, void* d_ws, size_t ws_size, hipStream_t stream) {
    static int grid = 0;
    if (grid == 0) {
        if (n_in != 18 || out_size != S * D || ws_size < WS_END) { fprintf(stderr, "kernel_launch: unexpected shapes (n_in %d out %d ws %zu, need %zu)\n", n_in, out_size, ws_size, (size_t)WS_END); grid = -1; return; }
        int dev = 0, cus = 0, per_cu = 0;
        if (hipGetDevice(&dev) != hipSuccess || hipDeviceGetAttribute(&cus, hipDeviceAttributeMultiprocessorCount, dev) != hipSuccess) { grid = -1; return; }
        if (hipFuncSetAttribute((const void*)mk_fwd, hipFuncAttributeMaxDynamicSharedMemorySize, LDS_BYTES) != hipSuccess) { fprintf(stderr, "kernel_launch: hipFuncSetAttribute failed\n"); grid = -1; return; }
        if (hipOccupancyMaxActiveBlocksPerMultiprocessor(&per_cu, (const void*)mk_fwd, 512, LDS_BYTES) != hipSuccess || per_cu < 1) fprintf(stderr, "kernel_launch: occupancy query says %d\n", per_cu);
        (void)hipGetLastError();
        grid = cus;
    }
    if (grid < 0) return;
    (void)hipMemsetAsync((char*)d_ws + WS_CTL, 0, CTL_ZERO_BYTES, stream);
    Args a{};
    for (int i = 0; i < 18; ++i) a.in[i] = (const float*)d_in[i];
    a.out = (float*)d_out; a.ws = (unsigned char*)d_ws;
#if MK_PER_PHASE
#if DBG_DUMP
    for (int p = 0; p <= 1 + DBG_AFTER; ++p) { a.ph_lo = p; a.ph_hi = p + 1; hipLaunchKernelGGL(mk_fwd, dim3(grid), dim3(512), LDS_BYTES, stream, a); }
    a.ph_lo = 999; a.ph_hi = 1000; hipLaunchKernelGGL(mk_fwd, dim3(grid), dim3(512), LDS_BYTES, stream, a);
#else
    for (int p = 0; p < NPHASE; ++p) { a.ph_lo = p; a.ph_hi = p + 1; hipLaunchKernelGGL(mk_fwd, dim3(grid), dim3(512), LDS_BYTES, stream, a); }
#endif
#else
    a.ph_lo = 0; a.ph_hi = NPHASE;
    hipLaunchKernelGGL(mk_fwd, dim3(grid), dim3(512), LDS_BYTES, stream, a);
#endif
}
```

```cpp
#include <hip/hip_runtime.h>
#include <cstdio>
#include <cstdint>

#ifndef MK_PER_PHASE
#define MK_PER_PHASE 0
#endif

#ifndef PROBE_MASK
#define PROBE_MASK 0
#endif
#define LAS __attribute__((address_space(3)))
#define GAS __attribute__((address_space(1)))
typedef unsigned short bf16;
typedef short bf16x8 __attribute__((ext_vector_type(8)));
typedef float f32x4 __attribute__((ext_vector_type(4)));
typedef float f32x2 __attribute__((ext_vector_type(2)));
typedef unsigned u32x4 __attribute__((ext_vector_type(4)));
typedef unsigned u32x2 __attribute__((ext_vector_type(2)));
typedef int v8i32_t __attribute__((ext_vector_type(8)));
typedef short bf16x16_t __attribute__((ext_vector_type(16)));

constexpr int S = 16384, D = 1024, DEPTH = 4;
constexpr int D_IN = 5396, NIN = 2560;
constexpr int NE = 32;
constexpr int NSLOT = 73728;
constexpr float ALPHA = 1.6817928305074290f;
constexpr float LOG2E = 1.4426950408889634f;
constexpr float C2 = 0.125f * LOG2E;
constexpr float LN_EPS = 1e-5f, RMS_EPS = 1e-6f;
constexpr int NPH = 11;
constexpr int NPHASE = 1 + DEPTH * NPH;

constexpr size_t MiB = 1ull << 20;
constexpr size_t WS_CTL = 0, CTL_ZERO_BYTES = 1 * MiB;
constexpr size_t WS_WIN = 1 * MiB;
constexpr size_t WS_WBR = WS_WIN + 44 * MiB;
constexpr size_t WS_WOUT = WS_WBR + 6 * MiB;
constexpr size_t WS_WGU = WS_WOUT + 8 * MiB;
constexpr size_t WS_WDN = WS_WGU + 512 * MiB;
constexpr size_t WS_XB = WS_WDN + 256 * MiB;
constexpr size_t WS_X1 = WS_XB + 32 * MiB;
constexpr size_t WS_PROJ = WS_X1 + 32 * MiB;
constexpr size_t WS_SG = WS_PROJ + 72 * MiB;
constexpr size_t WS_LA = WS_SG + 96 * MiB;
constexpr size_t WS_FFL = WS_LA + 8 * MiB;
constexpr size_t WS_CF = WS_FFL + 1 * MiB;
constexpr size_t WS_YS = WS_CF + 1 * MiB;
constexpr size_t WS_T = WS_YS + 24 * MiB;
constexpr size_t WS_MRG = WS_T + 64 * MiB;
constexpr size_t WS_Y = WS_MRG + 32 * MiB;
constexpr size_t WS_ACT = WS_Y + 64 * MiB;
constexpr size_t WS_YB = WS_ACT + 144 * MiB;
constexpr size_t WS_U = WS_YB + 144 * MiB;
constexpr size_t WS_SST = WS_U + 8 * MiB;
constexpr size_t WS_DEC = WS_SST + 8 * MiB;
constexpr size_t WS_KM = WS_DEC + 1 * MiB;
constexpr size_t WS_NRM = WS_KM + 256 * 1024;
constexpr size_t WS_SEL = WS_KM + 1 * MiB;
constexpr size_t WS_QL = WS_SEL + 1 * MiB;
constexpr size_t WS_TOK = WS_QL + 16 * MiB;
constexpr size_t WS_TE = WS_TOK + 2 * MiB;
constexpr size_t WS_TP = WS_TE + 1 * MiB;
constexpr size_t WS_TG = WS_TP + 1 * MiB;
constexpr size_t WS_POF = WS_TG + 1 * MiB;
constexpr size_t WS_LSF = WS_POF + 64 * MiB;
constexpr size_t WS_POM = WS_LSF + 2 * MiB;
constexpr size_t WS_LSM = WS_POM + 32 * MiB;
constexpr size_t WS_WBP = WS_LSM + 1 * MiB;
constexpr size_t WS_XB8 = WS_WBP + 17 * MiB;
constexpr size_t WS_WIN8 = WS_WBP + 33 * MiB;
constexpr size_t WS_X1F = WS_WBP + 1 * MiB;
constexpr size_t WS_WRT = WS_WBP;
constexpr size_t WS_END = WS_WBP + 46 * MiB;
constexpr int CW_BAR = 4096;
constexpr int CW_CNT = 16384;
constexpr int CW_MCNT = 20480;
constexpr int CW_Q = 24576;

constexpr int RING_BYTES = 131072;
constexpr int LDSCTL_OFF = RING_BYTES, MISC_OFF = LDSCTL_OFF + 320;
constexpr int TAB_OFF = RING_BYTES + 1024;
constexpr int RT_OFF = RING_BYTES + 4096;
constexpr int LDS_BYTES = 147456;

__device__ __forceinline__ float bf_lo(unsigned w) { return __uint_as_float(w << 16); }
__device__ __forceinline__ float bf_hi(unsigned w) { return __uint_as_float(w & 0xffff0000u); }
__device__ __forceinline__ float bf2f(bf16 b) { return __uint_as_float((unsigned)b << 16); }
typedef __bf16 bf16x2_t __attribute__((ext_vector_type(2)));
__device__ __forceinline__ unsigned cvt_pk_bf16(float lo, float hi) { f32x2 v = {lo, hi}; bf16x2_t b = __builtin_convertvector(v, bf16x2_t); return __builtin_bit_cast(unsigned, b); }
__device__ __forceinline__ unsigned cvt4_fp8(float a, float b, float c, float d) { int w = 0; w = __builtin_amdgcn_cvt_pk_fp8_f32(a, b, w, false); w = __builtin_amdgcn_cvt_pk_fp8_f32(c, d, w, true); return (unsigned)w; }
__device__ __forceinline__ float fast_exp2(float x) { return __builtin_amdgcn_exp2f(x); }
__device__ __forceinline__ float fast_rcp(float x) { return __builtin_amdgcn_rcpf(x); }
__device__ __forceinline__ float sigmoidf_(float x) { return fast_rcp(1.f + fast_exp2(-x * LOG2E)); }
__device__ __forceinline__ float logsigmoidf_(float x) { return fminf(x, 0.f) - __logf(1.f + __expf(-fabsf(x))); }
__device__ __forceinline__ unsigned lane_id_now() { unsigned r; asm volatile("v_mbcnt_lo_u32_b32 %0, -1, 0\n\tv_mbcnt_hi_u32_b32 %0, -1, %0" : "=v"(r)); return r; }
__device__ __forceinline__ int shx(int v, int m) { const int ln = (int)lane_id_now(); return __builtin_amdgcn_ds_bpermute((ln ^ m) << 2, v); }
__device__ __forceinline__ float shx(float v, int m) { return __uint_as_float((unsigned)shx((int)__float_as_uint(v), m)); }
__device__ __forceinline__ int shu(int v, int d) { const int ln = (int)lane_id_now(); const int s = ln - d; return __builtin_amdgcn_ds_bpermute((s < 0 ? ln : s) << 2, v); }
__device__ __forceinline__ float shu(float v, int d) { return __uint_as_float((unsigned)shu((int)__float_as_uint(v), d)); }
__device__ __forceinline__ float wave_sum(float v) {
#pragma unroll
    for (int o = 1; o < 64; o <<= 1) v += shx(v, o);
    return v;
}

namespace pg8 {
constexpr int BM = 256, BK = 64, HALF = 128, HTB = HALF * BK * 2, NXCD = 8, WGM = 8;
__device__ __forceinline__ int lds_byte(int r, int c) { const int st = (r >> 4) * 2 + (c >> 5), rr = r & 15, cc = c & 31, ob = rr * 64 + cc * 2; return st * 1024 + (ob ^ (((ob >> 9) & 1) << 5)); }
__device__ __forceinline__ void stage_rc(int b, int& R, int& C) { const int st = b / 1024, sb = b % 1024, swz = sb ^ (((sb >> 9) & 1) << 5); R = (st >> 1) * 16 + swz / 64; C = (st & 1) * 32 + (swz % 64) / 2; }
__device__ __forceinline__ int perm32(int rho) { const int n = rho >> 4, i = rho & 15; return 8 * (i >> 2) + 4 * n + (i & 3); }

struct Unit { int pm, pn, e, half, par; };

struct DenseOrder {
    int nM, nN, nwg, G, c; const char* Bt; int K; int split = 0;
    __device__ void init(int M, int N, int K_, const bf16* Bt_, int G_, int c_) { nM = M / BM; nN = N / BM; nwg = nM * nN; G = G_; c = c_; Bt = (const char*)Bt_; K = K_ * 2; }
    __device__ bool next(int i, Unit& u) const {
        long L = (long)i * G + c;
        if (split > 0 && i >= 2) { if (c < split || i >= 4) return false; L = 2l * G + (long)(i - 2) * (G - split) + (c - split); }
        if (L >= nwg) return false;
        int wgid = (int)L; { const int q = nwg / NXCD, r = nwg % NXCD, xcd = wgid % NXCD, off = wgid / NXCD; wgid = (xcd < r ? xcd * (q + 1) : r * (q + 1) + (xcd - r) * q) + off; }
        const int nig = WGM * nN, gid = wgid / nig, fm = gid * WGM, gsz = (nM - fm) < WGM ? (nM - fm) : WGM;
        u.pm = fm + ((wgid % nig) % gsz); u.pn = (wgid % nig) / gsz; u.e = 0; return true;
    }
    __device__ __forceinline__ unsigned arow(const Unit& u, int r) const { return (unsigned)(u.pm * BM + r); }
    __device__ __forceinline__ const char* bbase(const Unit& u) const { return Bt + (size_t)u.pn * BM * K; }
};

struct MoeOrder {
    int G, c, NN, ntiles; const LAS int* tab; const int* toklist; const char* Bt; size_t ebytes; int K;
    __device__ bool next(int i, Unit& u) const {
        const int L = i * G + c; if (L >= ntiles * NN) return false;
        const int k = L / NN; u.pm = tab[448 + k]; u.pn = L % NN; u.e = tab[128 + u.pm]; u.half = k >= tab[66] ? 1 : 0; return true;
    }
    __device__ __forceinline__ unsigned arow(const Unit& u, int r) const {
        if (!toklist) return (unsigned)(u.pm * BM + r);
        const int rr = (u.pm - tab[32 + u.e]) * BM + r;
        return rr < tab[u.e] ? (unsigned)toklist[u.e * 16384 + rr] : 0u;
    }
    __device__ __forceinline__ const char* bbase(const Unit& u) const { return Bt + (size_t)u.e * ebytes + (size_t)u.pn * BM * K; }
};

template <class Epi, class Sched, bool ALIGN_EPI, bool GATHER, bool FP8 = false, bool HOOK = false, bool TAILS = false>
__device__ __forceinline__ void gemm_phase(LAS unsigned char* lds, const bf16* Abase, const int K, const int lda, const Sched& S, const Epi& E, const int tid_in) {
    int tid_ = tid_in; asm volatile("" : "+v"(tid_));
    const int tid = tid_, wid = __builtin_amdgcn_readfirstlane(tid >> 6), lane = tid & 63, wr = wid >> 2, wc = wid & 3, fr = lane & 15, fq = lane >> 4;
    constexpr int EB = FP8 ? 1 : 2;
    const int nt = K * EB / 128;
    unsigned voffA[2], voffB[2];
#pragma unroll
    for (int i = 0; i < 2; ++i) { int R, C; stage_rc(tid * 16 + i * 8192, R, C); const int Rb = Epi::PERM == 3 ? ((R >> 5) * 64 + ((R >> 2) & 3) * 16 + ((R >> 4) & 1) * 4 + (R & 3)) : Epi::PERM ? ((R & ~31) + perm32(R & 31)) : R;
        voffA[i] = (unsigned)(R * lda * EB + C * 2); voffB[i] = (unsigned)(Rb * K * EB + C * 2); }
    LAS u32x4* const stash = (LAS u32x4*)(lds + RING_BYTES + 8192) + tid;
    const size_t kstep = (size_t)(BK * 2);
    const size_t hstep = (size_t)(Epi::PERM == 3 ? 8 : HALF) * K * EB;
    const size_t hstepA = (size_t)HALF * lda * EB;
    const unsigned ldsw = (unsigned)wid * 1024u;
    const unsigned ldsbase = (unsigned)(uintptr_t)lds;
    const int aoff = lds_byte(wr * 64 + fr, fq * 8), boff = lds_byte(wc * 32 + fr, fq * 8);
    const char* gA = (const char*)Abase;
#define PG8_SA(b, h) (((b) * 2 + (h)) * HTB)
#define PG8_SB(b, h) ((4 + (b) * 2 + (h)) * HTB)
#define PG8_STAGE(bufoff, gbase, voff) do { _Pragma("unroll") for (int _i = 0; _i < 2; ++_i) { unsigned keep_; \
        asm volatile("s_mov_b32 %0, m0\n\ts_mov_b32 m0, %3\n\ts_nop 0\n\tglobal_load_lds_dwordx4 %1, %2\n\ts_mov_b32 m0, %0" : "=&s"(keep_) \
            : "v"((voff)[_i]), "s"((const char*)(gbase)), "s"((unsigned)__builtin_amdgcn_readfirstlane(ldsbase + (unsigned)(bufoff) + ldsw + _i * 8192u)) : "memory"); } } while (0)
#define PG8_LD32(addr) __builtin_bit_cast(v8i32_t, __builtin_shufflevector(*(const LAS u32x4*)(addr), *(const LAS u32x4*)((addr) + 1024), 0, 1, 2, 3, 4, 5, 6, 7))
#define PG8_LDA(dst, b, h) do { if constexpr (FP8) { _Pragma("unroll") for (int m = 0; m < 4; ++m) dst##8[m] = PG8_LD32(lds + PG8_SA(b, h) + aoff + m * 2048); } \
        else { _Pragma("unroll") for (int m = 0; m < 4; ++m) _Pragma("unroll") for (int k = 0; k < 2; ++k) dst[m][k] = *(const LAS bf16x8*)(lds + PG8_SA(b, h) + aoff + m * 2048 + k * 1024); } } while (0)
#define PG8_LDB(dst, b, h) do { if constexpr (FP8) { _Pragma("unroll") for (int n = 0; n < 2; ++n) dst##8[n] = PG8_LD32(lds + PG8_SB(b, h) + boff + n * 2048); } \
        else { _Pragma("unroll") for (int n = 0; n < 2; ++n) _Pragma("unroll") for (int k = 0; k < 2; ++k) dst[n][k] = *(const LAS bf16x8*)(lds + PG8_SB(b, h) + boff + n * 2048 + k * 1024); } } while (0)
#define PG8_CAT(x) __builtin_bit_cast(v8i32_t, __builtin_shufflevector(__builtin_bit_cast(u32x4, x[0]), __builtin_bit_cast(u32x4, x[1]), 0, 1, 2, 3, 4, 5, 6, 7))
#define PG8_MMA(ai, bj, At, Bt) do { __builtin_amdgcn_s_setprio(1); \
        if constexpr (FP8) { _Pragma("unroll") for (int m = 0; m < 4; ++m) _Pragma("unroll") for (int n = 0; n < 2; ++n) \
            acc[ai][bj][m][n] = __builtin_amdgcn_mfma_scale_f32_16x16x128_f8f6f4(Bt##8[n], At##8[m], acc[ai][bj][m][n], 0, 0, 0, 0x7f7f7f7f, 0, 0x7f7f7f7f); } \
        else { _Pragma("unroll") for (int m = 0; m < 4; ++m) _Pragma("unroll") for (int n = 0; n < 2; ++n) _Pragma("unroll") for (int k = 0; k < 2; ++k) \
            acc[ai][bj][m][n] = __builtin_amdgcn_mfma_f32_16x16x32_bf16(Bt[n][k], At[m][k], acc[ai][bj][m][n], 0, 0, 0); } \
        __builtin_amdgcn_s_setprio(0); } while (0)
#define PG8_WAIT_V(n) asm volatile("s_waitcnt vmcnt(" #n ")" ::: "memory")
#define PG8_WAIT_L(n) asm volatile("s_waitcnt lgkmcnt(" #n ")" ::: "memory")
#define PG8_BAR __builtin_amdgcn_s_barrier()
#define PG8_SCHED __builtin_amdgcn_sched_barrier(0)
#define PG8_AOFF(dst, u) do { _Pragma("unroll") for (int _h = 0; _h < 2; ++_h) _Pragma("unroll") for (int _i = 0; _i < 2; ++_i) { int _R, _C; stage_rc(tid * 16 + _i * 8192, _R, _C); \
        dst[_h][_i] = S.arow(u, _h * HALF + _R) * (unsigned)(lda * EB) + (unsigned)(_C * 2); } } while (0)
    Unit cur, nxt; int ui = 0;
    if (!S.next(0, cur)) return;
    f32x4 acc[2][2][4][2];
#pragma unroll
    for (int a = 0; a < 2; ++a)
#pragma unroll
        for (int b = 0; b < 2; ++b)
#pragma unroll
            for (int m = 0; m < 4; ++m)
#pragma unroll
                for (int n = 0; n < 2; ++n) acc[a][b][m][n] = (f32x4){0.f, 0.f, 0.f, 0.f};
    bf16x8 At[4][2], B0[2][2], B1[2][2];
    v8i32_t At8[4], B08[2], B18[2];
    unsigned curA[2][2];
    const char* cA = gA;
    if constexpr (GATHER) { PG8_AOFF(curA, cur); }
    else { cA = gA + (size_t)S.arow(cur, 0) * lda * EB; }
#define PG8_STA(bufoff, ptr, h) do { if constexpr (GATHER) { PG8_STAGE(bufoff, ptr, curA[h]); } else { PG8_STAGE(bufoff, (ptr) + (h) * hstepA, voffA); } } while (0)
    const char* cB = S.bbase(cur);
    PG8_STAGE(PG8_SB(0, 0), cB, voffB); PG8_STAGE(PG8_SB(0, 1), cB + hstep, voffB); PG8_STA(PG8_SA(0, 0), cA, 0); PG8_STA(PG8_SA(0, 1), cA, 1);
    if (wr == 1) PG8_BAR;
    PG8_WAIT_V(2); PG8_BAR;
    PG8_STAGE(PG8_SB(1, 0), cB + kstep, voffB); PG8_STA(PG8_SA(1, 0), cA + kstep, 0); PG8_STAGE(PG8_SB(1, 1), cB + hstep + kstep, voffB);
    PG8_WAIT_V(6); PG8_BAR;
    for (;;) {
        if constexpr (Epi::LDSBIAS) {
            cur.par = ui & 1;
            if (wid == 0) { const unsigned long long bp_ = (unsigned long long)(uintptr_t)E.bsrc(cur);
                const char* bsrc_ = (const char*)(uintptr_t)(((unsigned long long)(unsigned)__builtin_amdgcn_readfirstlane((int)(bp_ >> 32)) << 32) | (unsigned)__builtin_amdgcn_readfirstlane((int)bp_));
                unsigned keep_; asm volatile("s_mov_b32 %0, m0\n\ts_mov_b32 m0, %3\n\ts_nop 0\n\tglobal_load_lds_dwordx4 %1, %2\n\ts_mov_b32 m0, %0" : "=&s"(keep_)
                : "v"((unsigned)(lane * 16)), "s"(bsrc_), "s"((unsigned)__builtin_amdgcn_readfirstlane(ldsbase + (unsigned)RT_OFF + (unsigned)cur.par * 1024u)) : "memory"); } }
        const bool has_next = S.next(ui + 1, nxt);
        const char* nB = cB; const char* nA = cA;
        if (has_next) { nB = S.bbase(nxt);
            if constexpr (GATHER) { unsigned na[2][2]; PG8_AOFF(na, nxt); *stash = (u32x4){na[0][0], na[0][1], na[1][0], na[1][1]}; }
            else nA = gA + (size_t)S.arow(nxt, 0) * lda * EB; }
#define PG8_KLOOP(FULL) \
        for (int t = 0; t < nt; t += 2) { \
            if constexpr (HOOK) { if (t == 4 || t == 8) { int fr_ = fr, fq_ = fq; asm volatile("" : "+v"(fr_), "+v"(fq_)); E.hook(acc, cur, t >> 2, wr, wc, fr_, fq_); } } \
            const bool last = (t == nt - 2); \
            const char* a1 = cA + (size_t)(t + 1) * kstep; \
            const char* a2 = last ? nA : cA + (size_t)(t + 2) * kstep; const char* b2 = last ? nB : cB + (size_t)(t + 2) * kstep; \
            const char* a3 = a2 + kstep; const char* b3 = b2 + kstep; \
            PG8_LDB(B0, 0, 0); PG8_LDB(B1, 0, 1); PG8_SCHED; PG8_LDA(At, 0, 0); PG8_STA(PG8_SA(1, 1), a1, 1); \
            if constexpr (GATHER) { if (last && has_next) { const u32x4 na = *stash; curA[0][0] = na.x; curA[0][1] = na.y; curA[1][0] = na.z; curA[1][1] = na.w; } } \
            PG8_WAIT_V(8); PG8_WAIT_L(0); PG8_BAR; PG8_MMA(0, 0, At, B0); PG8_MMA(0, 1, At, B1); PG8_BAR; PG8_SCHED; \
            if (FULL) { PG8_LDA(At, 0, 1); } PG8_STAGE(PG8_SB(0, 0), b2, voffB); PG8_STAGE(PG8_SB(0, 1), b2 + hstep, voffB); PG8_STA(PG8_SA(0, 0), a2, 0); \
            PG8_WAIT_V(8); PG8_WAIT_L(0); PG8_BAR; if (FULL) { PG8_MMA(1, 0, At, B0); PG8_MMA(1, 1, At, B1); } PG8_BAR; PG8_SCHED; \
            PG8_LDB(B0, 1, 0); PG8_LDB(B1, 1, 1); PG8_SCHED; PG8_LDA(At, 1, 0); PG8_STA(PG8_SA(0, 1), a2, 1); \
            PG8_WAIT_V(8); PG8_WAIT_L(0); PG8_BAR; PG8_MMA(0, 0, At, B0); PG8_MMA(0, 1, At, B1); PG8_BAR; PG8_SCHED; \
            if (FULL) { PG8_LDA(At, 1, 1); } PG8_STAGE(PG8_SB(1, 0), b3, voffB); PG8_STAGE(PG8_SB(1, 1), b3 + hstep, voffB); PG8_STA(PG8_SA(1, 0), a3, 0); \
            PG8_WAIT_V(8); PG8_WAIT_L(0); PG8_BAR; if (FULL) { PG8_MMA(1, 0, At, B0); PG8_MMA(1, 1, At, B1); } PG8_BAR; PG8_SCHED; \
        }
        if constexpr (TAILS) { if (cur.half) { PG8_KLOOP(0) } else { PG8_KLOOP(1) } } else { PG8_KLOOP(1) }
#undef PG8_KLOOP
        if constexpr (ALIGN_EPI) { if (wr == 0) PG8_BAR; }
        { int fr_ = fr, fq_ = fq; asm volatile("" : "+v"(fr_), "+v"(fq_)); E(acc, cur, wr, wc, fr_, fq_); }
        if (!has_next) break;
#pragma unroll
        for (int a = 0; a < 2; ++a)
#pragma unroll
            for (int b = 0; b < 2; ++b)
#pragma unroll
                for (int m = 0; m < 4; ++m)
#pragma unroll
                    for (int n = 0; n < 2; ++n) acc[a][b][m][n] = (f32x4){0.f, 0.f, 0.f, 0.f};
        cur = nxt; cB = nB; cA = nA; ++ui;
        if constexpr (ALIGN_EPI) { if (wr == 1) PG8_BAR; }
    }
    PG8_WAIT_V(0);
    if constexpr (!ALIGN_EPI) { if (wr == 0) PG8_BAR; }
    PG8_BAR;
#undef PG8_SA
#undef PG8_SB
#undef PG8_STAGE
#undef PG8_LDA
#undef PG8_LD32
#undef PG8_LDB
#undef PG8_MMA
#undef PG8_CAT
#undef PG8_WAIT_V
#undef PG8_WAIT_L
#undef PG8_BAR
#undef PG8_SCHED
#undef PG8_AOFF
#undef PG8_STA
}

template <bool WT> __device__ __forceinline__ void st16(void* p, const u32x4 v) {
    if constexpr (WT) asm volatile("global_store_dwordx4 %0, %1, off sc1" :: "v"(p), "v"(v) : "memory");
    else *(u32x4*)p = v;
}
template <bool WT> __device__ __forceinline__ void st8(void* p, const u32x2 v) {
    if constexpr (WT) asm volatile("global_store_dwordx2 %0, %1, off sc1" :: "v"(p), "v"(v) : "memory");
    else *(u32x2*)p = v;
}
#ifndef EPI_WT
#define EPI_WT false
#endif
__device__ __forceinline__ u32x4 pack8(const f32x4 a, const f32x4 b) { u32x4 w; w.x = cvt_pk_bf16(a[0], a[1]); w.y = cvt_pk_bf16(a[2], a[3]); w.z = cvt_pk_bf16(b[0], b[1]); w.w = cvt_pk_bf16(b[2], b[3]); return w; }
struct EpiIn {
    static constexpr int PERM = 3; static constexpr bool LDSBIAS = false;
    bf16* proj; bf16* sg; float* la; float* ffl; const float* a_b; const float* fb;
    __device__ __forceinline__ void operator()(const f32x4 (&acc)[2][2][4][2], const Unit& u, int wr, int wc, int fr, int fq) const {
        const int pn = u.pn, rowb = u.pm * BM + wr * 64 + fr, cl0 = wc * 64 + 16 * fq;
        if (pn < 9) {
            bf16* base = proj + (size_t)pn * S * 256; const float sc = (pn == 0 || pn == 3) ? C2 : 1.f;
#pragma unroll
            for (int ai = 0; ai < 2; ++ai)
#pragma unroll
                for (int m = 0; m < 4; ++m) { bf16* rowp = base + (size_t)(rowb + ai * HALF + m * 16) * 256 + cl0;
#pragma unroll
                    for (int bj = 0; bj < 2; ++bj) st16<EPI_WT>(rowp + bj * 8, pack8(acc[ai][bj][m][0] * sc, acc[ai][bj][m][1] * sc)); }
        } else {
            if (wc < 2) {
#pragma unroll
                for (int bj = 0; bj < 2; ++bj)
#pragma unroll
                    for (int n = 0; n < 2; ++n) { const int c = cl0 + bj * 8 + n * 4; const f32x4 bv = *(const f32x4*)(a_b + c);
#pragma unroll
                        for (int ai = 0; ai < 2; ++ai)
#pragma unroll
                            for (int m = 0; m < 4; ++m) { const f32x4 v = acc[ai][bj][m][n] + bv; f32x4 o;
                                o[0] = logsigmoidf_(v[0]) * 0.0625f; o[1] = logsigmoidf_(v[1]) * 0.0625f; o[2] = logsigmoidf_(v[2]) * 0.0625f; o[3] = logsigmoidf_(v[3]) * 0.0625f;
                                *(f32x4*)(la + (size_t)(rowb + ai * HALF + m * 16) * 128 + c) = o; } } }
            if (wc == 2 && fq == 0) { const f32x4 bv = *(const f32x4*)fb;
#pragma unroll
                for (int ai = 0; ai < 2; ++ai)
#pragma unroll
                    for (int m = 0; m < 4; ++m) { const f32x4 v = acc[ai][0][m][0] + bv; f32x4 o;
                        o[0] = logsigmoidf_(v[0]); o[1] = logsigmoidf_(v[1]); o[2] = logsigmoidf_(v[2]); o[3] = logsigmoidf_(v[3]);
                        const size_t r_ = (size_t)(rowb + ai * HALF + m * 16); ffl[r_] = o[0]; ffl[S + r_] = o[1]; ffl[2 * (size_t)S + r_] = o[2]; ffl[3 * (size_t)S + r_] = o[3]; } }
        }
    }
};
#define GQ(g_) fmaxf(256.f * (g_), 0.001953125f)
struct EpiGate {
    static constexpr int PERM = 3; static constexpr bool LDSBIAS = false;
    unsigned char* sg;
    __device__ __forceinline__ void operator()(const f32x4 (&acc)[2][2][4][2], const Unit& u, int wr, int wc, int fr, int fq) const {
        unsigned char* base = sg + (size_t)(u.pm * 12 + u.pn) * 65536 + (((wr * 4 + wc) * 64 + fq * 16 + fr) * 16);
        constexpr float KS = -0.03125f * LOG2E;
#pragma unroll
        for (int ai = 0; ai < 2; ++ai)
#pragma unroll
            for (int m = 0; m < 4; ++m) { u32x4 w;
#pragma unroll
                for (int bj = 0; bj < 2; ++bj) { const f32x4 v0 = acc[ai][bj][m][0], v1 = acc[ai][bj][m][1];
                    w[2 * bj]     = cvt4_fp8(GQ(fast_rcp(1.f + fast_exp2(v0[0] * KS))), GQ(fast_rcp(1.f + fast_exp2(v0[1] * KS))), GQ(fast_rcp(1.f + fast_exp2(v0[2] * KS))), GQ(fast_rcp(1.f + fast_exp2(v0[3] * KS))));
                    w[2 * bj + 1] = cvt4_fp8(GQ(fast_rcp(1.f + fast_exp2(v1[0] * KS))), GQ(fast_rcp(1.f + fast_exp2(v1[1] * KS))), GQ(fast_rcp(1.f + fast_exp2(v1[2] * KS))), GQ(fast_rcp(1.f + fast_exp2(v1[3] * KS)))); }
                *(u32x4*)(base + (ai * 4 + m) * 8192) = w; }
    }
};
#undef GQ
struct EpiLift {
    static constexpr int PERM = 3; static constexpr bool LDSBIAS = false;
    const unsigned char* sg; bf16* mrg;
    __device__ __forceinline__ void hook(f32x4 (&acc)[2][2][4][2], const Unit& u, int seg, int wr, int wc, int fr, int fq) const {
        const unsigned char* ta = sg + (size_t)(u.pm * 12 + (seg - 1) * 4 + u.pn) * 65536 + (((wr * 4 + wc) * 64 + fq * 16 + fr) * 16);
        u32x4 ga[2][2], gb[2][2];
#define LIFT_LOAD(buf, ai, mh) do { _Pragma("unroll") for (int mm = 0; mm < 2; ++mm) { const int i_ = (ai) * 4 + (mh) * 2 + mm; ga[buf][mm] = *(const u32x4*)(ta + i_ * 8192); gb[buf][mm] = *(const u32x4*)(ta + 4 * 65536 + i_ * 8192); } } while (0)
#define LIFT_PIN(buf) asm volatile("" : "+v"(ga[buf][0]), "+v"(ga[buf][1]), "+v"(gb[buf][0]), "+v"(gb[buf][1]))
#define LIFT_R4(aw, bw) ({ const f32x2 al_ = __builtin_amdgcn_cvt_pk_f32_fp8((int)(aw), false), ah_ = __builtin_amdgcn_cvt_pk_f32_fp8((int)(aw), true), bl_ = __builtin_amdgcn_cvt_pk_f32_fp8((int)(bw), false), bh_ = __builtin_amdgcn_cvt_pk_f32_fp8((int)(bw), true); \
            (f32x4){al_[0] * fast_rcp(bl_[0]), al_[1] * fast_rcp(bl_[1]), ah_[0] * fast_rcp(bh_[0]), ah_[1] * fast_rcp(bh_[1])}; })
#define LIFT_COMP(buf, ai, mh) do { _Pragma("unroll") for (int mm = 0; mm < 2; ++mm) { const u32x4 a = ga[buf][mm], b = gb[buf][mm]; const int m_ = (mh) * 2 + mm; \
            acc[ai][0][m_][0] *= LIFT_R4(a.x, b.x); acc[ai][0][m_][1] *= LIFT_R4(a.y, b.y); acc[ai][1][m_][0] *= LIFT_R4(a.z, b.z); acc[ai][1][m_][1] *= LIFT_R4(a.w, b.w); } } while (0)
        LIFT_LOAD(0, 0, 0); LIFT_LOAD(1, 0, 1);
        LIFT_PIN(0); LIFT_COMP(0, 0, 0); LIFT_LOAD(0, 1, 0);
        LIFT_PIN(1); LIFT_COMP(1, 0, 1); LIFT_LOAD(1, 1, 1);
        LIFT_PIN(0); LIFT_COMP(0, 1, 0);
        LIFT_PIN(1); LIFT_COMP(1, 1, 1);
#undef LIFT_LOAD
#undef LIFT_PIN
#undef LIFT_R4
#undef LIFT_COMP
    }
    __device__ __forceinline__ void operator()(const f32x4 (&acc)[2][2][4][2], const Unit& u, int wr, int wc, int fr, int fq) const {
        const int rowb = u.pm * BM + wr * 64 + fr, col0 = u.pn * BM + wc * 64 + 16 * fq;
        const unsigned char* tg = sg + (size_t)(u.pm * 12 + 8 + u.pn) * 65536 + (((wr * 4 + wc) * 64 + fq * 16 + fr) * 16);
        u32x4 gw[2][4];
#pragma unroll
        for (int ai = 0; ai < 2; ++ai)
#pragma unroll
            for (int m = 0; m < 4; ++m) gw[ai][m] = *(const u32x4*)(tg + (ai * 4 + m) * 8192);
#pragma unroll
        for (int ai = 0; ai < 2; ++ai) {
            asm volatile("" : "+v"(gw[ai][0]), "+v"(gw[ai][1]), "+v"(gw[ai][2]), "+v"(gw[ai][3]));
#pragma unroll
            for (int m = 0; m < 4; ++m) { const size_t row = (size_t)(rowb + ai * HALF + m * 16);
#pragma unroll
                for (int bj = 0; bj < 2; ++bj) { const unsigned gx = bj ? gw[ai][m].z : gw[ai][m].x, gy = bj ? gw[ai][m].w : gw[ai][m].y;
                    const f32x2 a0 = __builtin_amdgcn_cvt_pk_f32_fp8((int)gx, false), a1 = __builtin_amdgcn_cvt_pk_f32_fp8((int)gx, true), b0 = __builtin_amdgcn_cvt_pk_f32_fp8((int)gy, false), b1 = __builtin_amdgcn_cvt_pk_f32_fp8((int)gy, true);
                    const f32x4 v0 = acc[ai][bj][m][0] * ((f32x4){a0[0], a0[1], a1[0], a1[1]} * 0.00390625f), v1 = acc[ai][bj][m][1] * ((f32x4){b0[0], b0[1], b1[0], b1[1]} * 0.00390625f);
                    st16<EPI_WT>(mrg + row * 1024 + col0 + bj * 8, pack8(v0, v1)); } } }
    }
};
struct EpiF32 {
    static constexpr int PERM = 3; static constexpr bool LDSBIAS = false;
    bf16* C;
    __device__ __forceinline__ void operator()(const f32x4 (&acc)[2][2][4][2], const Unit& u, int wr, int wc, int fr, int fq) const {
        const int rowb = u.pm * BM + wr * 64 + fr, col0 = u.pn * BM + wc * 64 + 16 * fq;
#pragma unroll
        for (int ai = 0; ai < 2; ++ai)
#pragma unroll
            for (int m = 0; m < 4; ++m) { bf16* rowp = C + (size_t)(rowb + ai * HALF + m * 16) * 1024 + col0;
#pragma unroll
                for (int bj = 0; bj < 2; ++bj) st16<EPI_WT>(rowp + bj * 8, pack8(acc[ai][bj][m][0], acc[ai][bj][m][1])); }
    }
};
struct EpiMoe1 {
    static constexpr bool PERM = true; static constexpr bool LDSBIAS = true;
    unsigned char* act; const float* b_gu; const LAS float* bl;
    __device__ __forceinline__ const float* bsrc(const Unit& u) const { return b_gu + (size_t)u.e * 2048 + u.pn * 256; }
    __device__ __forceinline__ void operator()(const f32x4 (&acc)[2][2][4][2], const Unit& u, int wr, int wc, int fr, int fq) const {
        const int rowb = u.pm * BM + wr * 64 + fr, j0 = u.pn * HALF + wc * 32 + 8 * fq; const LAS float* bb = bl + u.par * 256 + 2 * (wc * 32 + 8 * fq);
        f32x4 bq[4];
#pragma unroll
        for (int q = 0; q < 4; ++q) bq[q] = *(const LAS f32x4*)(bb + 4 * q);
        f32x4 bg[2], bu[2];
#pragma unroll
        for (int n = 0; n < 2; ++n) { bg[n] = (f32x4){bq[2 * n][0], bq[2 * n][2], bq[2 * n + 1][0], bq[2 * n + 1][2]}; bu[n] = (f32x4){bq[2 * n][1], bq[2 * n][3], bq[2 * n + 1][1], bq[2 * n + 1][3]}; }
#pragma unroll
        for (int ai = 0; ai < 2; ++ai) { if (ai == 1 && u.half) break;
#pragma unroll
            for (int m = 0; m < 4; ++m) { u32x2 w;
#pragma unroll
                for (int n = 0; n < 2; ++n) { const f32x4 hg = acc[ai][0][m][n] * 0.03125f + bg[n], hu = acc[ai][1][m][n] * 0.03125f + bu[n]; float o[4];
#pragma unroll
                    for (int i = 0; i < 4; ++i) { const float g = fminf(hg[i], 7.f), uu = fminf(fmaxf(hu[i], -7.f), 7.f); o[i] = (uu + 1.f) * (g * fast_rcp(1.f + fast_exp2(g * (-1.702f * LOG2E)))); }
                    w[n] = cvt4_fp8(o[0], o[1], o[2], o[3]); }
                st8<false>(act + (size_t)(rowb + ai * HALF + m * 16) * 1024 + j0, w); } }
    }
};
struct EpiMoe2 {
    static constexpr int PERM = 3; static constexpr bool LDSBIAS = true;
    bf16* yb; const float* b_dn; const LAS float* bl;
    __device__ __forceinline__ const float* bsrc(const Unit& u) const { return b_dn + (size_t)u.e * 1024 + u.pn * 256; }
    __device__ __forceinline__ void operator()(const f32x4 (&acc)[2][2][4][2], const Unit& u, int wr, int wc, int fr, int fq) const {
        const int rowb = u.pm * BM + wr * 64 + fr, col0 = u.pn * BM + wc * 64 + 16 * fq; const LAS float* bb = bl + u.par * 256 + wc * 64 + 16 * fq;
        f32x4 bva[2][2];
#pragma unroll
        for (int bj = 0; bj < 2; ++bj)
#pragma unroll
            for (int n = 0; n < 2; ++n) bva[bj][n] = *(const LAS f32x4*)(bb + bj * 8 + n * 4) * 16.f;
#define CL8(x_) __builtin_amdgcn_fmed3f((x_), -448.f, 448.f)
#pragma unroll
        for (int ai = 0; ai < 2; ++ai) { if (ai == 1 && u.half) break;
#pragma unroll
            for (int m = 0; m < 4; ++m) { u32x4 w;
#pragma unroll
                for (int bj = 0; bj < 2; ++bj)
#pragma unroll
                    for (int n = 0; n < 2; ++n) { const f32x4 y = acc[ai][bj][m][n] * 0.25f + bva[bj][n]; w[2 * bj + n] = cvt4_fp8(CL8(y[0]), CL8(y[1]), CL8(y[2]), CL8(y[3])); }
                *(u32x4*)((unsigned char*)yb + (size_t)(rowb + ai * HALF + m * 16) * 1024 + col0) = w; } }
#undef CL8
    }
};
}

#define XB_TMO      128
#define XB_XCNT(j)  (256  + 64 * (j))
#define XB_XSUB(j)  (1280 + 64 * (j))
#define XB_XGEN(j)  (2304 + 64 * (j))
#define XB_TOP      3328
#define XB_TOPGEN   3392
#define XCD_BAR_WORDS 3456
#define XB_SPIN_CAP (1u << 22)
__device__ __forceinline__ unsigned xb_ld(unsigned* p)              { return __hip_atomic_load(p, __ATOMIC_RELAXED, __HIP_MEMORY_SCOPE_AGENT); }
__device__ __forceinline__ unsigned xb_add(unsigned* p, unsigned v) { return __hip_atomic_fetch_add(p, v, __ATOMIC_RELAXED, __HIP_MEMORY_SCOPE_AGENT); }
__device__ __forceinline__ unsigned xb_xcc_id() { return (unsigned)__builtin_amdgcn_s_getreg((3 << 11) | 20) & 0xFu; }
#define XB_SPIN(cond, bar) do { unsigned _sp = 0; while (cond) { __builtin_amdgcn_s_sleep(1); \
    if ((++_sp & 255u) == 0u) { if (xb_ld(&(bar)[XB_TMO])) break; if (_sp > XB_SPIN_CAP) { atomicAdd(&(bar)[XB_TMO], 1u); break; } } } } while (0)
struct XcdBarrier { unsigned* bar; unsigned x; volatile LAS unsigned* st; };
__device__ __forceinline__ XcdBarrier xcd_barrier_post(unsigned* bar, volatile LAS unsigned* st, const bool t0) {
    XcdBarrier b; b.bar = bar; b.x = xb_xcc_id(); b.st = st;
    if (t0) (void)xb_add(&bar[XB_XCNT(b.x)], 1u);
    return b;
}
__device__ __forceinline__ void xcd_barrier_complete(unsigned* bar, unsigned x, unsigned& nloc, unsigned& nx) {
    const unsigned G = gridDim.x * gridDim.y * gridDim.z;
    unsigned sum, cnt, mine, sp = 0u;
    for (;;) {
        sum = 0u; cnt = 0u; mine = 0u;
#pragma unroll
        for (unsigned j = 0; j < 16; ++j) { const unsigned c = xb_ld(&bar[XB_XCNT(j)]); sum += c; cnt += (c > 0u) ? 1u : 0u; mine = (j == x) ? c : mine; }
        if (sum == G) break;
        __builtin_amdgcn_s_sleep(1);
        if ((++sp & 255u) == 0u) { if (xb_ld(&bar[XB_TMO])) break; if (sp > XB_SPIN_CAP) { atomicAdd(&bar[XB_TMO], 1u); break; } }
    }
    nloc = mine > 0u ? mine : 1u; nx = cnt > 0u ? cnt : 1u;
}
__device__ __forceinline__ void xcd_barrier(const XcdBarrier& b, const bool t0) {
    asm volatile("s_waitcnt vmcnt(0)" ::: "memory");
    __syncthreads();
    if (t0) {
        unsigned* bar = b.bar;
        __builtin_amdgcn_s_waitcnt(0);
        unsigned nloc = b.st[0], nx = b.st[1];
        if (nloc == 0u) { xcd_barrier_complete(bar, b.x, nloc, nx); b.st[0] = nloc; b.st[1] = nx; }
        const unsigned old = xb_add(&bar[XB_XSUB(b.x)], 1u);
        const unsigned gen = old / nloc;
        if (old + 1u == (gen + 1u) * nloc) {
            __builtin_amdgcn_fence(__ATOMIC_RELEASE, "agent");
            asm volatile("s_waitcnt vmcnt(0)" ::: "memory");
            const unsigned og = xb_add(&bar[XB_TOP], 1u);
            const unsigned tg = og / nx;
            if (og + 1u == (tg + 1u) * nx) xb_add(&bar[XB_TOPGEN], 1u);
            else XB_SPIN(xb_ld(&bar[XB_TOPGEN]) == tg, bar);
            __builtin_amdgcn_fence(__ATOMIC_ACQUIRE, "agent");
            xb_add(&bar[XB_XGEN(b.x)], 1u);
            asm volatile("s_waitcnt vmcnt(0)" ::: "memory");
        } else {
            XB_SPIN(xb_ld(&bar[XB_XGEN(b.x)]) == gen, bar);
            __builtin_amdgcn_fence(__ATOMIC_ACQUIRE, "agent");
            asm volatile("s_waitcnt vmcnt(0)" ::: "memory");
        }
    }
    __syncthreads();
}

struct MapGate { __device__ __forceinline__ int operator()(int c) const { return c >= 2324 ? c - 2324 : -1; } };
struct MapIdent { __device__ __forceinline__ int operator()(int c) const { return c; } };
struct MapGU { __device__ __forceinline__ int operator()(int c) const { const int j = c >> 1, up = c & 1; return ((j >> 7) << 8) + (up << 7) + (j & 127); } };
struct MapIn { __device__ __forceinline__ int operator()(int c) const {
    if (c < 768) return c;
    if (c < 772) return 2432 + (c - 768);
    if (c < 1028) return 1536 + (c - 772);
    if (c < 1284) return 1792 + (c - 1028);
    if (c < 1300) return -1;
    if (c < 1556) return 2048 + (c - 1300);
    if (c < 2324) return 768 + (c - 1556);
    return -1;
} };
template <class RowMap>
__device__ __forceinline__ void transpose_item_fp8(const float* W, int K, int N, unsigned char* WT, LAS float* scr, int item, int lane, RowMap rm, float sc) {
    const int nblk = (N + 31) / 32, kb = item / nblk, nb = item % nblk, k0 = 64 * kb, n0 = 32 * nb;
    const int nn = n0 + (lane & 31);
#pragma unroll 32
    for (int i = 0; i < 32; ++i) { const int kk = 2 * i + (lane >> 5); scr[kk * 33 + (lane & 31)] = nn < N ? W[(size_t)(k0 + kk) * N + nn] : 0.f; }
    asm volatile("s_waitcnt lgkmcnt(0)" ::: "memory");
    const int c = lane & 7;
#pragma unroll
    for (int j = 0; j < 4; ++j) { const int n = (lane >> 3) + 8 * j; const LAS float* s = scr + (8 * c) * 33 + n;
        const int row = (n0 + n < N) ? rm(n0 + n) : -1;
        if (row >= 0) { u32x2 o; o.x = cvt4_fp8(s[0 * 33] * sc, s[1 * 33] * sc, s[2 * 33] * sc, s[3 * 33] * sc); o.y = cvt4_fp8(s[4 * 33] * sc, s[5 * 33] * sc, s[6 * 33] * sc, s[7 * 33] * sc);
            *(u32x2*)(WT + (size_t)row * K + k0 + 8 * c) = o; } }
    asm volatile("s_waitcnt lgkmcnt(0)" ::: "memory");
}
template <class RowMap>
__device__ __forceinline__ void convert_item_fp8(const float* W, int K, int N, unsigned char* WT, int item, int lane, RowMap rm, float sc) {
    const int nblk = N / 64, kb = item / nblk, nb = item % nblk, k0 = 128 * kb, n0 = 64 * nb;
    const float* src = W + (size_t)k0 * N + n0 + lane;
    float v[128];
#pragma unroll
    for (int i = 0; i < 128; ++i) v[i] = src[(size_t)i * N];
#pragma unroll
    for (int g = 0; g < 8; ++g)
        asm volatile("" : "+v"(v[g * 16 + 0]), "+v"(v[g * 16 + 1]), "+v"(v[g * 16 + 2]), "+v"(v[g * 16 + 3]), "+v"(v[g * 16 + 4]), "+v"(v[g * 16 + 5]), "+v"(v[g * 16 + 6]), "+v"(v[g * 16 + 7]),
                          "+v"(v[g * 16 + 8]), "+v"(v[g * 16 + 9]), "+v"(v[g * 16 + 10]), "+v"(v[g * 16 + 11]), "+v"(v[g * 16 + 12]), "+v"(v[g * 16 + 13]), "+v"(v[g * 16 + 14]), "+v"(v[g * 16 + 15]));
    unsigned char* dst = WT + (size_t)rm(n0 + lane) * K + k0;
#pragma unroll
    for (int q = 0; q < 8; ++q) { u32x4 o;
        o.x = cvt4_fp8(v[q * 16 + 0] * sc, v[q * 16 + 1] * sc, v[q * 16 + 2] * sc, v[q * 16 + 3] * sc); o.y = cvt4_fp8(v[q * 16 + 4] * sc, v[q * 16 + 5] * sc, v[q * 16 + 6] * sc, v[q * 16 + 7] * sc);
        o.z = cvt4_fp8(v[q * 16 + 8] * sc, v[q * 16 + 9] * sc, v[q * 16 + 10] * sc, v[q * 16 + 11] * sc); o.w = cvt4_fp8(v[q * 16 + 12] * sc, v[q * 16 + 13] * sc, v[q * 16 + 14] * sc, v[q * 16 + 15] * sc);
        *(u32x4*)(dst + q * 16) = o; }
}
template <class RowMap>
__device__ __forceinline__ void transpose_item(const float* W, int K, int N, bf16* WT, LAS float* scr, int item, int lane, RowMap rm, int ldk = 0) {
    if (ldk == 0) ldk = K;
    const int nblk = (N + 31) / 32, kb = item / nblk, nb = item % nblk, k0 = 64 * kb, n0 = 32 * nb;
    const int nn = n0 + (lane & 31);
#pragma unroll 32
    for (int i = 0; i < 32; ++i) { const int kk = 2 * i + (lane >> 5); scr[kk * 33 + (lane & 31)] = nn < N ? W[(size_t)(k0 + kk) * N + nn] : 0.f; }
    asm volatile("s_waitcnt lgkmcnt(0)" ::: "memory");
    const int c = lane & 7;
#pragma unroll
    for (int j = 0; j < 4; ++j) { const int n = (lane >> 3) + 8 * j; const LAS float* s = scr + (8 * c) * 33 + n;
        const int row = (n0 + n < N) ? rm(n0 + n) : -1;
        if (row >= 0) { u32x4 o; o.x = cvt_pk_bf16(s[0 * 33], s[1 * 33]); o.y = cvt_pk_bf16(s[2 * 33], s[3 * 33]); o.z = cvt_pk_bf16(s[4 * 33], s[5 * 33]); o.w = cvt_pk_bf16(s[6 * 33], s[7 * 33]);
            *(u32x4*)(WT + (size_t)row * ldk + k0 + 8 * c) = o; } }
    asm volatile("s_waitcnt lgkmcnt(0)" ::: "memory");
}

__device__ __forceinline__ void transpose_item_win(const float* W, bf16* WT, unsigned char* WT8, LAS float* scr, int item, int lane) {
    const int K = 1024, N = D_IN; const int nblk = (N + 31) / 32, kb = item / nblk, nb = item % nblk, k0 = 64 * kb, n0 = 32 * nb;
    const int nn = n0 + (lane & 31);
#pragma unroll 32
    for (int i = 0; i < 32; ++i) { const int kk = 2 * i + (lane >> 5); scr[kk * 33 + (lane & 31)] = nn < N ? W[(size_t)(k0 + kk) * N + nn] : 0.f; }
    asm volatile("s_waitcnt lgkmcnt(0)" ::: "memory");
    const int c = lane & 7;
#pragma unroll
    for (int j = 0; j < 4; ++j) { const int n = (lane >> 3) + 8 * j; const LAS float* s = scr + (8 * c) * 33 + n;
        const int row = (n0 + n < N) ? MapIn()(n0 + n) : -1, row8 = (n0 + n < N) ? MapGate()(n0 + n) : -1;
        if (row >= 0) { u32x4 o; o.x = cvt_pk_bf16(s[0 * 33], s[1 * 33]); o.y = cvt_pk_bf16(s[2 * 33], s[3 * 33]); o.z = cvt_pk_bf16(s[4 * 33], s[5 * 33]); o.w = cvt_pk_bf16(s[6 * 33], s[7 * 33]);
            *(u32x4*)(WT + (size_t)row * K + k0 + 8 * c) = o; }
        if (row8 >= 0) { u32x2 o; o.x = cvt4_fp8(s[0 * 33] * 32.f, s[1 * 33] * 32.f, s[2 * 33] * 32.f, s[3 * 33] * 32.f); o.y = cvt4_fp8(s[4 * 33] * 32.f, s[5 * 33] * 32.f, s[6 * 33] * 32.f, s[7 * 33] * 32.f);
            *(u32x2*)(WT8 + (size_t)row8 * K + k0 + 8 * c) = o; } }
    asm volatile("s_waitcnt lgkmcnt(0)" ::: "memory");
}

struct Args { const float* in[18]; float* out; unsigned char* ws; int ph_lo, ph_hi; };

#define CAS __attribute__((address_space(4)))
#define KARG_IN(kp, i) (*(const float* const CAS*)((kp) + 8 * (i)))
#define KARG_OUT(kp) (*(float* const CAS*)((kp) + 144))
#define KARG_WS(kp) (*(unsigned char* const CAS*)((kp) + 152))
__device__ __forceinline__ void p0_prologue(const CAS unsigned char* kp, LAS unsigned char* lds, int vcu, int G, int tid) {
    const int lane = tid & 63, wave = tid >> 6;
    LAS float* scr = (LAS float*)(lds + wave * 16384);
    unsigned char* ws = KARG_WS(kp);
    const int gw = vcu * 8 + wave, NGW = G * 8;
    constexpr int I_IN = 16 * 169, I_BR = 4 * 32, I_OUT = 16 * 32, I_GU = 8 * 32, I_DN = 8 * 16;
    constexpr int PER_L = I_IN + 3 * I_BR + I_OUT + 32 * I_GU + 32 * I_DN;
    for (int it = gw; it < DEPTH * PER_L; it += NGW) {
        const int l = it / PER_L; int r = it % PER_L;
        if (r < I_IN) { transpose_item_win(KARG_IN(kp, 1) + (size_t)l * 1024 * D_IN, (bf16*)(ws + WS_WIN) + (size_t)l * NIN * 1024, (unsigned char*)(ws + WS_WIN8) + (size_t)l * 3072 * 1024, scr, r, lane); continue; } r -= I_IN;
        if (r < 3 * I_BR) { const int nb = r / I_BR; transpose_item(KARG_IN(kp, 6) + ((size_t)l * 3 + nb) * 256 * 1024, 256, 1024, (bf16*)(ws + WS_WBR) + (size_t)l * 1024 * 768 + nb * 256, scr, r % I_BR, lane, MapIdent(), 768); continue; } r -= 3 * I_BR;
        if (r < I_OUT) { transpose_item(KARG_IN(kp, 7) + (size_t)l * 1024 * 1024, 1024, 1024, (bf16*)(ws + WS_WOUT) + (size_t)l * 1024 * 1024, scr, r, lane, MapIdent()); continue; } r -= I_OUT;
        if (r < 32 * I_GU) { const int e = r / I_GU; convert_item_fp8(KARG_IN(kp, 12) + ((size_t)l * 32 + e) * 1024 * 2048, 1024, 2048, (unsigned char*)(ws + WS_WGU) + ((size_t)l * 32 + e) * 2048 * 1024, r % I_GU, lane, MapGU(), 32.f); continue; } r -= 32 * I_GU;
        { const int e = r / I_DN; convert_item_fp8(KARG_IN(kp, 14) + ((size_t)l * 32 + e) * 1024 * 1024, 1024, 1024, (unsigned char*)(ws + WS_WDN) + ((size_t)l * 32 + e) * 1024 * 1024, r % I_DN, lane, MapIdent(), 64.f); }
    }
    const int gt = vcu * 512 + tid, NT = G * 512;
    for (int i = gt; i < DEPTH * 128 * 1024; i += NT) { const int l = i >> 17, j = (i >> 10) & 127, k = i & 1023;
        const float* wr_ = KARG_IN(kp, 1) + ((size_t)l * 1024 + k) * D_IN + 1284; const float* au = KARG_IN(kp, 3) + (size_t)l * 16 * 128 + j; float s = 0.f;
#pragma unroll
        for (int r = 0; r < 16; ++r) s += wr_[r] * au[r * 128];
        ((bf16*)(ws + WS_WIN))[((size_t)l * NIN + 2304 + j) * 1024 + k] = (bf16)(cvt_pk_bf16(s, 0.f) & 0xffffu); }
    for (int i = gt; i < DEPTH * 124 * 1024 / 8; i += NT) { const int l = i / (124 * 128), rr = i % (124 * 128);
        *(u32x4*)((bf16*)(ws + WS_WIN) + ((size_t)l * NIN + 2436) * 1024 + (size_t)rr * 8) = (u32x4){0u, 0u, 0u, 0u}; }
    for (int i = gt; i < DEPTH * 32 * 1024; i += NT) { const int l = i >> 15, e = (i >> 10) & 31, k = i & 1023; const float w = KARG_IN(kp, 10)[((size_t)l * 1024 + k) * 32 + e];
        const unsigned hb = cvt_pk_bf16(w, 0.f) & 0xffffu; const float rem = w - __uint_as_float(hb << 16); const unsigned lb = cvt_pk_bf16(rem, 0.f) & 0xffffu;
        bf16* wt = (bf16*)(ws + WS_WRT) + (size_t)l * 65536; wt[e * 1024 + k] = (bf16)hb; wt[32768 + e * 1024 + k] = (bf16)lb; }
    for (int i = gt; i < S * D / 8; i += NT) { const f32x4 v0 = *(const f32x4*)(KARG_IN(kp, 0) + (size_t)i * 8), v1 = *(const f32x4*)(KARG_IN(kp, 0) + (size_t)i * 8 + 4);
        u32x4 o; o.x = cvt_pk_bf16(v0[0], v0[1]); o.y = cvt_pk_bf16(v0[2], v0[3]); o.z = cvt_pk_bf16(v1[0], v1[1]); o.w = cvt_pk_bf16(v1[2], v1[3]);
        *(u32x4*)((bf16*)(ws + WS_XB) + (size_t)i * 8) = o;
        u32x2 o8; o8.x = cvt4_fp8(v0[0], v0[1], v0[2], v0[3]); o8.y = cvt4_fp8(v1[0], v1[1], v1[2], v1[3]); *(u32x2*)((unsigned char*)(ws + WS_XB8) + (size_t)i * 8) = o8; }
}

__device__ __forceinline__ void gla_cumsum(LAS float* bb, LAS float* scn, int tid) {
    const int k = tid & 31, seg = (tid >> 5) & 7; float loc[8]; float run = 0.f;
    if (tid < 256) {
#pragma unroll
        for (int i = 0; i < 8; ++i) { run += bb[(seg * 8 + i) * 32 + k]; loc[i] = run; }
        scn[seg * 32 + k] = run; }
    __syncthreads();
    if (tid < 256) { float pre = 0.f;
#pragma unroll
        for (int s2 = 0; s2 < 7; ++s2) pre += (s2 < seg) ? scn[s2 * 32 + k] : 0.f;
#pragma unroll
        for (int i = 0; i < 8; ++i) bb[(seg * 8 + i) * 32 + k] = loc[i] + pre; }
    __syncthreads();
}
__device__ __forceinline__ void gla_local_unit(LAS unsigned char* lds, int tid, int ci, int h, const bf16* GQK, const bf16* GV, const float* LAp, float* U, float* DEC) {
    LAS float* kb = (LAS float*)lds;
    LAS float* vb = kb + 64 * 33;
    LAS float* bb = vb + 64 * 64;
    LAS float* scn = bb + 64 * 32;
    const int t0 = ci * 64; const int r = tid >> 3;
    { const int c4 = (tid & 7) * 4; const u32x2 w = *(const u32x2*)(GQK + (size_t)(t0 + r) * 256 + 128 + h * 32 + c4);
      kb[r * 33 + c4 + 0] = bf_lo(w.x); kb[r * 33 + c4 + 1] = bf_hi(w.x); kb[r * 33 + c4 + 2] = bf_lo(w.y); kb[r * 33 + c4 + 3] = bf_hi(w.y);
      const f32x4 a = *(const f32x4*)(LAp + (size_t)(t0 + r) * 128 + h * 32 + c4); *(LAS f32x4*)(bb + r * 32 + c4) = a; }
    { const int c8 = (tid & 7) * 8; const u32x4 w = *(const u32x4*)(GV + (size_t)(t0 + r) * 256 + h * 64 + c8);
      *(LAS f32x4*)(vb + r * 64 + c8) = (f32x4){bf_lo(w.x), bf_hi(w.x), bf_lo(w.y), bf_hi(w.y)}; *(LAS f32x4*)(vb + r * 64 + c8 + 4) = (f32x4){bf_lo(w.z), bf_hi(w.z), bf_lo(w.w), bf_hi(w.w)}; }
    __syncthreads();
    gla_cumsum(bb, scn, tid);
    for (int idx = tid; idx < 2048; idx += 512) { const int c = idx >> 5, k = idx & 31; kb[c * 33 + k] *= __expf(bb[63 * 32 + k] - bb[c * 32 + k]); }
    __syncthreads();
    { const int k = tid >> 4, v0 = (tid & 15) * 4; f32x4 acc = (f32x4){0.f, 0.f, 0.f, 0.f};
#pragma unroll 8
      for (int c = 0; c < 64; ++c) { const float kk = kb[c * 33 + k]; const f32x4 vv = *(const LAS f32x4*)(vb + c * 64 + v0); acc += vv * kk; }
      *(f32x4*)(U + ((size_t)(ci * 4 + h) * 32 + k) * 64 + v0) = acc; }
    if (tid < 32) DEC[(ci * 4 + h) * 32 + tid] = __expf(bb[63 * 32 + tid]);
    __syncthreads();
}
__device__ __forceinline__ void gla_out_unit(LAS unsigned char* lds, int tid, int ci, int h, const bf16* GQK, const bf16* GV, const bf16* GR, const float* LAp, const float* SST, const float* ng, bf16* Y) {
    LAS float* qb = (LAS float*)lds;
    LAS float* kb = qb + 64 * 33;
    LAS float* vb = kb + 64 * 33;
    LAS float* bb = vb + 64 * 64;
    LAS float* Ab = bb + 64 * 32;
    LAS float* Sb = Ab + 64 * 65;
    LAS float* scn = Sb + 32 * 64;
    const int t0 = ci * 64; const int r = tid >> 3;
    { const int c4 = (tid & 7) * 4; const u32x2 wq = *(const u32x2*)(GQK + (size_t)(t0 + r) * 256 + h * 32 + c4); const u32x2 wk = *(const u32x2*)(GQK + (size_t)(t0 + r) * 256 + 128 + h * 32 + c4);
      qb[r * 33 + c4 + 0] = bf_lo(wq.x); qb[r * 33 + c4 + 1] = bf_hi(wq.x); qb[r * 33 + c4 + 2] = bf_lo(wq.y); qb[r * 33 + c4 + 3] = bf_hi(wq.y);
      kb[r * 33 + c4 + 0] = bf_lo(wk.x); kb[r * 33 + c4 + 1] = bf_hi(wk.x); kb[r * 33 + c4 + 2] = bf_lo(wk.y); kb[r * 33 + c4 + 3] = bf_hi(wk.y);
      const f32x4 a = *(const f32x4*)(LAp + (size_t)(t0 + r) * 128 + h * 32 + c4); *(LAS f32x4*)(bb + r * 32 + c4) = a; }
    { const int c8 = (tid & 7) * 8; const u32x4 w = *(const u32x4*)(GV + (size_t)(t0 + r) * 256 + h * 64 + c8);
      *(LAS f32x4*)(vb + r * 64 + c8) = (f32x4){bf_lo(w.x), bf_hi(w.x), bf_lo(w.y), bf_hi(w.y)}; *(LAS f32x4*)(vb + r * 64 + c8 + 4) = (f32x4){bf_lo(w.z), bf_hi(w.z), bf_lo(w.w), bf_hi(w.w)}; }
    { const f32x4 s4 = *(const f32x4*)(SST + (size_t)(ci * 4 + h) * 2048 + tid * 4); *(LAS f32x4*)(Sb + tid * 4) = s4; }
    __syncthreads();
    gla_cumsum(bb, scn, tid);
    for (int idx = tid; idx < 2048; idx += 512) { const int c = idx >> 5, k = idx & 31; const float b = bb[c * 32 + k];
        qb[c * 33 + k] *= 0.17677669529663687f * __expf(b); kb[c * 33 + k] *= __expf(-b); }
    __syncthreads();
    { const int t = tid >> 3, s0 = (tid & 7) * 8; float a[8];
#pragma unroll
      for (int i = 0; i < 8; ++i) a[i] = 0.f;
      for (int k = 0; k < 32; ++k) { const float qv = qb[t * 33 + k];
#pragma unroll
          for (int i = 0; i < 8; ++i) a[i] += qv * kb[(s0 + i) * 33 + k]; }
#pragma unroll
      for (int i = 0; i < 8; ++i) Ab[t * 65 + s0 + i] = (s0 + i <= t) ? a[i] : 0.f; }
    __syncthreads();
    { const int t = tid >> 3, v0 = (tid & 7) * 8; f32x4 o0 = (f32x4){0.f, 0.f, 0.f, 0.f}, o1 = o0;
      for (int s = 0; s < 64; ++s) { const float av = Ab[t * 65 + s]; o0 += *(const LAS f32x4*)(vb + s * 64 + v0) * av; o1 += *(const LAS f32x4*)(vb + s * 64 + v0 + 4) * av; }
      for (int k = 0; k < 32; ++k) { const float qv = qb[t * 33 + k]; o0 += *(const LAS f32x4*)(Sb + k * 64 + v0) * qv; o1 += *(const LAS f32x4*)(Sb + k * 64 + v0 + 4) * qv; }
      float ss = o0[0] * o0[0] + o0[1] * o0[1] + o0[2] * o0[2] + o0[3] * o0[3] + o1[0] * o1[0] + o1[1] * o1[1] + o1[2] * o1[2] + o1[3] * o1[3];
      ss += shx(ss, 1); ss += shx(ss, 2); ss += shx(ss, 4);
      const float rinv = 1.0f / sqrtf(ss * (1.f / 64.f) + RMS_EPS);
      const size_t tok = (size_t)(t0 + t); const u32x4 gw = *(const u32x4*)(GR + tok * 256 + h * 64 + v0);
      const f32x4 g0 = *(const f32x4*)(ng + h * 64 + v0), g1 = *(const f32x4*)(ng + h * 64 + v0 + 4);
      float gr[8] = {bf_lo(gw.x), bf_hi(gw.x), bf_lo(gw.y), bf_hi(gw.y), bf_lo(gw.z), bf_hi(gw.z), bf_lo(gw.w), bf_hi(gw.w)}; float y[8];
#pragma unroll
      for (int i = 0; i < 4; ++i) { y[i] = o0[i] * rinv * g0[i] * (gr[i] * sigmoidf_(gr[i])); y[4 + i] = o1[i] * rinv * g1[i] * (gr[4 + i] * sigmoidf_(gr[4 + i])); }
      u32x4 w; w.x = cvt_pk_bf16(y[0], y[1]); w.y = cvt_pk_bf16(y[2], y[3]); w.z = cvt_pk_bf16(y[4], y[5]); w.w = cvt_pk_bf16(y[6], y[7]);
      *(u32x4*)(Y + tok * 768 + h * 64 + v0) = w; }
    __syncthreads();
}


typedef float f32x16g __attribute__((ext_vector_type(16)));
__device__ __forceinline__ bf16x8 pack8(const float* x) { u32x4 w; w.x = cvt_pk_bf16(x[0], x[1]); w.y = cvt_pk_bf16(x[2], x[3]); w.z = cvt_pk_bf16(x[4], x[5]); w.w = cvt_pk_bf16(x[6], x[7]); return __builtin_bit_cast(bf16x8, w); }
__device__ __forceinline__ void gla_wave_cumsum(const float* LAp, size_t tok, int h, int lane, float (&b)[32]) {
#pragma unroll
    for (int j = 0; j < 8; ++j) { const f32x4 a = *(const f32x4*)(LAp + tok * 128 + h * 32 + j * 4); b[j * 4] = a[0]; b[j * 4 + 1] = a[1]; b[j * 4 + 2] = a[2]; b[j * 4 + 3] = a[3]; }
#pragma unroll
    for (int o = 1; o < 64; o <<= 1) {
#pragma unroll
        for (int k = 0; k < 32; ++k) { const float y = shu(b[k], o); b[k] += (lane >= o) ? y : 0.f; } }
}
__device__ __forceinline__ void load32bf(const bf16* p, float (&x)[32]) {
#pragma unroll
    for (int j = 0; j < 4; ++j) { const u32x4 w = *(const u32x4*)(p + j * 8); x[j * 8] = bf_lo(w.x); x[j * 8 + 1] = bf_hi(w.x); x[j * 8 + 2] = bf_lo(w.y); x[j * 8 + 3] = bf_hi(w.y); x[j * 8 + 4] = bf_lo(w.z); x[j * 8 + 5] = bf_hi(w.z); x[j * 8 + 6] = bf_lo(w.w); x[j * 8 + 7] = bf_hi(w.w); }
}
__device__ __forceinline__ void gla_stage_vt(LAS unsigned char* wl, const bf16* GV, size_t tok, int h, int lane) {
    u32x4 w[8];
#pragma unroll
    for (int j = 0; j < 8; ++j) w[j] = *(const u32x4*)(GV + tok * 256 + h * 64 + j * 8);
    asm volatile("" : "+v"(w[0]), "+v"(w[1]), "+v"(w[2]), "+v"(w[3]), "+v"(w[4]), "+v"(w[5]), "+v"(w[6]), "+v"(w[7]));
#pragma unroll
    for (int j = 0; j < 8; ++j) { const unsigned ww[4] = {w[j].x, w[j].y, w[j].z, w[j].w};
#pragma unroll
        for (int e = 0; e < 4; ++e) { *(LAS bf16*)(wl + 8192 + (j * 8 + 2 * e) * 128 + lane * 2) = (bf16)(ww[e] & 0xffffu); *(LAS bf16*)(wl + 8192 + (j * 8 + 2 * e + 1) * 128 + lane * 2) = (bf16)(ww[e] >> 16); } }
}
__device__ __forceinline__ void gla_local_wave(LAS unsigned char* wl, int lane, int ci, int h, const bf16* GQK, const bf16* GV, const float* LAp, float* U, float* DEC) {
    const size_t tok = (size_t)ci * 64 + lane; const int r32 = lane & 31, hi = lane >> 5;
    float b[32]; gla_wave_cumsum(LAp, tok, h, lane, b);
    float kx[32]; load32bf(GQK + tok * 256 + 128 + h * 32, kx);
    float myl = 0.f;
#pragma unroll
    for (int k = 0; k < 32; ++k) { const float bl = __uint_as_float((unsigned)__builtin_amdgcn_readlane((int)__float_as_uint(b[k]), 63)); kx[k] *= __expf(bl - b[k]); myl = (lane == k) ? bl : myl;
        *(LAS bf16*)(wl + k * 128 + lane * 2) = (bf16)(cvt_pk_bf16(kx[k], 0.f) & 0xffffu); }
    if (lane < 32) DEC[(ci * 4 + h) * 32 + lane] = __expf(myl);
    gla_stage_vt(wl, GV, tok, h, lane);
    asm volatile("s_waitcnt lgkmcnt(0)" ::: "memory");
    f32x16g u0 = {}, u1 = {};
#pragma unroll
    for (int st = 0; st < 4; ++st) { const bf16x8 ka = *(const LAS bf16x8*)(wl + r32 * 128 + (8 * hi + 16 * st) * 2);
        const bf16x8 v0 = *(const LAS bf16x8*)(wl + 8192 + r32 * 128 + (8 * hi + 16 * st) * 2), v1 = *(const LAS bf16x8*)(wl + 8192 + (r32 + 32) * 128 + (8 * hi + 16 * st) * 2);
        u0 = __builtin_amdgcn_mfma_f32_32x32x16_bf16(ka, v0, u0, 0, 0, 0); u1 = __builtin_amdgcn_mfma_f32_32x32x16_bf16(ka, v1, u1, 0, 0, 0); }
    float* up = U + (size_t)(ci * 4 + h) * 2048;
#pragma unroll
    for (int r = 0; r < 16; ++r) { const int k = (r & 3) + 8 * (r >> 2) + 4 * hi; up[k * 64 + r32] = u0[r]; up[k * 64 + 32 + r32] = u1[r]; }
    asm volatile("s_waitcnt lgkmcnt(0)" ::: "memory");
}
__device__ __forceinline__ void gla_out_wave(LAS unsigned char* wl, int lane, int ci, int h, const bf16* GQK, const bf16* GV, const bf16* GR, const float* LAp, const float* SST, const float* ng, bf16* Y) {
    const size_t tok = (size_t)ci * 64 + lane; const int r32 = lane & 31, hi = lane >> 5;
    { float b[32]; gla_wave_cumsum(LAp, tok, h, lane, b);
      float qx[32], kx[32]; load32bf(GQK + tok * 256 + h * 32, qx); load32bf(GQK + tok * 256 + 128 + h * 32, kx);
#pragma unroll
      for (int k = 0; k < 32; ++k) { const float eb = __expf(b[k]); qx[k] *= 0.17677669529663687f * eb; kx[k] *= fast_rcp(eb); }
#pragma unroll
      for (int j = 0; j < 4; ++j) { *(LAS bf16x8*)(wl + lane * 64 + j * 16) = pack8(qx + j * 8); *(LAS bf16x8*)(wl + 4096 + lane * 64 + j * 16) = pack8(kx + j * 8); } }
    gla_stage_vt(wl, GV, tok, h, lane);
    asm volatile("s_waitcnt lgkmcnt(0)" ::: "memory");
    bf16x8 qf[2][2], kf[2][2];
#pragma unroll
    for (int tb = 0; tb < 2; ++tb)
#pragma unroll
        for (int st = 0; st < 2; ++st) { qf[tb][st] = *(const LAS bf16x8*)(wl + (r32 + 32 * tb) * 64 + (8 * hi + 16 * st) * 2); kf[tb][st] = *(const LAS bf16x8*)(wl + 4096 + (r32 + 32 * tb) * 64 + (8 * hi + 16 * st) * 2); }
    f32x16g a00 = {}, a01 = {}, a11 = {};
#pragma unroll
    for (int st = 0; st < 2; ++st) { a00 = __builtin_amdgcn_mfma_f32_32x32x16_bf16(kf[0][st], qf[0][st], a00, 0, 0, 0); a01 = __builtin_amdgcn_mfma_f32_32x32x16_bf16(kf[0][st], qf[1][st], a01, 0, 0, 0); a11 = __builtin_amdgcn_mfma_f32_32x32x16_bf16(kf[1][st], qf[1][st], a11, 0, 0, 0); }
    bf16x8 p00[2], p01[2], p11[2];
    { float t0[16], t1[16], t2[16];
#pragma unroll
      for (int r = 0; r < 16; ++r) { const bool keep = ((r & 3) + 8 * (r >> 2) + 4 * hi) <= r32; t0[r] = keep ? a00[r] : 0.f; t1[r] = a01[r]; t2[r] = keep ? a11[r] : 0.f; }
      p00[0] = pack8(t0); p00[1] = pack8(t0 + 8); p01[0] = pack8(t1); p01[1] = pack8(t1 + 8); p11[0] = pack8(t2); p11[1] = pack8(t2 + 8); }
    f32x16g o[2][2] = {};
    const float* sp = SST + (size_t)(ci * 4 + h) * 2048;
#pragma unroll
    for (int vb = 0; vb < 2; ++vb) {
#pragma unroll
        for (int sb = 0; sb < 2; ++sb)
#pragma unroll
            for (int j = 0; j < 2; ++j) { const LAS unsigned char* vp = wl + 8192 + (r32 + 32 * vb) * 128 + (32 * sb + 16 * j + 4 * hi) * 2;
                const u32x2 lo = *(const LAS u32x2*)vp, hh = *(const LAS u32x2*)(vp + 16); const bf16x8 vf = __builtin_bit_cast(bf16x8, (u32x4){lo.x, lo.y, hh.x, hh.y});
                if (sb == 0) { o[vb][0] = __builtin_amdgcn_mfma_f32_32x32x16_bf16(vf, p00[j], o[vb][0], 0, 0, 0); o[vb][1] = __builtin_amdgcn_mfma_f32_32x32x16_bf16(vf, p01[j], o[vb][1], 0, 0, 0); }
                else o[vb][1] = __builtin_amdgcn_mfma_f32_32x32x16_bf16(vf, p11[j], o[vb][1], 0, 0, 0); }
#pragma unroll
        for (int st = 0; st < 2; ++st) { float sx[8];
#pragma unroll
            for (int e = 0; e < 8; ++e) sx[e] = sp[(8 * hi + 16 * st + e) * 64 + r32 + 32 * vb];
            const bf16x8 sf = pack8(sx);
            o[vb][0] = __builtin_amdgcn_mfma_f32_32x32x16_bf16(sf, qf[0][st], o[vb][0], 0, 0, 0); o[vb][1] = __builtin_amdgcn_mfma_f32_32x32x16_bf16(sf, qf[1][st], o[vb][1], 0, 0, 0); } }
#pragma unroll
    for (int tb = 0; tb < 2; ++tb) { float ss = 0.f;
#pragma unroll
        for (int vb = 0; vb < 2; ++vb)
#pragma unroll
            for (int r = 0; r < 16; ++r) ss += o[vb][tb][r] * o[vb][tb][r];
        { auto rr = __builtin_amdgcn_permlane32_swap(__float_as_uint(ss), __float_as_uint(ss), false, false); ss = __uint_as_float(rr[0]) + __uint_as_float(rr[1]); }
        const float rinv = 1.0f / sqrtf(ss * (1.f / 64.f) + RMS_EPS); const size_t t = (size_t)ci * 64 + r32 + 32 * tb;
#pragma unroll
        for (int vb = 0; vb < 2; ++vb)
#pragma unroll
            for (int g = 0; g < 4; ++g) { const int v0 = 32 * vb + 8 * g + 4 * hi; const u32x2 gw = *(const u32x2*)(GR + t * 256 + h * 64 + v0); const f32x4 gn = *(const f32x4*)(ng + h * 64 + v0);
                const float gr[4] = {bf_lo(gw.x), bf_hi(gw.x), bf_lo(gw.y), bf_hi(gw.y)}; float y[4];
#pragma unroll
                for (int i = 0; i < 4; ++i) y[i] = o[vb][tb][4 * g + i] * rinv * gn[i] * (gr[i] * sigmoidf_(gr[i]));
                u32x2 w; w.x = cvt_pk_bf16(y[0], y[1]); w.y = cvt_pk_bf16(y[2], y[3]); *(u32x2*)(Y + t * 768 + h * 64 + v0) = w; } }
    asm volatile("s_waitcnt lgkmcnt(0)" ::: "memory");
}
namespace attn {
using s16x4 = __attribute__((ext_vector_type(4))) short;
using f32x16 = __attribute__((ext_vector_type(16))) float;
constexpr int DM = 256;
constexpr int NW = 8, QBLK = 32, KVBLK = 64;
constexpr int NSLOT = 3, SLOTB = 8192;
constexpr int LDS_K = 0, LDS_V = NSLOT * SLOTB, LDS_WS = 2 * NSLOT * SLOTB, LDS_OST = LDS_WS + NW * 64 * 4, LDS_CK = LDS_OST + NW * 4096, LDS_ENT = LDS_CK + 8192, LDS_BYTES = LDS_ENT + NW * 128;
__device__ __forceinline__ int crow(int r, int hi) { return (r & 3) + 8 * (r >> 2) + 4 * hi; }
#define SBAR() __builtin_amdgcn_sched_barrier(0)
__device__ __forceinline__ void cmask(f32x16& p0, f32x16& p1, int jb, int qrel, int hi) {
  const float NEG = -INFINITY; int kb = 64 * jb + 4 * hi;
#pragma unroll
  for (int r = 0; r < 16; ++r) { int kv = kb + (r & 3) + 8 * (r >> 2); if (kv > qrel) p0[r] = NEG; if (kv + 32 > qrel) p1[r] = NEG; }
}
__device__ __forceinline__ void glds16(const void* gbase, unsigned voff, unsigned lds_dst) { unsigned keep;
  asm volatile("s_mov_b32 %0, m0\n\ts_mov_b32 m0, %3\n\ts_nop 0\n\tglobal_load_lds_dwordx4 %1, %2\n\ts_mov_b32 m0, %0" : "=&s"(keep) : "v"(voff), "s"(gbase), "s"(lds_dst) : "memory"); }
__device__ __forceinline__ float max3f(float a, float b, float c) { float r; asm("v_max3_f32 %0, %1, %2, %3" : "=v"(r) : "v"(a), "v"(b), "v"(c)); return r; }
__device__ __forceinline__ float max2f(float a, float b) { float r; asm("v_max_f32_e32 %0, %1, %2" : "=v"(r) : "v"(a), "v"(b)); return r; }
__device__ __forceinline__ float fadd_s(float a, float b) { float r; asm("v_add_f32_e32 %0, %1, %2" : "=v"(r) : "v"(a), "v"(b)); return r; }
__device__ __forceinline__ float fsub_s(float a, float b) { float r; asm("v_sub_f32_e32 %0, %1, %2" : "=v"(r) : "v"(a), "v"(b)); return r; }
__device__ __forceinline__ unsigned cvtpk_s(float lo, float hi) { f32x2 v = {lo, hi}; bf16x2_t b = __builtin_convertvector(v, bf16x2_t); return __builtin_bit_cast(unsigned, b); }
#define WAIT_BAR(N) asm volatile("s_waitcnt vmcnt(" #N ") lgkmcnt(0)\n\ts_barrier" ::: "memory")
typedef __attribute__((address_space(3))) const char* lds_cptr;
typedef short v4i16_t __attribute__((ext_vector_type(4)));
__device__ __forceinline__ void qkt(f32x16& p0, f32x16& p1, const char* Kslot, const bf16x8* qr, int r32, int hi) {
  const char* kb = Kslot + hi * 1024 + r32 * 16;
#pragma unroll
  for (int d0 = 0; d0 < 4; ++d0) {
    const bf16x8 b0 = *reinterpret_cast<const bf16x8*>(kb + d0 * 2048);
    const bf16x8 b1 = *reinterpret_cast<const bf16x8*>(kb + d0 * 2048 + 512);
    p0 = __builtin_amdgcn_mfma_f32_32x32x16_bf16(b0, qr[d0], p0, 0, 0, 0); p1 = __builtin_amdgcn_mfma_f32_32x32x16_bf16(b1, qr[d0], p1, 0, 0, 0); }
}
__device__ __forceinline__ void kload8(bf16x8* kf, lds_cptr kp) {
  kf[0] = *(const LAS bf16x8*)(kp);        kf[1] = *(const LAS bf16x8*)(kp + 512);
  kf[2] = *(const LAS bf16x8*)(kp + 2048); kf[3] = *(const LAS bf16x8*)(kp + 2560);
  kf[4] = *(const LAS bf16x8*)(kp + 4096); kf[5] = *(const LAS bf16x8*)(kp + 4608);
  kf[6] = *(const LAS bf16x8*)(kp + 6144); kf[7] = *(const LAS bf16x8*)(kp + 6656);
}
__device__ __forceinline__ void kload2(bf16x8* kf, lds_cptr kp, int j) { kf[2 * j] = *(const LAS bf16x8*)(kp + j * 2048); kf[2 * j + 1] = *(const LAS bf16x8*)(kp + j * 2048 + 512); }
__device__ __forceinline__ s16x4 vtr(lds_cptr p) { return __builtin_bit_cast(s16x4, __builtin_amdgcn_ds_read_tr16_b64_v4i16((LAS v4i16_t*)p)); }
__device__ __forceinline__ float rowmax(const f32x16& p0, const f32x16& p1) {
  float a = max3f(p0[0], p0[1], p1[0]), b = max3f(p0[2], p0[3], p1[1]); a = max3f(a, p1[2], p1[3]);
#pragma unroll
  for (int r = 4; r < 16; r += 4) { a = max3f(a, p0[r], p0[r + 1]); b = max3f(b, p0[r + 2], p0[r + 3]); a = max3f(a, p1[r], p1[r + 1]); b = max3f(b, p1[r + 2], p1[r + 3]); }
  const float m = max2f(a, b);
  auto rr = __builtin_amdgcn_permlane32_swap(__float_as_uint(m), __float_as_uint(m), false, false);
  return max2f(__uint_as_float(rr[0]), __uint_as_float(rr[1]));
}
__device__ __forceinline__ void pv(f32x16* o, int vb, bf16x8 pa0, bf16x8 pa1, bf16x8 pa2, bf16x8 pa3) {
#pragma unroll
  for (int d0 = 0; d0 < 2; ++d0) { s16x4 lo[4], hi[4];
#pragma unroll
    for (int ks = 0; ks < 4; ++ks) {
      asm volatile("ds_read_b64_tr_b16 %0,%1 offset:%c2" : "=&v"(lo[ks]) : "v"(vb), "i"(d0 * 4096 + ks * 1024) : "memory");
      asm volatile("ds_read_b64_tr_b16 %0,%1 offset:%c2" : "=&v"(hi[ks]) : "v"(vb), "i"(d0 * 4096 + ks * 1024 + 512) : "memory"); }
    asm volatile("s_waitcnt lgkmcnt(0)" ::: "memory"); SBAR();
#define PK(k) (bf16x8){lo[k][0], lo[k][1], lo[k][2], lo[k][3], hi[k][0], hi[k][1], hi[k][2], hi[k][3]}
    o[d0] = __builtin_amdgcn_mfma_f32_32x32x16_bf16(pa0, PK(0), o[d0], 0, 0, 0);
    o[d0] = __builtin_amdgcn_mfma_f32_32x32x16_bf16(pa1, PK(1), o[d0], 0, 0, 0);
    o[d0] = __builtin_amdgcn_mfma_f32_32x32x16_bf16(pa2, PK(2), o[d0], 0, 0, 0);
    o[d0] = __builtin_amdgcn_mfma_f32_32x32x16_bf16(pa3, PK(3), o[d0], 0, 0, 0);
#undef PK
  }
}

template <int THRL> __device__ __forceinline__ void attn_unit(const bf16* Qrow, const bf16* __restrict__ Kh, const bf16* __restrict__ Vh, const int NT, const bool band,
                                                             const float cq, const float* ckg, const int dest, bf16* PO, float* LSEp, char* shm, const int tid) {
  const int lane = tid & 63, r32 = lane & 31, hi = lane >> 5; const int wid = __builtin_amdgcn_readfirstlane(tid >> 6);
  const unsigned lds0 = (unsigned)(uintptr_t)shm;
  float* wsf = (float*)(shm + LDS_WS) + wid * 64;
  f32x4 ckv = (f32x4){0.f, 0.f, 0.f, 0.f};
  if (ckg && tid * 4 < NT * 64) ckv = *(const f32x4*)(ckg + tid * 4);
  const unsigned koff = (unsigned)(lane * DM + wid * 8) * 2u;
  const unsigned voff = (unsigned)((16 * (wid & 3) + (lane >> 2)) * DM + (wid >> 2) * 32 + (lane & 3) * 8) * 2u;
  const unsigned kdst = lds0 + LDS_K + wid * 1024, vdst = lds0 + LDS_V + wid * 1024;
#define DMA_K(t, slot) glds16(Kh + (long)(t) * KVBLK * DM, koff, (unsigned)__builtin_amdgcn_readfirstlane(kdst + (slot)))
#define DMA_V(t, slot) glds16(Vh + (long)(t) * KVBLK * DM, voff, (unsigned)__builtin_amdgcn_readfirstlane(vdst + (slot)))
  const char* Kbase = shm + LDS_K; bf16x8 kf[8];
  const lds_cptr shm3 = (lds_cptr)shm; const lds_cptr kp0 = shm3 + LDS_K + hi * 1024 + r32 * 16; const lds_cptr vp0 = shm3 + LDS_V + ((lane >> 4) & 1) * 32 + (lane & 3) * 8 + (4 * hi + ((lane & 15) >> 2)) * 64;
  const LAS f32x4* ck4 = (const LAS f32x4*)(shm3 + LDS_CK) + hi;
  DMA_K(0, 0); DMA_V(0, 0); DMA_K(1, SLOTB);
  bf16x8 qr[4];
#pragma unroll
  for (int d0 = 0; d0 < 4; ++d0) qr[d0] = *reinterpret_cast<const bf16x8*>(&Qrow[d0 * 16 + hi * 8]);
  *(LAS f32x4*)((LAS char*)shm3 + LDS_CK + tid * 16) = ckv;
  if (hi == 0) *(LAS int*)((LAS char*)shm3 + LDS_ENT + wid * 128 + r32 * 4) = dest;
  float mhat = 0.f, l_reg = 0.f, nb = cq; f32x16 o[2]; o[0] = f32x16{}; o[1] = f32x16{};
  const int qrel = wid * QBLK + r32;
#define CMASK(P0, P1, t) do { int jb_ = (t) - (NT - 4); if (band && jb_ >= 0) cmask(P0, P1, jb_, qrel, hi); } while (0)
#define BINIT(P0, P1, t) do { _Pragma("unroll") for (int g_ = 0; g_ < 4; ++g_) { const f32x4 a_ = ck4[16 * (t) + 2 * g_], b_ = ck4[16 * (t) + 8 + 2 * g_]; \
      _Pragma("unroll") for (int i_ = 0; i_ < 4; ++i_) { P0[4 * g_ + i_] = nb - a_[i_]; P1[4 * g_ + i_] = nb - b_[i_]; } } } while (0)
  bool resc = false;
#define START(P0, P1) do { const float rm = rowmax(P0, P1); resc = false; \
    { const float dl = rm; mhat = fadd_s(mhat, dl); nb = fsub_s(nb, dl); \
      _Pragma("unroll") for (int r = 0; r < 16; ++r) { P0[r] = fsub_s(P0[r], dl); P1[r] = fsub_s(P1[r], dl); } } \
    _Pragma("unroll") for (int r = 0; r < 16; ++r) P0[r] = __builtin_amdgcn_exp2f(P0[r]); } while (0)
#define RESC() do { if (resc) { asm volatile("s_waitcnt lgkmcnt(0)" ::: "memory"); \
      _Pragma("unroll") for (int d_ = 0; d_ < 2; ++d_) _Pragma("unroll") for (int r = 0; r < 16; ++r) o[d_][r] *= wsf[crow(r, hi)]; } } while (0)
  f32x16 pA0, pA1, pB0, pB1;
  int sl_prev = 0, sl_cur = 0, sl_next = SLOTB;
#define ROT() do { sl_prev = sl_cur; sl_cur = sl_next; sl_next = (sl_next == (NSLOT - 1) * SLOTB) ? 0 : sl_next + SLOTB; } while (0)
  DMA_K(2, 2 * SLOTB);
  WAIT_BAR(3);
  BINIT(pA0, pA1, 0);
  qkt(pA0, pA1, Kbase, qr, r32, hi); asm volatile("s_nop 15\n\ts_nop 7" : "+v"(pA0), "+v"(pA1)); CMASK(pA0, pA1, 0);
  START(pA0, pA1);
  _Pragma("unroll") for (int r = 0; r < 16; ++r) pA1[r] = __builtin_amdgcn_exp2f(pA1[r]);
  BINIT(pB0, pB1, 1);
  WAIT_BAR(0);
  DMA_K(3, 0); DMA_V(1, SLOTB);
  ROT();
  kload8(kf, kp0 + sl_cur);
  WAIT_BAR(2);
  s16x4 vlo[8], vhi[8]; u32x4 pw0, pw1, pw2, pw3;
#define PKW(P, B) cvtpk_s(P[B], P[B + 1])
#define PAF(k) __builtin_bit_cast(bf16x8, pw##k)
#define VFR(i) (bf16x8){vlo[i][0], vlo[i][1], vlo[i][2], vlo[i][3], vhi[i][0], vhi[i][1], vhi[i][2], vhi[i][3]}
#define PIN(x) asm volatile("" : "+v"(x))
#define MX3(a, b, c) __builtin_fmaxf(__builtin_fmaxf((a), (b)), (c))
#define GAPA(MF, A0, A1, A2, A3, W0, W1, PW) do { MF; sacc += A0; sacc += A1; sacc += A2; sacc += A3; PIN(sacc); W0; W1; PIN(PW); SBAR(); } while (0)
#define EX(v) __builtin_amdgcn_exp2f(v)
#define GAPB(MF, X, B) do { MF; X[B] = EX(X[B]); X[B + 1] = EX(X[B + 1]); X[B + 2] = EX(X[B + 2]); X[B + 3] = EX(X[B + 3]); PIN(X); SBAR(); } while (0)
#define VRD(i) do { vlo[i] = vtr(vp_ + (((i) >> 2) * 4096 + ((i) & 3) * 1024)); vhi[i] = vtr(vp_ + (((i) >> 2) * 4096 + ((i) & 3) * 1024 + 512)); } while (0)
#define KRD(G, j) do { if (G) { kload2(kf, kp0 + sl_next, j); SBAR(); } } while (0)
#define BRD(G, P0, P1, t, g) do { if (G) { const f32x4 a_ = ck4[16 * ((t) + 1) + 2 * (g)], b_ = ck4[16 * ((t) + 1) + 8 + 2 * (g)]; \
      P0[4 * (g)] = a_[0]; P0[4 * (g) + 1] = a_[1]; P0[4 * (g) + 2] = a_[2]; P0[4 * (g) + 3] = a_[3]; P1[4 * (g)] = b_[0]; P1[4 * (g) + 1] = b_[1]; P1[4 * (g) + 2] = b_[2]; P1[4 * (g) + 3] = b_[3]; SBAR(); } } while (0)
#define BSB(G, P0, P1) do { if (G) { _Pragma("unroll") for (int r = 0; r < 16; ++r) { P0[r] = nb - P0[r]; P1[r] = nb - P1[r]; } PIN(P0); PIN(P1); SBAR(); } } while (0)
#define STEP(C0, C1, P0, P1, t, GK, GV, GL) do { SBAR(); \
    const lds_cptr vp_ = vp0 + sl_prev; \
    VRD(0); SBAR(); float sacc = (P0[0] + P0[1]); \
    GAPA(C0 = __builtin_amdgcn_mfma_f32_32x32x16_bf16(kf[0], qr[0], C0, 0, 0, 0), P0[2], P0[3], P0[4], P0[5],     pw0[0] = PKW(P0, 0), pw0[1] = PKW(P0, 2), pw0); \
    VRD(4); SBAR(); GAPA(C1 = __builtin_amdgcn_mfma_f32_32x32x16_bf16(kf[1], qr[0], C1, 0, 0, 0), P0[6], P0[7], P0[8], P0[9],     pw0[2] = PKW(P0, 4), pw0[3] = PKW(P0, 6), pw0); \
    VRD(1); SBAR(); GAPA(C0 = __builtin_amdgcn_mfma_f32_32x32x16_bf16(kf[2], qr[1], C0, 0, 0, 0),   P0[10], P0[11], P0[12], P0[13], pw1[0] = PKW(P0, 8), pw1[1] = PKW(P0, 10), pw1); \
    VRD(5); SBAR(); GAPA(C1 = __builtin_amdgcn_mfma_f32_32x32x16_bf16(kf[3], qr[1], C1, 0, 0, 0),   P0[14], P0[15], P1[0], P1[1],   pw1[2] = PKW(P0, 12), pw1[3] = PKW(P0, 14), pw1); \
    VRD(2); SBAR(); GAPA(C0 = __builtin_amdgcn_mfma_f32_32x32x16_bf16(kf[4], qr[2], C0, 0, 0, 0),   P1[2], P1[3], P1[4], P1[5],     pw2[0] = PKW(P1, 0), pw2[1] = PKW(P1, 2), pw2); \
    VRD(6); SBAR(); GAPA(C1 = __builtin_amdgcn_mfma_f32_32x32x16_bf16(kf[5], qr[2], C1, 0, 0, 0),   P1[6], P1[7], P1[8], P1[9],     pw2[2] = PKW(P1, 4), pw2[3] = PKW(P1, 6), pw2); \
    VRD(3); SBAR(); GAPA(C0 = __builtin_amdgcn_mfma_f32_32x32x16_bf16(kf[6], qr[3], C0, 0, 0, 0),   P1[10], P1[11], P1[12], P1[13], pw3[0] = PKW(P1, 8), pw3[1] = PKW(P1, 10), pw3); \
    VRD(7); SBAR(); GAPA(C1 = __builtin_amdgcn_mfma_f32_32x32x16_bf16(kf[7], qr[3], C1, 0, 0, 0),   P1[14], P1[15], 0.f, 0.f,       pw3[2] = PKW(P1, 12), pw3[3] = PKW(P1, 14), pw3); \
    l_reg += sacc; \
    if (GK) { DMA_K((t) + 3, sl_cur); } if (GV) { DMA_V((t) + 1, sl_next); } \
    CMASK(C0, C1, t); \
    { float a = MX3(C0[0], C0[1], C1[0]), b = MX3(C0[2], C0[3], C1[1]); a = MX3(a, C1[2], C1[3]); \
      _Pragma("unroll") for (int r = 4; r < 16; r += 4) { a = MX3(a, C0[r], C0[r + 1]); b = MX3(b, C0[r + 2], C0[r + 3]); a = MX3(a, C1[r], C1[r + 1]); b = MX3(b, C1[r + 2], C1[r + 3]); } \
      float rm = __builtin_fmaxf(a, b); { auto rr = __builtin_amdgcn_permlane32_swap(__float_as_uint(rm), __float_as_uint(rm), false, false); rm = __builtin_fmaxf(__uint_as_float(rr[0]), __uint_as_float(rr[1])); } \
      resc = false; \
      if (__builtin_expect(__any(rm > (float)THRL), 0)) { const float dl = __builtin_fmaxf(rm, 0.f); mhat += dl; nb -= dl; \
        _Pragma("unroll") for (int r = 0; r < 16; ++r) { C0[r] -= dl; C1[r] -= dl; } \
        const float f = __builtin_amdgcn_exp2f(-dl); l_reg *= f; if (hi == 0) wsf[r32] = f; resc = true; } } \
    SBAR(); \
    BRD(GL, P0, P1, t, 0); BRD(GL, P0, P1, t, 1); \
    GAPB(o[0] = __builtin_amdgcn_mfma_f32_32x32x16_bf16(PAF(0), VFR(0), o[0], 0, 0, 0), C0, 0); \
    BRD(GL, P0, P1, t, 2); BRD(GL, P0, P1, t, 3); \
    GAPB(o[1] = __builtin_amdgcn_mfma_f32_32x32x16_bf16(PAF(0), VFR(4), o[1], 0, 0, 0), C0, 4); \
    KRD(GL, 0); GAPB(o[0] = __builtin_amdgcn_mfma_f32_32x32x16_bf16(PAF(1), VFR(1), o[0], 0, 0, 0), C0, 8); \
    KRD(GL, 1); GAPB(o[1] = __builtin_amdgcn_mfma_f32_32x32x16_bf16(PAF(1), VFR(5), o[1], 0, 0, 0), C0, 12); \
    KRD(GL, 2); GAPB(o[0] = __builtin_amdgcn_mfma_f32_32x32x16_bf16(PAF(2), VFR(2), o[0], 0, 0, 0), C1, 0); \
    KRD(GL, 3); GAPB(o[1] = __builtin_amdgcn_mfma_f32_32x32x16_bf16(PAF(2), VFR(6), o[1], 0, 0, 0), C1, 4); \
    GAPB(o[0] = __builtin_amdgcn_mfma_f32_32x32x16_bf16(PAF(3), VFR(3), o[0], 0, 0, 0), C1, 8); \
    GAPB(o[1] = __builtin_amdgcn_mfma_f32_32x32x16_bf16(PAF(3), VFR(7), o[1], 0, 0, 0), C1, 12); \
    BSB(GL, P0, P1); \
    } while (0)
  int t = 1;
#undef CMASK
#define CMASK(P0, P1, t) do {} while (0)
  for (; t + 5 < NT; t += 2) {
    STEP(pB0, pB1, pA0, pA1, t, true, true, true);     WAIT_BAR(2); RESC(); ROT();
    STEP(pA0, pA1, pB0, pB1, t + 1, true, true, true); WAIT_BAR(2); RESC(); ROT();
  }
#undef CMASK
#define CMASK(P0, P1, t) do { int jb_ = (t) - (NT - 4); if (band && jb_ >= 0) cmask(P0, P1, jb_, qrel, hi); } while (0)
#define ENDW(tt) do { if ((tt) + 3 < NT) { WAIT_BAR(2); } else if ((tt) + 2 < NT) { WAIT_BAR(1); } else { WAIT_BAR(0); } } while (0)
  for (; t + 1 < NT; t += 2) {
    STEP(pB0, pB1, pA0, pA1, t, (t + 3 < NT), (t + 1 < NT), (t + 1 < NT));         ENDW(t);     RESC(); ROT();
    STEP(pA0, pA1, pB0, pB1, t + 1, (t + 4 < NT), (t + 2 < NT), (t + 2 < NT));     ENDW(t + 1); RESC(); ROT();
  }
  STEP(pB0, pB1, pA0, pA1, NT - 1, false, false, false); RESC();
  { float sacc = pB0[0] + pB0[1]; _Pragma("unroll") for (int r = 2; r < 16; ++r) sacc += pB0[r]; _Pragma("unroll") for (int r = 0; r < 16; ++r) sacc += pB1[r]; l_reg += sacc;
    pw0 = (u32x4){PKW(pB0, 0), PKW(pB0, 2), PKW(pB0, 4), PKW(pB0, 6)}; pw1 = (u32x4){PKW(pB0, 8), PKW(pB0, 10), PKW(pB0, 12), PKW(pB0, 14)}; pw2 = (u32x4){PKW(pB1, 0), PKW(pB1, 2), PKW(pB1, 4), PKW(pB1, 6)}; pw3 = (u32x4){PKW(pB1, 8), PKW(pB1, 10), PKW(pB1, 12), PKW(pB1, 14)};
    const int vb0 = (int)(lds0 + LDS_V) + ((lane >> 4) & 1) * 32 + (lane & 3) * 8 + (4 * hi + ((lane & 15) >> 2)) * 64;
    SBAR(); pv(o, vb0 + sl_cur, PAF(0), PAF(1), PAF(2), PAF(3)); }
#undef PKW
#undef PAF
#undef VFR
#undef PIN
#undef MX3
#undef GAPA
#undef GAPB
#undef EX
#undef VRD
#undef KRD
#undef BRD
#undef BSB
#undef STEP
#undef ENDW
  { auto rr = __builtin_amdgcn_permlane32_swap(__float_as_uint(l_reg), __float_as_uint(l_reg), false, false); l_reg = __uint_as_float(rr[0]) + __uint_as_float(rr[1]); }
  if (hi == 0) { wsf[32 + r32] = l_reg; const int de0 = *(const LAS int*)((LAS char*)shm3 + LDS_ENT + wid * 128 + r32 * 4); if (de0 >= 0) LSEp[de0] = mhat + __builtin_amdgcn_logf(l_reg); }
  asm volatile("s_waitcnt lgkmcnt(0)" ::: "memory");
  float rli[16];
#pragma unroll
  for (int r = 0; r < 16; ++r) rli[r] = __builtin_amdgcn_rcpf(wsf[32 + crow(r, hi)]);
  { bf16* stg = (bf16*)(shm + LDS_OST) + wid * 2048;
#pragma unroll
    for (int r = 0; r < 16; ++r) { const int orow = crow(r, hi);
#pragma unroll
      for (int d0 = 0; d0 < 2; ++d0) stg[orow * 64 + d0 * 32 + r32] = (bf16)(cvtpk_s(o[d0][r] * rli[r], 0.f) & 0xffffu); }
    asm volatile("s_waitcnt lgkmcnt(0)" ::: "memory");
    const LAS int* ents = (const LAS int*)((LAS char*)shm3 + LDS_ENT + wid * 128);
#pragma unroll
    for (int i = 0; i < 4; ++i) { const int row = i * 8 + (lane >> 3), ch = lane & 7; const u32x4 v = *(const u32x4*)(stg + row * 64 + ch * 8); const int de = ents[row];
      if (de >= 0) *(u32x4*)(PO + (size_t)de * 64 + ch * 8) = v; } }
  asm volatile("s_waitcnt lgkmcnt(0)\n\ts_barrier" ::: "memory");
#undef DMA_K
#undef DMA_V
#undef CMASK
#undef BINIT
#undef START
#undef RESC
#undef ROT
}
#undef SBAR
#undef WAIT_BAR
}

__device__ __forceinline__ void load16(const bf16* p, float (&v)[16]) {
    const u32x4 a = *(const u32x4*)p, b = *(const u32x4*)(p + 8);
    v[0] = bf_lo(a.x); v[1] = bf_hi(a.x); v[2] = bf_lo(a.y); v[3] = bf_hi(a.y); v[4] = bf_lo(a.z); v[5] = bf_hi(a.z); v[6] = bf_lo(a.w); v[7] = bf_hi(a.w);
    v[8] = bf_lo(b.x); v[9] = bf_hi(b.x); v[10] = bf_lo(b.y); v[11] = bf_hi(b.y); v[12] = bf_lo(b.z); v[13] = bf_hi(b.z); v[14] = bf_lo(b.w); v[15] = bf_hi(b.w);
}
__device__ __forceinline__ void moba_gate_batch(LAS unsigned char* lds, int tid, int b, const bf16* MQ, const float* KM, int* QL, unsigned* MCNT) {
    typedef float f32x16 __attribute__((ext_vector_type(16)));
    LAS int* hist = (LAS int*)(lds + 65536);
    LAS int* base = hist + 256;
    const int own = (b * 128) >> 8, nsel = own < 3 ? own : 3;
    const int lane = tid & 63, r32 = lane & 31, hi = lane >> 5, w = tid >> 6, h = w & 3, th = w >> 2;
    if (tid < 256) hist[tid] = 0;
    __syncthreads();
    LAS int* sres = base + 256;
    if (own > 0) {
        bf16x8 kh[2][4], kl[2][4];
#pragma unroll
        for (int nb = 0; nb < 2; ++nb)
#pragma unroll
            for (int st = 0; st < 4; ++st) { const float* kp = KM + ((size_t)h * 64 + r32 + 32 * nb) * 64 + 8 * hi + 16 * st; const f32x4 a = *(const f32x4*)kp, c = *(const f32x4*)(kp + 4);
                const float x[8] = {a[0], a[1], a[2], a[3], c[0], c[1], c[2], c[3]}; float lo[8]; u32x4 hw;
                hw.x = cvt_pk_bf16(x[0], x[1]); hw.y = cvt_pk_bf16(x[2], x[3]); hw.z = cvt_pk_bf16(x[4], x[5]); hw.w = cvt_pk_bf16(x[6], x[7]);
                const unsigned hh[4] = {hw.x, hw.y, hw.z, hw.w};
#pragma unroll
                for (int e = 0; e < 4; ++e) { lo[2 * e] = x[2 * e] - bf_lo(hh[e]); lo[2 * e + 1] = x[2 * e + 1] - bf_hi(hh[e]); }
                kh[nb][st] = __builtin_bit_cast(bf16x8, hw); kl[nb][st] = pack8(lo); }
#pragma unroll 1
        for (int g = 0; g < 2; ++g) { const int t = b * 128 + th * 64 + g * 32 + r32;
            f32x16 a0 = {}, a1 = {};
#pragma unroll
            for (int st = 0; st < 4; ++st) { const bf16x8 qf = *(const bf16x8*)(MQ + (size_t)t * 256 + h * 64 + 8 * hi + 16 * st);
                a0 = __builtin_amdgcn_mfma_f32_32x32x16_bf16(kh[0][st], qf, a0, 0, 0, 0); a0 = __builtin_amdgcn_mfma_f32_32x32x16_bf16(kl[0][st], qf, a0, 0, 0, 0);
                a1 = __builtin_amdgcn_mfma_f32_32x32x16_bf16(kh[1][st], qf, a1, 0, 0, 0); a1 = __builtin_amdgcn_mfma_f32_32x32x16_bf16(kl[1][st], qf, a1, 0, 0, 0); }
            float v0 = -INFINITY, v1 = -INFINITY, v2 = -INFINITY; int i0 = 0, i1 = 0, i2 = 0;
#pragma unroll
            for (int nb = 0; nb < 2; ++nb)
#pragma unroll
                for (int r = 0; r < 16; ++r) { const int n = (r & 3) + 8 * (r >> 2) + 4 * hi + 32 * nb; const float s = (n < own) ? (nb == 0 ? a0[r] : a1[r]) : -INFINITY;
                    if (s > v0) { v2 = v1; i2 = i1; v1 = v0; i1 = i0; v0 = s; i0 = n; }
                    else if (s > v1) { v2 = v1; i2 = i1; v1 = s; i1 = n; }
                    else if (s > v2) { v2 = s; i2 = n; } }
            float pv[3]; int pi[3];
            { const float mv[3] = {v0, v1, v2}; const int mi[3] = {i0, i1, i2};
#pragma unroll
              for (int c = 0; c < 3; ++c) { auto rv = __builtin_amdgcn_permlane32_swap(__float_as_uint(mv[c]), __float_as_uint(mv[c]), false, false); pv[c] = __uint_as_float(hi ? rv[0] : rv[1]);
                  auto ri = __builtin_amdgcn_permlane32_swap((unsigned)mi[c], (unsigned)mi[c], false, false); pi[c] = (int)(hi ? ri[0] : ri[1]); } }
            float cv[6] = {v0, v1, v2, pv[0], pv[1], pv[2]}; int cix[6] = {i0, i1, i2, pi[0], pi[1], pi[2]};
#pragma unroll
            for (int s3 = 0; s3 < 3; ++s3) { float bv = -INFINITY; int bi = 0x7fffffff, bc = 0;
#pragma unroll
                for (int c = 0; c < 6; ++c) { const bool better = (cv[c] > bv) || (cv[c] == bv && cix[c] < bi); if (better) { bv = cv[c]; bi = cix[c]; bc = c; } }
#pragma unroll
                for (int c = 0; c < 6; ++c) if (c == bc) { cv[c] = -INFINITY; cix[c] = 0x7fffffff; }
                if (hi == 0 && s3 < nsel) { const int rnk = __hip_atomic_fetch_add(hist + h * 64 + bi, 1, __ATOMIC_RELAXED, __HIP_MEMORY_SCOPE_WORKGROUP); sres[((w * 2 + g) * 32 + r32) * 3 + s3] = (bi << 16) | rnk; } }
        }
    }
    __syncthreads();
    if (tid < 256) { const int c = hist[tid]; base[tid] = c > 0 ? (int)__hip_atomic_fetch_add(MCNT + tid, (unsigned)c, __ATOMIC_RELAXED, __HIP_MEMORY_SCOPE_AGENT) : 0; }
    __syncthreads();
    if (own > 0 && hi == 0) {
#pragma unroll
        for (int g = 0; g < 2; ++g) { const int t = b * 128 + th * 64 + g * 32 + r32;
#pragma unroll
            for (int s3 = 0; s3 < 3; ++s3) if (s3 < nsel) { const int pk = sres[((w * 2 + g) * 32 + r32) * 3 + s3]; const int bi = pk >> 16, rnk = pk & 0xffff; QL[((size_t)h * 63 + bi) * 16384 + base[h * 64 + bi] + rnk] = t * 4 + s3; } } }
    __syncthreads();
}

__device__ __forceinline__ void moe_table(const unsigned* cntg, LAS int* tab, int tid) {
    if (tid < 64) { const int e = tid; const int c = e < 32 ? (int)__hip_atomic_load(cntg + e, __ATOMIC_RELAXED, __HIP_MEMORY_SCOPE_AGENT) : 0; const int nt = (c + 255) >> 8;
        const int tail = (c > 0 && ((c - 1) & 255) < 128) ? 1 : 0;
        int incl = nt, itail = tail;
#pragma unroll
        for (int o = 1; o < 64; o <<= 1) { const int y = shu(incl, o), z = shu(itail, o); if (e >= o) { incl += y; itail += z; } }
        if (e < 32) { tab[e] = c; tab[32 + e] = incl - nt; tab[96 + e] = ((incl - nt) - (itail - tail)) | ((itail - tail) << 10) | (tail << 16); }
        if (e == 31) { tab[64] = incl; tab[65] = incl; tab[66] = incl - itail; } }
    __syncthreads();
    const int ntl = tab[65], nfull = tab[66];
    for (int m = tid; m < ntl; m += 512) { int e = 0;
        for (int j = 1; j < 32; ++j) if (tab[32 + j] <= m) e = j;
        tab[128 + m] = e;
        const int pk = tab[96 + e], i = m - tab[32 + e], nte = (tab[e] + 255) >> 8;
        const int k = ((pk >> 16) & 1) && i == nte - 1 ? nfull + ((pk >> 10) & 63) : (pk & 1023) + i;
        tab[448 + k] = m; }
    __syncthreads();
}

__device__ __forceinline__ void ln1_router_block(LAS unsigned char* lds, int tid, int blk, const bf16* XB, const bf16* Y, const float* g1, const float* b1, const float* brt, const bf16* WRT,
                                                 bf16* X1, unsigned char* X1F, unsigned* CNT, int* TOK, int* TE, int* TP, float* TG) {
    typedef float f32x16 __attribute__((ext_vector_type(16)));
    LAS float* part = (LAS float*)lds;
    LAS int* hist = (LAS int*)(lds + RT_OFF); LAS int* base = hist + 32; LAS int* sel_e = base + 32; LAS int* sel_r = sel_e + 256; LAS float* sel_g = (LAS float*)(sel_r + 256);
    const int lane = tid & 63, wave = tid >> 6;
    if (tid < 32) hist[tid] = 0;
    { u32x2 yn[2][4], xn[2][4];
      { const size_t t = (size_t)blk * 64 + wave * 8;
#pragma unroll
        for (int r = 0; r < 2; ++r)
#pragma unroll
            for (int j = 0; j < 4; ++j) { const int c = 4 * lane + 256 * j; yn[r][j] = *(const u32x2*)(Y + (t + r) * 1024 + c); xn[r][j] = *(const u32x2*)(XB + (t + r) * 1024 + c); } }
      f32x4 gv[4], bv[4];
#pragma unroll
      for (int j = 0; j < 4; ++j) { gv[j] = *(const f32x4*)(g1 + 4 * lane + 256 * j); bv[j] = *(const f32x4*)(b1 + 4 * lane + 256 * j); }
#pragma unroll 1
      for (int rr = 0; rr < 8; rr += 2) {
        const size_t t = (size_t)blk * 64 + wave * 8 + rr;
        f32x4 v[2][4]; float s[2] = {0.f, 0.f};
#pragma unroll
        for (int r = 0; r < 2; ++r)
#pragma unroll
            for (int j = 0; j < 4; ++j) { v[r][j] = (f32x4){bf_lo(xn[r][j].x), bf_hi(xn[r][j].x), bf_lo(xn[r][j].y), bf_hi(xn[r][j].y)} * ALPHA + (f32x4){bf_lo(yn[r][j].x), bf_hi(yn[r][j].x), bf_lo(yn[r][j].y), bf_hi(yn[r][j].y)}; s[r] += (v[r][j][0] + v[r][j][1]) + (v[r][j][2] + v[r][j][3]); }
        if (rr < 6) {
#pragma unroll
            for (int r = 0; r < 2; ++r)
#pragma unroll
                for (int j = 0; j < 4; ++j) { const int c = 4 * lane + 256 * j; yn[r][j] = *(const u32x2*)(Y + (t + 2 + r) * 1024 + c); xn[r][j] = *(const u32x2*)(XB + (t + 2 + r) * 1024 + c); } }
        float mean[2], s2[2] = {0.f, 0.f}, rstd[2];
#pragma unroll
        for (int o = 1; o < 64; o <<= 1) { s[0] += shx(s[0], o); s[1] += shx(s[1], o); }
#pragma unroll
        for (int r = 0; r < 2; ++r) { mean[r] = s[r] * (1.f / 1024.f);
#pragma unroll
            for (int j = 0; j < 4; ++j) { v[r][j] = v[r][j] - mean[r]; s2[r] += (v[r][j][0] * v[r][j][0] + v[r][j][1] * v[r][j][1]) + (v[r][j][2] * v[r][j][2] + v[r][j][3] * v[r][j][3]); } }
#pragma unroll
        for (int o = 1; o < 64; o <<= 1) { s2[0] += shx(s2[0], o); s2[1] += shx(s2[1], o); }
#pragma unroll
        for (int r = 0; r < 2; ++r) { rstd[r] = 1.f / sqrtf(s2[r] * (1.f / 1024.f) + LN_EPS);
#pragma unroll
            for (int j = 0; j < 4; ++j) { const int c = 4 * lane + 256 * j; v[r][j] = v[r][j] * rstd[r] * gv[j] + bv[j];
                u32x2 w; w.x = cvt_pk_bf16(v[r][j][0], v[r][j][1]); w.y = cvt_pk_bf16(v[r][j][2], v[r][j][3]); *(u32x2*)(X1 + (t + r) * 1024 + c) = w;
                *(unsigned*)(X1F + (t + r) * 1024 + c) = cvt4_fp8(v[r][j][0], v[r][j][1], v[r][j][2], v[r][j][3]); } } } }
    asm volatile("s_waitcnt vmcnt(0)" ::: "memory");
    __syncthreads();
    { const int r32 = lane & 31, hi = lane >> 5, grp = wave & 1, kq = wave >> 1;
      const bf16* xr = X1 + ((size_t)blk * 64 + grp * 32 + r32) * 1024 + kq * 256 + hi * 8;
      const bf16* wh = WRT + (size_t)r32 * 1024 + kq * 256 + hi * 8;
      f32x16 acc = {};
#pragma unroll
      for (int half = 0; half < 2; ++half) { bf16x8 xf[8], wf[8], wl[8];
#pragma unroll
          for (int s = 0; s < 8; ++s) { const int ko = (half * 8 + s) * 16; xf[s] = *(const bf16x8*)(xr + ko); wf[s] = *(const bf16x8*)(wh + ko); wl[s] = *(const bf16x8*)(wh + 32768 + ko); }
#pragma unroll
          for (int s = 0; s < 8; ++s) { acc = __builtin_amdgcn_mfma_f32_32x32x16_bf16(wf[s], xf[s], acc, 0, 0, 0); acc = __builtin_amdgcn_mfma_f32_32x32x16_bf16(wl[s], xf[s], acc, 0, 0, 0); } }
      LAS float* pw = part + ((size_t)wave * 32 + r32) * 36 + 4 * hi;
#pragma unroll
      for (int g = 0; g < 4; ++g) *(LAS f32x4*)(pw + 8 * g) = (f32x4){acc[4 * g], acc[4 * g + 1], acc[4 * g + 2], acc[4 * g + 3]}; }
    __syncthreads();
    if (tid < 64) { const int grp = tid >> 5, tk = tid & 31; float lv[32];
#pragma unroll
        for (int e4 = 0; e4 < 8; ++e4) { f32x4 x = *(const f32x4*)(brt + e4 * 4);
#pragma unroll
            for (int q = 0; q < 4; ++q) x += *(const LAS f32x4*)(part + ((size_t)(q * 2 + grp) * 32 + tk) * 36 + e4 * 4);
            lv[e4 * 4] = x[0]; lv[e4 * 4 + 1] = x[1]; lv[e4 * 4 + 2] = x[2]; lv[e4 * 4 + 3] = x[3]; }
        float tv[4]; int ti[4];
#pragma unroll
        for (int k = 0; k < 4; ++k) { float bvv = -INFINITY; int bi = 0;
#pragma unroll
            for (int e = 0; e < 32; ++e) { const bool taken = (k > 0 && ti[0] == e) || (k > 1 && ti[1] == e) || (k > 2 && ti[2] == e); if (!taken && lv[e] > bvv) { bvv = lv[e]; bi = e; } }
            tv[k] = bvv; ti[k] = bi; }
        const float e1 = __expf(tv[1] - tv[0]), e2 = __expf(tv[2] - tv[0]), e3 = __expf(tv[3] - tv[0]); const float inv = 1.f / (1.f + e1 + e2 + e3);
        const float gk[4] = {inv, e1 * inv, e2 * inv, e3 * inv};
#pragma unroll
        for (int k = 0; k < 4; ++k) { const int rk = __hip_atomic_fetch_add(hist + ti[k], 1, __ATOMIC_RELAXED, __HIP_MEMORY_SCOPE_WORKGROUP); sel_e[tid * 4 + k] = ti[k]; sel_r[tid * 4 + k] = rk; sel_g[tid * 4 + k] = gk[k]; } }
    __syncthreads();
    if (tid < 32) { const int c = hist[tid]; base[tid] = c > 0 ? (int)__hip_atomic_fetch_add(CNT + tid, (unsigned)c, __ATOMIC_RELAXED, __HIP_MEMORY_SCOPE_AGENT) : 0; }
    __syncthreads();
    if (tid < 256) { const int tl = tid >> 2; const int t = blk * 64 + tl; const int e = sel_e[tid], pos = base[e] + sel_r[tid];
        TOK[e * 16384 + pos] = t; TE[(size_t)t * 4 + (tid & 3)] = e; TP[(size_t)t * 4 + (tid & 3)] = pos; TG[(size_t)t * 4 + (tid & 3)] = sel_g[tid]; }
    __syncthreads();
}

__device__ __forceinline__ void ln2_rows8(int lane, int t0, const bf16* X1, const bf16* YB, const LAS int* tab, const int* TE, const int* TP, const float* TG, const float* g2, const float* b2, bf16* XB, unsigned char* XB8, float* outp) {
    int slot_l = 0; float g_l = 0.f;
    if (lane < 32) { const int e = TE[(size_t)t0 * 4 + lane], pos = TP[(size_t)t0 * 4 + lane]; g_l = TG[(size_t)t0 * 4 + lane]; slot_l = tab[32 + e] * 256 + pos; }
    f32x4 gv[4], bv[4];
#pragma unroll
    for (int j = 0; j < 4; ++j) { gv[j] = *(const f32x4*)(g2 + 4 * lane + 256 * j); bv[j] = *(const f32x4*)(b2 + 4 * lane + 256 * j); }
    const unsigned char* YB8 = (const unsigned char*)YB;
    for (int rp = 0; rp < 8; rp += 2) {
        u32x2 xw[2][4]; unsigned yw[2][4][4]; float gg[2][4];
#pragma unroll
        for (int r = 0; r < 2; ++r) { const size_t t = (size_t)t0 + rp + r;
#pragma unroll
            for (int j = 0; j < 4; ++j) xw[r][j] = *(const u32x2*)(X1 + t * 1024 + 4 * lane + 256 * j);
#pragma unroll
            for (int k = 0; k < 4; ++k) { const size_t slot = (size_t)__builtin_amdgcn_readlane(slot_l, (rp + r) * 4 + k); gg[r][k] = __uint_as_float(__builtin_amdgcn_readlane(__float_as_uint(g_l), (rp + r) * 4 + k)) * 0.0625f;
#pragma unroll
                for (int j = 0; j < 4; ++j) yw[r][k][j] = *(const unsigned*)(YB8 + slot * 1024 + 4 * lane + 256 * j); } }
#pragma unroll
        for (int r = 0; r < 2; ++r) { const size_t t = (size_t)t0 + rp + r; f32x4 v[4]; float s = 0.f;
#pragma unroll
            for (int j = 0; j < 4; ++j) { v[j] = (f32x4){bf_lo(xw[r][j].x), bf_hi(xw[r][j].x), bf_lo(xw[r][j].y), bf_hi(xw[r][j].y)} * ALPHA;
#pragma unroll
                for (int k = 0; k < 4; ++k) { const f32x2 lo2 = __builtin_amdgcn_cvt_pk_f32_fp8((int)yw[r][k][j], false), hi2 = __builtin_amdgcn_cvt_pk_f32_fp8((int)yw[r][k][j], true); v[j] += (f32x4){lo2[0], lo2[1], hi2[0], hi2[1]} * gg[r][k]; }
                s += (v[j][0] + v[j][1]) + (v[j][2] + v[j][3]); }
            const float mean = wave_sum(s) * (1.f / 1024.f); float s2 = 0.f;
#pragma unroll
            for (int j = 0; j < 4; ++j) { v[j] = v[j] - mean; s2 += (v[j][0] * v[j][0] + v[j][1] * v[j][1]) + (v[j][2] * v[j][2] + v[j][3] * v[j][3]); }
            const float rstd = 1.f / sqrtf(wave_sum(s2) * (1.f / 1024.f) + LN_EPS);
#pragma unroll
            for (int j = 0; j < 4; ++j) { const int c = 4 * lane + 256 * j; v[j] = v[j] * rstd * gv[j] + bv[j];
                u32x2 w; w.x = cvt_pk_bf16(v[j][0], v[j][1]); w.y = cvt_pk_bf16(v[j][2], v[j][3]); *(u32x2*)(XB + t * 1024 + c) = w;
                *(unsigned*)(XB8 + t * 1024 + c) = cvt4_fp8(v[j][0], v[j][1], v[j][2], v[j][3]);
                if (outp) *(f32x4*)(outp + t * 1024 + c) = v[j]; } }
    }
}

constexpr int NFOX_FULL = 928, NFOX = 1152;
__device__ __forceinline__ void fox_item(int idx, int& h, int& qb, int& p, int& NT, bool& band) {
    if (idx < NFOX_FULL) { h = idx / 232; const int k = idx % 232; int pp = 0, base = 0;
#pragma unroll
        for (int j = 0; j < 7; ++j) { const int cnt = 57 - 8 * j; if (k >= base + cnt && pp == j) { base += cnt; pp = j + 1; } }
        p = pp; qb = 8 * pp + 7 + (k - base); NT = 32; band = (8 * (pp + 1) == qb + 1); }
    else { const int i2 = idx - NFOX_FULL, cls = i2 >> 5, w = i2 & 31, r = 7 - cls; h = w >> 3; p = w & 7; qb = 8 * p + r - 1; NT = 4 * r; band = true; }
}
__device__ __forceinline__ void attn_item(int item, int nsel_items, const LAS int* mpre, unsigned char* ws, const unsigned* mcnt, char* shm, const int tid) {
    const int lane = tid & 63, r32 = lane & 31; const int wid = __builtin_amdgcn_readfirstlane(tid >> 6);
    const bf16* PROJ = (const bf16*)(ws + WS_PROJ);
    const int rw = wid * 32 + r32;
    int h, NT, tok, dest, kv0, tq; bool band; float cq = 0.f; const float* ckg = nullptr; bf16* PO; float* LSEp;
    if (item < NFOX) { int qb, p; fox_item(item, h, qb, p, NT, band);
        const float* CF = (const float*)(ws + WS_CF) + (size_t)h * S;
        tok = qb * 256 + rw; kv0 = p * 2048; dest = (tok * 4 + h) * 8 + p; tq = 0;
        PO = (bf16*)(ws + WS_POF); LSEp = (float*)(ws + WS_LSF);
        { const float* QN = (const float*)(ws + WS_NRM) + h * 256; const float* KN = QN + 1024;
          const float qm = fmaxf(fmaxf(QN[qb * 4], QN[qb * 4 + 1]), fmaxf(QN[qb * 4 + 2], QN[qb * 4 + 3])), ko = fmaxf(fmaxf(KN[qb * 4], KN[qb * 4 + 1]), fmaxf(KN[qb * 4 + 2], KN[qb * 4 + 3]));
          const int nfree = band ? NT - 4 : NT; const int ti = lane & 31; bool sk = false;
          if (ti < nfree) sk = qm * (KN[kv0 / 64 + ti] + ko) + (CF[qb * 256] - CF[kv0 + ti * 64 + 63]) < -40.f;
          const unsigned long long bal = __ballot(sk); int ns = __builtin_ctzll(~(bal & 0xffffffffull) | (1ull << 32));
          ns = __builtin_amdgcn_readfirstlane(ns) & ~1;
          if (!band && NT - ns < 4) { if (ns >= NT) { if (tid < 256) LSEp[((qb * 256 + tid) * 4 + h) * 8 + p] = -1e30f; return; } ns = NT - 4; }
          kv0 += ns * 64; NT -= ns; }
        cq = CF[tok]; ckg = CF + kv0;
    } else { int j; NT = 4; tq = 3; PO = (bf16*)(ws + WS_POM); LSEp = (float*)(ws + WS_LSM);
        if (item < NFOX + nsel_items) { const int k = item - NFOX; int lo = 0, hi_ = 252;
            while (hi_ - lo > 1) { const int mid = (lo + hi_) >> 1; if (mpre[mid] <= k) lo = mid; else hi_ = mid; }
            const int hj = lo, c = k - mpre[hj]; h = hj / 63; j = hj % 63; const int n = (int)mcnt[h * 64 + j] - c * 256;
            const int e = rw < n ? ((const int*)(ws + WS_QL))[((size_t)h * 63 + j) * 16384 + c * 256 + rw] : -1;
            tok = e < 0 ? 0 : (e >> 2); dest = e < 0 ? -1 : (tok * 4 + h) * 4 + (e & 3); band = false; }
        else { const int k = item - NFOX - nsel_items; h = k >> 6; j = k & 63; tok = j * 256 + rw; dest = (tok * 4 + h) * 4 + 3; band = true; }
        kv0 = j * 256; }
    attn::attn_unit<8>(PROJ + (size_t)tq * S * 256 + (size_t)tok * 256 + h * 64, PROJ + (size_t)(tq + 1) * S * 256 + (size_t)kv0 * 256 + h * 64, PROJ + (size_t)(tq + 2) * S * 256 + (size_t)kv0 * 256 + h * 64,
                       NT, band, cq, ckg, dest, PO, LSEp, shm, tid);
}
__device__ __forceinline__ void combine_token(int lane, int tok, unsigned char* ws) {
    const int h = lane >> 4, d4 = (lane & 15) * 4; bf16* YS = (bf16*)(ws + WS_YS);
    const int np = (tok >> 11) + 1; const float* LF = (const float*)(ws + WS_LSF) + ((size_t)tok * 4 + h) * 8; const bf16* PF = (const bf16*)(ws + WS_POF) + ((size_t)tok * 4 + h) * 8 * 64 + d4;
    const int own = tok >> 8, nsel = own < 3 ? own : 3; const float* LM = (const float*)(ws + WS_LSM) + ((size_t)tok * 4 + h) * 4; const bf16* PM = (const bf16*)(ws + WS_POM) + ((size_t)tok * 4 + h) * 4 * 64 + d4;
    float lf[8], lm[4]; u32x2 xf[8], xm[4];
#pragma unroll
    for (int p = 0; p < 8; ++p) { const bool on = p < np; lf[p] = on ? LF[p] : -INFINITY; xf[p] = on ? *(const u32x2*)(PF + p * 64) : (u32x2){0u, 0u}; }
#pragma unroll
    for (int s = 0; s < 4; ++s) { const bool on = s < nsel || s == 3; lm[s] = on ? LM[s] : -INFINITY; xm[s] = on ? *(const u32x2*)(PM + s * 64) : (u32x2){0u, 0u}; }
    { float m = lf[0];
#pragma unroll
      for (int p = 1; p < 8; ++p) m = fmaxf(m, lf[p]);
      float den = 0.f; f32x4 acc = (f32x4){0.f, 0.f, 0.f, 0.f};
#pragma unroll
      for (int p = 0; p < 8; ++p) { const float w = fast_exp2(lf[p] - m); den += w; acc += (f32x4){bf_lo(xf[p].x), bf_hi(xf[p].x), bf_lo(xf[p].y), bf_hi(xf[p].y)} * w; }
      const float inv = 1.f / den; u32x2 o; o.x = cvt_pk_bf16(acc[0] * inv, acc[1] * inv); o.y = cvt_pk_bf16(acc[2] * inv, acc[3] * inv);
      *(u32x2*)(YS + (size_t)tok * 768 + h * 64 + d4) = o; }
    { float m = lm[3];
#pragma unroll
      for (int s = 0; s < 3; ++s) m = fmaxf(m, lm[s]);
      float den = 0.f; f32x4 acc = (f32x4){0.f, 0.f, 0.f, 0.f};
#pragma unroll
      for (int s = 0; s < 4; ++s) { const float w = fast_exp2(lm[s] - m); den += w; acc += (f32x4){bf_lo(xm[s].x), bf_hi(xm[s].x), bf_lo(xm[s].y), bf_hi(xm[s].y)} * w; }
      const float inv = 1.f / den; u32x2 o; o.x = cvt_pk_bf16(acc[0] * inv, acc[1] * inv); o.y = cvt_pk_bf16(acc[2] * inv, acc[3] * inv);
      *(u32x2*)(YS + (size_t)tok * 768 + 512 + h * 64 + d4) = o; }
}
__global__ void __launch_bounds__(512, 2) mk_fwd(Args args_in_kernarg) {
    extern __shared__ __attribute__((aligned(16))) unsigned char lds_raw[];
    LAS unsigned char* lds = (LAS unsigned char*)lds_raw;
    const int tid0 = threadIdx.x; const int wave0 = __builtin_amdgcn_readfirstlane(tid0 >> 6);
    const int G = gridDim.x; const int bx = blockIdx.x; const int vcu = (G % 8 == 0) ? (bx % 8) * (G / 8) + bx / 8 : bx;
    const CAS unsigned char* const kargs = (const CAS unsigned char*)__builtin_amdgcn_kernarg_segment_ptr();
    for (int u = tid0; u < (LDS_BYTES - LDSCTL_OFF) / 4; u += 512) ((LAS unsigned*)(lds + LDSCTL_OFF))[u] = 0u;
    __syncthreads();
    const int lo = *(const CAS int*)(kargs + 160), hi = *(const CAS int*)(kargs + 164);
    XcdBarrier bar; bar.bar = (unsigned*)KARG_WS(kargs) + CW_BAR; bar.x = 0; bar.st = nullptr;
    if (hi - lo > 1) bar = xcd_barrier_post((unsigned*)KARG_WS(kargs) + CW_BAR, (volatile LAS unsigned*)(lds + MISC_OFF) + 8, tid0 == 0);
#if PROBE_MASK
    unsigned long long probe_t0 = 0;
#define PROBE_T0() probe_t0 = __builtin_amdgcn_s_memrealtime()
#define PROBE_END(p) do { if ((PROBE_MASK >> (p)) & 1) { asm volatile("s_waitcnt vmcnt(0)" ::: "memory"); const unsigned long long t1_ = __builtin_amdgcn_s_memrealtime(), dt_ = t1_ - probe_t0; \
        if (probe_t0 != 0) while (__builtin_amdgcn_s_memrealtime() - t1_ < dt_) __builtin_amdgcn_s_sleep(8); } probe_t0 = 0; } while (0)
#else
#define PROBE_T0() do {} while (0)
#define PROBE_END(p) do {} while (0)
#endif
#define IN(k) (lo <= (k) && (k) < hi)
#define SEAM(k) do { if (IN(k) && IN((k) + 1)) { const CAS unsigned char* kq_ = kargs; asm volatile("" : "+s"(kq_)); XcdBarrier b2_ = bar; b2_.bar = (unsigned*)KARG_WS(kq_) + CW_BAR; \
        xcd_barrier(b2_, wave0 == 0 && lane_id_now() == 0u); } } while (0)
#define PHASE_PTRS() const CAS unsigned char* kp = kargs; asm volatile("" : "+s"(kp)); unsigned char* const ws = KARG_WS(kp); (void)ws; \
    int tid = wave0 * 64 + (int)lane_id_now(); asm volatile("" : "+v"(tid)); const int lane = tid & 63, wave = __builtin_amdgcn_readfirstlane(tid >> 6); (void)lane; (void)wave
#define PROJ_ ((bf16*)(ws + WS_PROJ))
#define FQ_ (PROJ_)
#define FK_ (PROJ_ + (size_t)1 * S * 256)
#define FV_ (PROJ_ + (size_t)2 * S * 256)
#define MQ_ (PROJ_ + (size_t)3 * S * 256)
#define MK_ (PROJ_ + (size_t)4 * S * 256)
#define MV_ (PROJ_ + (size_t)5 * S * 256)
#define GQK_ (PROJ_ + (size_t)6 * S * 256)
#define GV_ (PROJ_ + (size_t)7 * S * 256)
#define GR_ (PROJ_ + (size_t)8 * S * 256)
    LAS int* const tab = (LAS int*)(lds + TAB_OFF);

    if (IN(0)) { PROBE_T0(); PHASE_PTRS(); p0_prologue(kp, lds, vcu, G, tid); }
    PROBE_END(15); SEAM(0);

    for (int l = 0; l < DEPTH; ++l) {
        const int pb = 1 + l * NPH;
        if (hi <= pb || lo >= pb + NPH) continue;
        if (IN(pb + 0)) { PROBE_T0(); PHASE_PTRS();
            { pg8::DenseOrder So; So.init(S, NIN, 1024, (const bf16*)(ws + WS_WIN) + (size_t)l * NIN * 1024, G, bx);
              pg8::EpiIn E{PROJ_, (bf16*)(ws + WS_SG), (float*)(ws + WS_LA), (float*)(ws + WS_FFL), KARG_IN(kp, 4) + l * 128, KARG_IN(kp, 2) + l * 4};
              pg8::gemm_phase<pg8::EpiIn, pg8::DenseOrder, true, false>(lds, (const bf16*)(ws + WS_XB), 1024, 1024, So, E, tid); }
            asm volatile("s_waitcnt vmcnt(0)" ::: "memory"); __syncthreads();
            { int Kq = 1024; asm volatile("" : "+s"(Kq));
              pg8::DenseOrder So; So.init(S, 3072, Kq, (const bf16*)(ws + WS_WIN8 + (size_t)l * 3072 * 1024), G, bx); So.K = Kq; So.split = (G == 256) ? 128 : 0;
              pg8::EpiGate E{(unsigned char*)(ws + WS_SG)};
              pg8::gemm_phase<pg8::EpiGate, pg8::DenseOrder, true, false, true>(lds, (const bf16*)(ws + WS_XB8), Kq, Kq, So, E, tid); }
        }
        PROBE_END(0); SEAM(pb + 0);
        if (IN(pb + 1)) { PROBE_T0(); PHASE_PTRS();
            const bf16* MK = MK_; float* KM = (float*)(ws + WS_KM);
            for (int wj = vcu * 8 + wave; wj < 1024 + 2048 + 256; wj += G * 8) {
                if (wj < 1024) gla_local_wave(lds + wave * 16384, lane, wj >> 2, wj & 3, GQK_, GV_, (const float*)(ws + WS_LA), (float*)(ws + WS_U), (float*)(ws + WS_DEC));
                else if (wj < 3072) {
                    const int idx = wj - 1024, tile = idx >> 3, which = (idx >> 2) & 1, h = idx & 3;
                    const bf16* src_ = PROJ_ + (size_t)which * S * 256 + (size_t)(tile * 64 + lane) * 256 + h * 64; float ss = 0.f;
#pragma unroll
                    for (int c = 0; c < 8; ++c) { const u32x4 w = *(const u32x4*)(src_ + c * 8); const float a0 = bf_lo(w.x), a1 = bf_hi(w.x), a2 = bf_lo(w.y), a3 = bf_hi(w.y), a4 = bf_lo(w.z), a5 = bf_hi(w.z), a6 = bf_lo(w.w), a7 = bf_hi(w.w);
                        ss += (a0 * a0 + a1 * a1) + (a2 * a2 + a3 * a3) + (a4 * a4 + a5 * a5) + (a6 * a6 + a7 * a7); }
                    float nm = sqrtf(ss);
#pragma unroll
                    for (int o = 1; o < 64; o <<= 1) nm = fmaxf(nm, shx(nm, o));
                    if (lane == 0) ((float*)(ws + WS_NRM))[(which * 4 + h) * 256 + tile] = nm; }
                else {
                    const int hj = wj - 3072, h = hj >> 6, j = hj & 63, kp = lane >> 4, dq = lane & 15;
                    const bf16* mk = MK_ + (size_t)(j * 256 + kp) * 256 + h * 64 + dq * 4; f32x4 s4 = (f32x4){0.f, 0.f, 0.f, 0.f};
#pragma unroll 1
                    for (int ib = 0; ib < 64; ib += 16) { u32x2 w[16];
#pragma unroll
                        for (int i = 0; i < 16; ++i) w[i] = *(const u32x2*)(mk + (size_t)(ib + i) * 4 * 256);
                        asm volatile("" : "+v"(w[0]), "+v"(w[1]), "+v"(w[2]), "+v"(w[3]), "+v"(w[4]), "+v"(w[5]), "+v"(w[6]), "+v"(w[7]), "+v"(w[8]), "+v"(w[9]), "+v"(w[10]), "+v"(w[11]), "+v"(w[12]), "+v"(w[13]), "+v"(w[14]), "+v"(w[15]));
#pragma unroll
                        for (int i = 0; i < 16; ++i) s4 += (f32x4){bf_lo(w[i].x), bf_hi(w[i].x), bf_lo(w[i].y), bf_hi(w[i].y)}; }
#pragma unroll
                    for (int c = 0; c < 4; ++c) { s4[c] += shx(s4[c], 16); s4[c] += shx(s4[c], 32); }
                    if (kp == 0) *(f32x4*)((float*)(ws + WS_KM) + (size_t)(h * 64 + j) * 64 + dq * 4) = s4 * (1.f / 256.f); }
            }
        }
        PROBE_END(1); SEAM(pb + 1);
        if (IN(pb + 2)) { PROBE_T0(); PHASE_PTRS();
            for (int job = vcu; job < 128 + 4 + 128; job += G) {
                if (job < 128) {
                    const float* DEC = (const float*)(ws + WS_DEC); const float* Ub = (const float*)(ws + WS_U); float* SST = (float*)(ws + WS_SST);
                    LAS float* cd = (LAS float*)lds; LAS float* cu = cd + 512;
                    const int e = job * 64 + lane; const float* dp = DEC + (size_t)wave * 32 * 128 + (e >> 6); const float* up = Ub + (size_t)wave * 32 * 8192 + e; float* sp = SST + (size_t)wave * 32 * 8192 + e;
                    float d[32], u[32];
#pragma unroll
                    for (int k = 0; k < 32; ++k) { d[k] = dp[k * 128]; u[k] = up[(size_t)k * 8192]; }
                    float dd = 1.f, uu = 0.f;
#pragma unroll
                    for (int k = 0; k < 32; ++k) { uu = uu * d[k] + u[k]; dd *= d[k]; }
                    cd[wave * 64 + lane] = dd; cu[wave * 64 + lane] = uu;
                    __syncthreads();
                    float s = 0.f;
                    for (int g2 = 0; g2 < wave; ++g2) s = s * cd[g2 * 64 + lane] + cu[g2 * 64 + lane];
#pragma unroll
                    for (int k = 0; k < 32; ++k) { sp[(size_t)k * 8192] = s; s = s * d[k] + u[k]; }
                    __syncthreads(); }
                else if (job < 132) { const float* FFL = (const float*)(ws + WS_FFL); float* CF = (float*)(ws + WS_CF);
                    const int h = job - 128; LAS float* wt = (LAS float*)lds; const f32x4* sp4 = (const f32x4*)(FFL + (size_t)h * S + tid * 32); f32x4 x[8];
#pragma unroll
                    for (int i = 0; i < 8; ++i) x[i] = sp4[i];
                    float run = 0.f;
#pragma unroll
                    for (int i = 0; i < 8; ++i) { x[i][0] += run; x[i][1] += x[i][0]; x[i][2] += x[i][1]; x[i][3] += x[i][2]; run = x[i][3]; }
                    float tot = run;
#pragma unroll
                    for (int o = 1; o < 64; o <<= 1) { const float y = shu(tot, o); if (lane >= o) tot += y; }
                    if (lane == 63) wt[wave] = tot;
                    __syncthreads();
                    float pre = tot - run;
                    for (int w = 0; w < wave; ++w) pre += wt[w];
                    f32x4* dp4 = (f32x4*)(CF + (size_t)h * S + tid * 32);
#pragma unroll
                    for (int i = 0; i < 8; ++i) dp4[i] = (x[i] + pre) * LOG2E;
                    __syncthreads(); }
                else moba_gate_batch(lds, tid, 127 - (job - 132), MQ_, (const float*)(ws + WS_KM), (int*)(ws + WS_QL), (unsigned*)ws + CW_MCNT + l * 256);
            }
        }
        PROBE_END(2); SEAM(pb + 2);
        if (IN(pb + 3)) { PROBE_T0(); PHASE_PTRS();
            bf16* const YS = (bf16*)(ws + WS_YS);
            for (int wj = vcu * 8 + wave; wj < 1024; wj += G * 8) gla_out_wave(lds + wave * 16384, lane, wj >> 2, wj & 3, GQK_, GV_, GR_, (const float*)(ws + WS_LA), (const float*)(ws + WS_SST), KARG_IN(kp, 5) + l * 256, YS + 256);
            __syncthreads();
            LAS int* const mpre = (LAS int*)(lds + RT_OFF); LAS int* const qslot = mpre + 256;
            const unsigned* mcnt = (const unsigned*)ws + CW_MCNT + l * 256; unsigned* qhead = (unsigned*)ws + CW_Q + l * 64;
            if (tid < 64) { int c4[4]; int s4 = 0;
#pragma unroll
                for (int i = 0; i < 4; ++i) { const int hj = tid * 4 + i; const int c = hj < 252 ? (int)mcnt[(hj / 63) * 64 + hj % 63] : 0; c4[i] = (c + 255) >> 8; s4 += c4[i]; }
                int incl = s4;
#pragma unroll
                for (int o = 1; o < 64; o <<= 1) { const int y = shu(incl, o); if (tid >= o) incl += y; }
                int run = incl - s4;
#pragma unroll
                for (int i = 0; i < 4; ++i) { if (tid * 4 + i <= 252) mpre[tid * 4 + i] = run; run += c4[i]; } }
            if (tid == 0) qslot[0] = (int)__hip_atomic_fetch_add(qhead, 1u, __ATOMIC_RELAXED, __HIP_MEMORY_SCOPE_AGENT);
            __syncthreads();
            const int nsel_items = mpre[252], total = NFOX + nsel_items + 256;
            int cur = qslot[0];
            __syncthreads();
            while (cur < total) {
                int nxt = 0;
                if (tid == 0) nxt = (int)__hip_atomic_fetch_add(qhead, 1u, __ATOMIC_RELAXED, __HIP_MEMORY_SCOPE_AGENT);
                attn_item(cur, nsel_items, mpre, ws, mcnt, (char*)lds_raw, tid);
                if (tid == 0) qslot[0] = nxt;
                __syncthreads();
                cur = qslot[0];
                __syncthreads();
            }
        }
        PROBE_END(3); SEAM(pb + 3);
        if (IN(pb + 4)) { PROBE_T0(); PHASE_PTRS();
            for (int t = (vcu * 8 + wave) * 8; t < S; t += G * 64) {
#pragma unroll 2
                for (int i = 0; i < 8; ++i) combine_token(lane, t + i, ws); }
        }
        PROBE_END(4); SEAM(pb + 4);
        if (IN(pb + 5)) { PROBE_T0(); PHASE_PTRS();
            int Kl = 768; asm volatile("" : "+s"(Kl));
            pg8::DenseOrder So; So.init(S, 1024, Kl, (const bf16*)(ws + WS_WBR) + (size_t)l * 1024 * 768, G, bx);
            pg8::EpiLift E{(const unsigned char*)(ws + WS_SG), (bf16*)(ws + WS_MRG)};
            pg8::gemm_phase<pg8::EpiLift, pg8::DenseOrder, true, false, false, true>(lds, (const bf16*)(ws + WS_YS), Kl, Kl, So, E, tid);
        }
        PROBE_END(5); SEAM(pb + 5);
        if (IN(pb + 6)) { PROBE_T0(); PHASE_PTRS();
            pg8::DenseOrder So; So.init(S, 1024, 1024, (const bf16*)(ws + WS_WOUT) + (size_t)l * 1024 * 1024, G, bx);
            pg8::EpiF32 E{(bf16*)(ws + WS_Y)};
            pg8::gemm_phase<pg8::EpiF32, pg8::DenseOrder, true, false>(lds, (const bf16*)(ws + WS_MRG), 1024, 1024, So, E, tid);
        }
        PROBE_END(6); SEAM(pb + 6);
        if (IN(pb + 7)) { PROBE_T0(); PHASE_PTRS();
            for (int blk = vcu; blk < S / 64; blk += G)
                ln1_router_block(lds, tid, blk, (const bf16*)(ws + WS_XB), (const bf16*)(ws + WS_Y), KARG_IN(kp, 8) + l * 1024, KARG_IN(kp, 9) + l * 1024, KARG_IN(kp, 11) + l * 32, (const bf16*)(ws + WS_WRT) + (size_t)l * 65536, (bf16*)(ws + WS_X1), (unsigned char*)(ws + WS_X1F),
                                 (unsigned*)ws + CW_CNT + l * 64, (int*)(ws + WS_TOK), (int*)(ws + WS_TE), (int*)(ws + WS_TP), (float*)(ws + WS_TG));
        }
        PROBE_END(7); SEAM(pb + 7);
        if (IN(pb + 8)) { PROBE_T0(); PHASE_PTRS();
            moe_table((const unsigned*)ws + CW_CNT + l * 64, tab, tid);
            pg8::MoeOrder So{G, vcu, 8, tab[65], tab, (const int*)(ws + WS_TOK), (const char*)(ws + WS_WGU) + (size_t)l * 32 * 2048 * 1024, (size_t)2048 * 1024, 1024};
            pg8::EpiMoe1 E{(unsigned char*)(ws + WS_ACT), KARG_IN(kp, 13) + (size_t)l * 32 * 2048, (const LAS float*)(lds + RT_OFF)};
            int Kq = 1024; asm volatile("" : "+s"(Kq));
            pg8::gemm_phase<pg8::EpiMoe1, pg8::MoeOrder, true, true, true, false, true>(lds, (const bf16*)(ws + WS_X1F), Kq, Kq, So, E, tid);
        }
        PROBE_END(8); SEAM(pb + 8);
        if (IN(pb + 9)) { PROBE_T0(); PHASE_PTRS();
            moe_table((const unsigned*)ws + CW_CNT + l * 64, tab, tid);
            pg8::MoeOrder So{G, vcu, 4, tab[65], tab, nullptr, (const char*)(ws + WS_WDN) + (size_t)l * 32 * 1024 * 1024, (size_t)1024 * 1024, 1024};
            pg8::EpiMoe2 E{(bf16*)(ws + WS_YB), KARG_IN(kp, 15) + (size_t)l * 32 * 1024, (const LAS float*)(lds + RT_OFF)};
            int Kq = 1024; asm volatile("" : "+s"(Kq));
            pg8::gemm_phase<pg8::EpiMoe2, pg8::MoeOrder, true, false, true, false, true>(lds, (const bf16*)(ws + WS_ACT), Kq, Kq, So, E, tid);
        }
        PROBE_END(9); SEAM(pb + 9);
        if (IN(pb + 10)) { PROBE_T0(); PHASE_PTRS();
            moe_table((const unsigned*)ws + CW_CNT + l * 64, tab, tid);
            float* outp = (l == DEPTH - 1) ? KARG_OUT(kp) : nullptr;
            for (int t0 = (vcu * 8 + wave) * 8; t0 < S; t0 += G * 64) ln2_rows8(lane, t0, (const bf16*)(ws + WS_X1), (const bf16*)(ws + WS_YB), tab, (const int*)(ws + WS_TE), (const int*)(ws + WS_TP), (const float*)(ws + WS_TG),
                                                                            KARG_IN(kp, 16) + l * 1024, KARG_IN(kp, 17) + l * 1024, (bf16*)(ws + WS_XB), (unsigned char*)(ws + WS_XB8), outp);
        }
        PROBE_END(10); SEAM(pb + 10);
    }
#undef IN
#undef SEAM
}

extern "C" void kernel_launch(void* const* d_in, const int* in_sizes, int n_in, void* d_out, int out_size, void* d_ws, size_t ws_size, hipStream_t stream) {
    static int grid = 0;
    if (grid == 0) {
        if (n_in != 18 || out_size != S * D || ws_size < WS_END) { fprintf(stderr, "kernel_launch: unexpected shapes (n_in %d out %d ws %zu, need %zu)\n", n_in, out_size, ws_size, (size_t)WS_END); grid = -1; return; }
        int dev = 0, cus = 0, per_cu = 0;
        if (hipGetDevice(&dev) != hipSuccess || hipDeviceGetAttribute(&cus, hipDeviceAttributeMultiprocessorCount, dev) != hipSuccess) { grid = -1; return; }
        if (hipFuncSetAttribute((const void*)mk_fwd, hipFuncAttributeMaxDynamicSharedMemorySize, LDS_BYTES) != hipSuccess) { fprintf(stderr, "kernel_launch: hipFuncSetAttribute failed\n"); grid = -1; return; }
        if (hipOccupancyMaxActiveBlocksPerMultiprocessor(&per_cu, (const void*)mk_fwd, 512, LDS_BYTES) != hipSuccess || per_cu < 1) fprintf(stderr, "kernel_launch: occupancy query says %d\n", per_cu);
        (void)hipGetLastError();
        grid = cus;
    }
    if (grid < 0) return;
    (void)hipMemsetAsync((char*)d_ws + WS_CTL, 0, CTL_ZERO_BYTES, stream);
    Args a{};
    for (int i = 0; i < 18; ++i) a.in[i] = (const float*)d_in[i];
    a.out = (float*)d_out; a.ws = (unsigned char*)d_ws;
#if MK_PER_PHASE
    for (int p = 0; p < NPHASE; ++p) { a.ph_lo = p; a.ph_hi = p + 1; hipLaunchKernelGGL(mk_fwd, dim3(grid), dim3(512), LDS_BYTES, stream, a); }
#else
    a.ph_lo = 0; a.ph_hi = NPHASE;
    hipLaunchKernelGGL(mk_fwd, dim3(grid), dim3(512), LDS_BYTES, stream, a);
#endif
}
```

```cpp
#include <hip/hip_runtime.h>
#include <cstdio>
#include <cstdint>

#ifndef MK_PER_PHASE
#define MK_PER_PHASE 0
#endif

#ifndef PROBE_MASK
#define PROBE_MASK 0
#endif
#define LAS __attribute__((address_space(3)))
#define GAS __attribute__((address_space(1)))
typedef unsigned short bf16;
typedef short bf16x8 __attribute__((ext_vector_type(8)));
typedef float f32x4 __attribute__((ext_vector_type(4)));
typedef float f32x2 __attribute__((ext_vector_type(2)));
typedef unsigned u32x4 __attribute__((ext_vector_type(4)));
typedef unsigned u32x2 __attribute__((ext_vector_type(2)));
typedef int v8i32_t __attribute__((ext_vector_type(8)));
typedef short bf16x16_t __attribute__((ext_vector_type(16)));

constexpr int S = 16384, D = 1024, DEPTH = 4;
constexpr int D_IN = 5396, NIN = 2560;
constexpr int NE = 32;
constexpr int NSLOT = 73728;
constexpr float ALPHA = 1.6817928305074290f;
constexpr float LOG2E = 1.4426950408889634f;
constexpr float C2 = 0.125f * LOG2E;
constexpr float LN_EPS = 1e-5f, RMS_EPS = 1e-6f;
constexpr int NPH = 11;
constexpr int NPHASE = 1 + DEPTH * NPH;

constexpr size_t MiB = 1ull << 20;
constexpr size_t WS_CTL = 0, CTL_ZERO_BYTES = 1 * MiB;
constexpr size_t WS_WIN = 1 * MiB;
constexpr size_t WS_WBR = WS_WIN + 44 * MiB;
constexpr size_t WS_WOUT = WS_WBR + 6 * MiB;
constexpr size_t WS_WGU = WS_WOUT + 8 * MiB;
constexpr size_t WS_WDN = WS_WGU + 512 * MiB;
constexpr size_t WS_XB = WS_WDN + 256 * MiB;
constexpr size_t WS_X1 = WS_XB + 32 * MiB;
constexpr size_t WS_PROJ = WS_X1 + 32 * MiB;
constexpr size_t WS_SG = WS_PROJ + 72 * MiB;
constexpr size_t WS_LA = WS_SG + 96 * MiB;
constexpr size_t WS_FFL = WS_LA + 8 * MiB;
constexpr size_t WS_CF = WS_FFL + 1 * MiB;
constexpr size_t WS_YS = WS_CF + 1 * MiB;
constexpr size_t WS_T = WS_YS + 24 * MiB;
constexpr size_t WS_MRG = WS_T + 64 * MiB;
constexpr size_t WS_Y = WS_MRG + 32 * MiB;
constexpr size_t WS_ACT = WS_Y + 64 * MiB;
constexpr size_t WS_YB = WS_ACT + 144 * MiB;
constexpr size_t WS_U = WS_YB + 144 * MiB;
constexpr size_t WS_SST = WS_U + 8 * MiB;
constexpr size_t WS_DEC = WS_SST + 8 * MiB;
constexpr size_t WS_KM = WS_DEC + 1 * MiB;
constexpr size_t WS_NRM = WS_KM + 256 * 1024;
constexpr size_t WS_SEL = WS_KM + 1 * MiB;
constexpr size_t WS_QL = WS_SEL + 1 * MiB;
constexpr size_t WS_TOK = WS_QL + 16 * MiB;
constexpr size_t WS_TE = WS_TOK + 2 * MiB;
constexpr size_t WS_TP = WS_TE + 1 * MiB;
constexpr size_t WS_TG = WS_TP + 1 * MiB;
constexpr size_t WS_POF = WS_TG + 1 * MiB;
constexpr size_t WS_LSF = WS_POF + 64 * MiB;
constexpr size_t WS_POM = WS_LSF + 2 * MiB;
constexpr size_t WS_LSM = WS_POM + 32 * MiB;
constexpr size_t WS_WBP = WS_LSM + 1 * MiB;
constexpr size_t WS_XB8 = WS_WBP + 17 * MiB;
constexpr size_t WS_WIN8 = WS_WBP + 33 * MiB;
constexpr size_t WS_X1F = WS_WBP + 1 * MiB;
constexpr size_t WS_WRT = WS_WBP;
constexpr size_t WS_END = WS_WBP + 46 * MiB;
constexpr int CW_BAR = 4096;
constexpr int CW_CNT = 16384;
constexpr int CW_MCNT = 20480;
constexpr int CW_Q = 24576;

constexpr int RING_BYTES = 131072;
constexpr int LDSCTL_OFF = RING_BYTES, MISC_OFF = LDSCTL_OFF + 320;
constexpr int TAB_OFF = RING_BYTES + 1024;
constexpr int RT_OFF = RING_BYTES + 4096;
constexpr int LDS_BYTES = 147456;

__device__ __forceinline__ float bf_lo(unsigned w) { return __uint_as_float(w << 16); }
__device__ __forceinline__ float bf_hi(unsigned w) { return __uint_as_float(w & 0xffff0000u); }
__device__ __forceinline__ float bf2f(bf16 b) { return __uint_as_float((unsigned)b << 16); }
typedef __bf16 bf16x2_t __attribute__((ext_vector_type(2)));
__device__ __forceinline__ unsigned cvt_pk_bf16(float lo, float hi) { f32x2 v = {lo, hi}; bf16x2_t b = __builtin_convertvector(v, bf16x2_t); return __builtin_bit_cast(unsigned, b); }
__device__ __forceinline__ unsigned cvt4_fp8(float a, float b, float c, float d) { int w = 0; w = __builtin_amdgcn_cvt_pk_fp8_f32(a, b, w, false); w = __builtin_amdgcn_cvt_pk_fp8_f32(c, d, w, true); return (unsigned)w; }
__device__ __forceinline__ float fast_exp2(float x) { return __builtin_amdgcn_exp2f(x); }
__device__ __forceinline__ float fast_rcp(float x) { return __builtin_amdgcn_rcpf(x); }
__device__ __forceinline__ float sigmoidf_(float x) { return fast_rcp(1.f + fast_exp2(-x * LOG2E)); }
__device__ __forceinline__ float logsigmoidf_(float x) { return fminf(x, 0.f) - __logf(1.f + __expf(-fabsf(x))); }
__device__ __forceinline__ unsigned lane_id_now() { unsigned r; asm volatile("v_mbcnt_lo_u32_b32 %0, -1, 0\n\tv_mbcnt_hi_u32_b32 %0, -1, %0" : "=v"(r)); return r; }
__device__ __forceinline__ int shx(int v, int m) { const int ln = (int)lane_id_now(); return __builtin_amdgcn_ds_bpermute((ln ^ m) << 2, v); }
__device__ __forceinline__ float shx(float v, int m) { return __uint_as_float((unsigned)shx((int)__float_as_uint(v), m)); }
__device__ __forceinline__ int shu(int v, int d) { const int ln = (int)lane_id_now(); const int s = ln - d; return __builtin_amdgcn_ds_bpermute((s < 0 ? ln : s) << 2, v); }
__device__ __forceinline__ float shu(float v, int d) { return __uint_as_float((unsigned)shu((int)__float_as_uint(v), d)); }
__device__ __forceinline__ float wave_sum(float v) {
#pragma unroll
    for (int o = 1; o < 64; o <<= 1) v += shx(v, o);
    return v;
}

namespace pg8 {
constexpr int BM = 256, BK = 64, HALF = 128, HTB = HALF * BK * 2, NXCD = 8, WGM = 8;
__device__ __forceinline__ int lds_byte(int r, int c) { const int st = (r >> 4) * 2 + (c >> 5), rr = r & 15, cc = c & 31, ob = rr * 64 + cc * 2; return st * 1024 + (ob ^ (((ob >> 9) & 1) << 5)); }
__device__ __forceinline__ void stage_rc(int b, int& R, int& C) { const int st = b / 1024, sb = b % 1024, swz = sb ^ (((sb >> 9) & 1) << 5); R = (st >> 1) * 16 + swz / 64; C = (st & 1) * 32 + (swz % 64) / 2; }
__device__ __forceinline__ int perm32(int rho) { const int n = rho >> 4, i = rho & 15; return 8 * (i >> 2) + 4 * n + (i & 3); }

struct Unit { int pm, pn, e, half, par; };

struct DenseOrder {
    int nM, nN, nwg, G, c; const char* Bt; int K; int split = 0;
    __device__ void init(int M, int N, int K_, const bf16* Bt_, int G_, int c_) { nM = M / BM; nN = N / BM; nwg = nM * nN; G = G_; c = c_; Bt = (const char*)Bt_; K = K_ * 2; }
    __device__ bool next(int i, Unit& u) const {
        long L = (long)i * G + c;
        if (split > 0 && i >= 2) { if (c < split || i >= 4) return false; L = 2l * G + (long)(i - 2) * (G - split) + (c - split); }
        if (L >= nwg) return false;
        int wgid = (int)L; { const int q = nwg / NXCD, r = nwg % NXCD, xcd = wgid % NXCD, off = wgid / NXCD; wgid = (xcd < r ? xcd * (q + 1) : r * (q + 1) + (xcd - r) * q) + off; }
        const int nig = WGM * nN, gid = wgid / nig, fm = gid * WGM, gsz = (nM - fm) < WGM ? (nM - fm) : WGM;
        u.pm = fm + ((wgid % nig) % gsz); u.pn = (wgid % nig) / gsz; u.e = 0; return true;
    }
    __device__ __forceinline__ unsigned arow(const Unit& u, int r) const { return (unsigned)(u.pm * BM + r); }
    __device__ __forceinline__ const char* bbase(const Unit& u) const { return Bt + (size_t)u.pn * BM * K; }
};

struct MoeOrder {
    int G, c, NN, ntiles; const LAS int* tab; const int* toklist; const char* Bt; size_t ebytes; int K;
    __device__ bool next(int i, Unit& u) const {
        const int L = i * G + c; if (L >= ntiles * NN) return false;
        const int k = L / NN; u.pm = tab[448 + k]; u.pn = L % NN; u.e = tab[128 + u.pm]; u.half = k >= tab[66] ? 1 : 0; return true;
    }
    __device__ __forceinline__ unsigned arow(const Unit& u, int r) const {
        if (!toklist) return (unsigned)(u.pm * BM + r);
        const int rr = (u.pm - tab[32 + u.e]) * BM + r;
        return rr < tab[u.e] ? (unsigned)toklist[u.e * 16384 + rr] : 0u;
    }
    __device__ __forceinline__ const char* bbase(const Unit& u) const { return Bt + (size_t)u.e * ebytes + (size_t)u.pn * BM * K; }
};

template <class Epi, class Sched, bool ALIGN_EPI, bool GATHER, bool FP8 = false, bool HOOK = false, bool TAILS = false>
__device__ __forceinline__ void gemm_phase(LAS unsigned char* lds, const bf16* Abase, const int K, const int lda, const Sched& S, const Epi& E, const int tid_in) {
    int tid_ = tid_in; asm volatile("" : "+v"(tid_));
    const int tid = tid_, wid = __builtin_amdgcn_readfirstlane(tid >> 6), lane = tid & 63, wr = wid >> 2, wc = wid & 3, fr = lane & 15, fq = lane >> 4;
    constexpr int EB = FP8 ? 1 : 2;
    const int nt = K * EB / 128;
    unsigned voffA[2], voffB[2];
#pragma unroll
    for (int i = 0; i < 2; ++i) { int R, C; stage_rc(tid * 16 + i * 8192, R, C); const int Rb = Epi::PERM == 3 ? ((R >> 5) * 64 + ((R >> 2) & 3) * 16 + ((R >> 4) & 1) * 4 + (R & 3)) : Epi::PERM ? ((R & ~31) + perm32(R & 31)) : R;
        voffA[i] = (unsigned)(R * lda * EB + C * 2); voffB[i] = (unsigned)(Rb * K * EB + C * 2); }
    LAS u32x4* const stash = (LAS u32x4*)(lds + RING_BYTES + 8192) + tid;
    const size_t kstep = (size_t)(BK * 2);
    const size_t hstep = (size_t)(Epi::PERM == 3 ? 8 : HALF) * K * EB;
    const size_t hstepA = (size_t)HALF * lda * EB;
    const unsigned ldsw = (unsigned)wid * 1024u;
    const unsigned ldsbase = (unsigned)(uintptr_t)lds;
    const int aoff = lds_byte(wr * 64 + fr, fq * 8), boff = lds_byte(wc * 32 + fr, fq * 8);
    const char* gA = (const char*)Abase;
#define PG8_SA(b, h) (((b) * 2 + (h)) * HTB)
#define PG8_SB(b, h) ((4 + (b) * 2 + (h)) * HTB)
#define PG8_STAGE(bufoff, gbase, voff) do { _Pragma("unroll") for (int _i = 0; _i < 2; ++_i) { unsigned keep_; \
        asm volatile("s_mov_b32 %0, m0\n\ts_mov_b32 m0, %3\n\ts_nop 0\n\tglobal_load_lds_dwordx4 %1, %2\n\ts_mov_b32 m0, %0" : "=&s"(keep_) \
            : "v"((voff)[_i]), "s"((const char*)(gbase)), "s"((unsigned)__builtin_amdgcn_readfirstlane(ldsbase + (unsigned)(bufoff) + ldsw + _i * 8192u)) : "memory"); } } while (0)
#define PG8_LD32(addr) __builtin_bit_cast(v8i32_t, __builtin_shufflevector(*(const LAS u32x4*)(addr), *(const LAS u32x4*)((addr) + 1024), 0, 1, 2, 3, 4, 5, 6, 7))
#define PG8_LDA(dst, b, h) do { if constexpr (FP8) { _Pragma("unroll") for (int m = 0; m < 4; ++m) dst##8[m] = PG8_LD32(lds + PG8_SA(b, h) + aoff + m * 2048); } \
        else { _Pragma("unroll") for (int m = 0; m < 4; ++m) _Pragma("unroll") for (int k = 0; k < 2; ++k) dst[m][k] = *(const LAS bf16x8*)(lds + PG8_SA(b, h) + aoff + m * 2048 + k * 1024); } } while (0)
#define PG8_LDB(dst, b, h) do { if constexpr (FP8) { _Pragma("unroll") for (int n = 0; n < 2; ++n) dst##8[n] = PG8_LD32(lds + PG8_SB(b, h) + boff + n * 2048); } \
        else { _Pragma("unroll") for (int n = 0; n < 2; ++n) _Pragma("unroll") for (int k = 0; k < 2; ++k) dst[n][k] = *(const LAS bf16x8*)(lds + PG8_SB(b, h) + boff + n * 2048 + k * 1024); } } while (0)
#define PG8_CAT(x) __builtin_bit_cast(v8i32_t, __builtin_shufflevector(__builtin_bit_cast(u32x4, x[0]), __builtin_bit_cast(u32x4, x[1]), 0, 1, 2, 3, 4, 5, 6, 7))
#define PG8_MMA(ai, bj, At, Bt) do { __builtin_amdgcn_s_setprio(1); \
        if constexpr (FP8) { _Pragma("unroll") for (int m = 0; m < 4; ++m) _Pragma("unroll") for (int n = 0; n < 2; ++n) \
            acc[ai][bj][m][n] = __builtin_amdgcn_mfma_scale_f32_16x16x128_f8f6f4(Bt##8[n], At##8[m], acc[ai][bj][m][n], 0, 0, 0, 0x7f7f7f7f, 0, 0x7f7f7f7f); } \
        else { _Pragma("unroll") for (int m = 0; m < 4; ++m) _Pragma("unroll") for (int n = 0; n < 2; ++n) _Pragma("unroll") for (int k = 0; k < 2; ++k) \
            acc[ai][bj][m][n] = __builtin_amdgcn_mfma_f32_16x16x32_bf16(Bt[n][k], At[m][k], acc[ai][bj][m][n], 0, 0, 0); } \
        __builtin_amdgcn_s_setprio(0); } while (0)
#define PG8_WAIT_V(n) asm volatile("s_waitcnt vmcnt(" #n ")" ::: "memory")
#define PG8_WAIT_L(n) asm volatile("s_waitcnt lgkmcnt(" #n ")" ::: "memory")
#define PG8_BAR __builtin_amdgcn_s_barrier()
#define PG8_SCHED __builtin_amdgcn_sched_barrier(0)
#define PG8_AOFF(dst, u) do { _Pragma("unroll") for (int _h = 0; _h < 2; ++_h) _Pragma("unroll") for (int _i = 0; _i < 2; ++_i) { int _R, _C; stage_rc(tid * 16 + _i * 8192, _R, _C); \
        dst[_h][_i] = S.arow(u, _h * HALF + _R) * (unsigned)(lda * EB) + (unsigned)(_C * 2); } } while (0)
    Unit cur, nxt; int ui = 0;
    if (!S.next(0, cur)) return;
    f32x4 acc[2][2][4][2];
#pragma unroll
    for (int a = 0; a < 2; ++a)
#pragma unroll
        for (int b = 0; b < 2; ++b)
#pragma unroll
            for (int m = 0; m < 4; ++m)
#pragma unroll
                for (int n = 0; n < 2; ++n) acc[a][b][m][n] = (f32x4){0.f, 0.f, 0.f, 0.f};
    bf16x8 At[4][2], B0[2][2], B1[2][2];
    v8i32_t At8[4], B08[2], B18[2];
    unsigned curA[2][2];
    const char* cA = gA;
    if constexpr (GATHER) { PG8_AOFF(curA, cur); }
    else { cA = gA + (size_t)S.arow(cur, 0) * lda * EB; }
#define PG8_STA(bufoff, ptr, h) do { if constexpr (GATHER) { PG8_STAGE(bufoff, ptr, curA[h]); } else { PG8_STAGE(bufoff, (ptr) + (h) * hstepA, voffA); } } while (0)
    const char* cB = S.bbase(cur);
    PG8_STAGE(PG8_SB(0, 0), cB, voffB); PG8_STAGE(PG8_SB(0, 1), cB + hstep, voffB); PG8_STA(PG8_SA(0, 0), cA, 0); PG8_STA(PG8_SA(0, 1), cA, 1);
    if (wr == 1) PG8_BAR;
    PG8_WAIT_V(2); PG8_BAR;
    PG8_STAGE(PG8_SB(1, 0), cB + kstep, voffB); PG8_STA(PG8_SA(1, 0), cA + kstep, 0); PG8_STAGE(PG8_SB(1, 1), cB + hstep + kstep, voffB);
    PG8_WAIT_V(6); PG8_BAR;
    for (;;) {
        if constexpr (Epi::LDSBIAS) {
            cur.par = ui & 1;
            if (wid == 0) { const unsigned long long bp_ = (unsigned long long)(uintptr_t)E.bsrc(cur);
                const char* bsrc_ = (const char*)(uintptr_t)(((unsigned long long)(unsigned)__builtin_amdgcn_readfirstlane((int)(bp_ >> 32)) << 32) | (unsigned)__builtin_amdgcn_readfirstlane((int)bp_));
                unsigned keep_; asm volatile("s_mov_b32 %0, m0\n\ts_mov_b32 m0, %3\n\ts_nop 0\n\tglobal_load_lds_dwordx4 %1, %2\n\ts_mov_b32 m0, %0" : "=&s"(keep_)
                : "v"((unsigned)(lane * 16)), "s"(bsrc_), "s"((unsigned)__builtin_amdgcn_readfirstlane(ldsbase + (unsigned)RT_OFF + (unsigned)cur.par * 1024u)) : "memory"); } }
        const bool has_next = S.next(ui + 1, nxt);
        const char* nB = cB; const char* nA = cA;
        if (has_next) { nB = S.bbase(nxt);
            if constexpr (GATHER) { unsigned na[2][2]; PG8_AOFF(na, nxt); *stash = (u32x4){na[0][0], na[0][1], na[1][0], na[1][1]}; }
            else nA = gA + (size_t)S.arow(nxt, 0) * lda * EB; }
#define PG8_KLOOP(FULL) \
        for (int t = 0; t < nt; t += 2) { \
            if constexpr (HOOK) { if (t == 4 || t == 8) { int fr_ = fr, fq_ = fq; asm volatile("" : "+v"(fr_), "+v"(fq_)); E.hook(acc, cur, t >> 2, wr, wc, fr_, fq_); } } \
            const bool last = (t == nt - 2); \
            const char* a1 = cA + (size_t)(t + 1) * kstep; \
            const char* a2 = last ? nA : cA + (size_t)(t + 2) * kstep; const char* b2 = last ? nB : cB + (size_t)(t + 2) * kstep; \
            const char* a3 = a2 + kstep; const char* b3 = b2 + kstep; \
            PG8_LDB(B0, 0, 0); PG8_LDB(B1, 0, 1); PG8_SCHED; PG8_LDA(At, 0, 0); PG8_STA(PG8_SA(1, 1), a1, 1); \
            if constexpr (GATHER) { if (last && has_next) { const u32x4 na = *stash; curA[0][0] = na.x; curA[0][1] = na.y; curA[1][0] = na.z; curA[1][1] = na.w; } } \
            PG8_WAIT_V(8); PG8_WAIT_L(0); PG8_BAR; PG8_MMA(0, 0, At, B0); PG8_MMA(0, 1, At, B1); PG8_BAR; PG8_SCHED; \
            if (FULL) { PG8_LDA(At, 0, 1); } PG8_STAGE(PG8_SB(0, 0), b2, voffB); PG8_STAGE(PG8_SB(0, 1), b2 + hstep, voffB); PG8_STA(PG8_SA(0, 0), a2, 0); \
            PG8_WAIT_V(8); PG8_WAIT_L(0); PG8_BAR; if (FULL) { PG8_MMA(1, 0, At, B0); PG8_MMA(1, 1, At, B1); } PG8_BAR; PG8_SCHED; \
            PG8_LDB(B0, 1, 0); PG8_LDB(B1, 1, 1); PG8_SCHED; PG8_LDA(At, 1, 0); PG8_STA(PG8_SA(0, 1), a2, 1); \
            PG8_WAIT_V(8); PG8_WAIT_L(0); PG8_BAR; PG8_MMA(0, 0, At, B0); PG8_MMA(0, 1, At, B1); PG8_BAR; PG8_SCHED; \
            if (FULL) { PG8_LDA(At, 1, 1); } PG8_STAGE(PG8_SB(1, 0), b3, voffB); PG8_STAGE(PG8_SB(1, 1), b3 + hstep, voffB); PG8_STA(PG8_SA(1, 0), a3, 0); \
            PG8_WAIT_V(8); PG8_WAIT_L(0); PG8_BAR; if (FULL) { PG8_MMA(1, 0, At, B0); PG8_MMA(1, 1, At, B1); } PG8_BAR; PG8_SCHED; \
        }
        if constexpr (TAILS) { if (cur.half) { PG8_KLOOP(0) } else { PG8_KLOOP(1) } } else { PG8_KLOOP(1) }
#undef PG8_KLOOP
        if constexpr (ALIGN_EPI) { if (wr == 0) PG8_BAR; }
        { int fr_ = fr, fq_ = fq; asm volatile("" : "+v"(fr_), "+v"(fq_)); E(acc, cur, wr, wc, fr_, fq_); }
        if (!has_next) break;
#pragma unroll
        for (int a = 0; a < 2; ++a)
#pragma unroll
            for (int b = 0; b < 2; ++b)
#pragma unroll
                for (int m = 0; m < 4; ++m)
#pragma unroll
                    for (int n = 0; n < 2; ++n) acc[a][b][m][n] = (f32x4){0.f, 0.f, 0.f, 0.f};
        cur = nxt; cB = nB; cA = nA; ++ui;
        if constexpr (ALIGN_EPI) { if (wr == 1) PG8_BAR; }
    }
    PG8_WAIT_V(0);
    if constexpr (!ALIGN_EPI) { if (wr == 0) PG8_BAR; }
    PG8_BAR;
#undef PG8_SA
#undef PG8_SB
#undef PG8_STAGE
#undef PG8_LDA
#undef PG8_LD32
#undef PG8_LDB
#undef PG8_MMA
#undef PG8_CAT
#undef PG8_WAIT_V
#undef PG8_WAIT_L
#undef PG8_BAR
#undef PG8_SCHED
#undef PG8_AOFF
#undef PG8_STA
}

template <bool WT> __device__ __forceinline__ void st16(void* p, const u32x4 v) {
    if constexpr (WT) asm volatile("global_store_dwordx4 %0, %1, off sc1" :: "v"(p), "v"(v) : "memory");
    else *(u32x4*)p = v;
}
template <bool WT> __device__ __forceinline__ void st8(void* p, const u32x2 v) {
    if constexpr (WT) asm volatile("global_store_dwordx2 %0, %1, off sc1" :: "v"(p), "v"(v) : "memory");
    else *(u32x2*)p = v;
}
#ifndef EPI_WT
#define EPI_WT false
#endif
__device__ __forceinline__ u32x4 pack8(const f32x4 a, const f32x4 b) { u32x4 w; w.x = cvt_pk_bf16(a[0], a[1]); w.y = cvt_pk_bf16(a[2], a[3]); w.z = cvt_pk_bf16(b[0], b[1]); w.w = cvt_pk_bf16(b[2], b[3]); return w; }
struct EpiIn {
    static constexpr bool PERM = true; static constexpr bool LDSBIAS = false;
    bf16* proj; bf16* sg; float* la; float* ffl; const float* a_b; const float* fb;
    __device__ __forceinline__ void operator()(const f32x4 (&acc)[2][2][4][2], const Unit& u, int wr, int wc, int fr, int fq) const {
        const int pn = u.pn, rowb = u.pm * BM + wr * 64 + fr, cl0 = wc * 32 + 8 * fq;
        if (pn < 9) {
            bf16* base = proj + (size_t)pn * S * 256; const float sc = (pn == 0 || pn == 3) ? C2 : 1.f;
#pragma unroll
            for (int ai = 0; ai < 2; ++ai)
#pragma unroll
                for (int m = 0; m < 4; ++m) { bf16* rowp = base + (size_t)(rowb + ai * HALF + m * 16) * 256 + cl0;
#pragma unroll
                    for (int bj = 0; bj < 2; ++bj) st16<EPI_WT>(rowp + bj * HALF, pack8(acc[ai][bj][m][0] * sc, acc[ai][bj][m][1] * sc)); }
        } else {
#pragma unroll
            for (int n = 0; n < 2; ++n) { const f32x4 bv = *(const f32x4*)(a_b + cl0 + n * 4);
#pragma unroll
                for (int ai = 0; ai < 2; ++ai)
#pragma unroll
                    for (int m = 0; m < 4; ++m) { const f32x4 v = acc[ai][0][m][n] + bv; f32x4 o;
                        o[0] = logsigmoidf_(v[0]) * 0.0625f; o[1] = logsigmoidf_(v[1]) * 0.0625f; o[2] = logsigmoidf_(v[2]) * 0.0625f; o[3] = logsigmoidf_(v[3]) * 0.0625f;
                        *(f32x4*)(la + (size_t)(rowb + ai * HALF + m * 16) * 128 + cl0 + n * 4) = o; } }
            if (wc == 0 && fq == 0) { const f32x4 bv = *(const f32x4*)fb;
#pragma unroll
                for (int ai = 0; ai < 2; ++ai)
#pragma unroll
                    for (int m = 0; m < 4; ++m) { const f32x4 v = acc[ai][1][m][0] + bv; f32x4 o;
                        o[0] = logsigmoidf_(v[0]); o[1] = logsigmoidf_(v[1]); o[2] = logsigmoidf_(v[2]); o[3] = logsigmoidf_(v[3]);
                        const size_t r_ = (size_t)(rowb + ai * HALF + m * 16); ffl[r_] = o[0]; ffl[S + r_] = o[1]; ffl[2 * (size_t)S + r_] = o[2]; ffl[3 * (size_t)S + r_] = o[3]; } }
        }
    }
};
#define GQ(g_) fmaxf(256.f * (g_), 0.001953125f)
struct EpiGate {
    static constexpr int PERM = 3; static constexpr bool LDSBIAS = false;
    unsigned char* sg;
    __device__ __forceinline__ void operator()(const f32x4 (&acc)[2][2][4][2], const Unit& u, int wr, int wc, int fr, int fq) const {
        unsigned char* base = sg + (size_t)(u.pm * 12 + u.pn) * 65536 + (((wr * 4 + wc) * 64 + fq * 16 + fr) * 16);
        constexpr float KS = -0.03125f * LOG2E;
#pragma unroll
        for (int ai = 0; ai < 2; ++ai)
#pragma unroll
            for (int m = 0; m < 4; ++m) { u32x4 w;
#pragma unroll
                for (int bj = 0; bj < 2; ++bj) { const f32x4 v0 = acc[ai][bj][m][0], v1 = acc[ai][bj][m][1];
                    w[2 * bj]     = cvt4_fp8(GQ(fast_rcp(1.f + fast_exp2(v0[0] * KS))), GQ(fast_rcp(1.f + fast_exp2(v0[1] * KS))), GQ(fast_rcp(1.f + fast_exp2(v0[2] * KS))), GQ(fast_rcp(1.f + fast_exp2(v0[3] * KS))));
                    w[2 * bj + 1] = cvt4_fp8(GQ(fast_rcp(1.f + fast_exp2(v1[0] * KS))), GQ(fast_rcp(1.f + fast_exp2(v1[1] * KS))), GQ(fast_rcp(1.f + fast_exp2(v1[2] * KS))), GQ(fast_rcp(1.f + fast_exp2(v1[3] * KS)))); }
                *(u32x4*)(base + (ai * 4 + m) * 8192) = w; }
    }
};
#undef GQ
struct EpiLift {
    static constexpr int PERM = 3; static constexpr bool LDSBIAS = false;
    const unsigned char* sg; bf16* mrg;
    __device__ __forceinline__ void hook(f32x4 (&acc)[2][2][4][2], const Unit& u, int seg, int wr, int wc, int fr, int fq) const {
        const unsigned char* ta = sg + (size_t)(u.pm * 12 + (seg - 1) * 4 + u.pn) * 65536 + (((wr * 4 + wc) * 64 + fq * 16 + fr) * 16);
        u32x4 ga[2][2], gb[2][2];
#define LIFT_LOAD(buf, ai, mh) do { _Pragma("unroll") for (int mm = 0; mm < 2; ++mm) { const int i_ = (ai) * 4 + (mh) * 2 + mm; ga[buf][mm] = *(const u32x4*)(ta + i_ * 8192); gb[buf][mm] = *(const u32x4*)(ta + 4 * 65536 + i_ * 8192); } } while (0)
#define LIFT_PIN(buf) asm volatile("" : "+v"(ga[buf][0]), "+v"(ga[buf][1]), "+v"(gb[buf][0]), "+v"(gb[buf][1]))
#define LIFT_R4(aw, bw) ({ const f32x2 al_ = __builtin_amdgcn_cvt_pk_f32_fp8((int)(aw), false), ah_ = __builtin_amdgcn_cvt_pk_f32_fp8((int)(aw), true), bl_ = __builtin_amdgcn_cvt_pk_f32_fp8((int)(bw), false), bh_ = __builtin_amdgcn_cvt_pk_f32_fp8((int)(bw), true); \
            (f32x4){al_[0] * fast_rcp(bl_[0]), al_[1] * fast_rcp(bl_[1]), ah_[0] * fast_rcp(bh_[0]), ah_[1] * fast_rcp(bh_[1])}; })
#define LIFT_COMP(buf, ai, mh) do { _Pragma("unroll") for (int mm = 0; mm < 2; ++mm) { const u32x4 a = ga[buf][mm], b = gb[buf][mm]; const int m_ = (mh) * 2 + mm; \
            acc[ai][0][m_][0] *= LIFT_R4(a.x, b.x); acc[ai][0][m_][1] *= LIFT_R4(a.y, b.y); acc[ai][1][m_][0] *= LIFT_R4(a.z, b.z); acc[ai][1][m_][1] *= LIFT_R4(a.w, b.w); } } while (0)
        LIFT_LOAD(0, 0, 0); LIFT_LOAD(1, 0, 1);
        LIFT_PIN(0); LIFT_COMP(0, 0, 0); LIFT_LOAD(0, 1, 0);
        LIFT_PIN(1); LIFT_COMP(1, 0, 1); LIFT_LOAD(1, 1, 1);
        LIFT_PIN(0); LIFT_COMP(0, 1, 0);
        LIFT_PIN(1); LIFT_COMP(1, 1, 1);
#undef LIFT_LOAD
#undef LIFT_PIN
#undef LIFT_R4
#undef LIFT_COMP
    }
    __device__ __forceinline__ void operator()(const f32x4 (&acc)[2][2][4][2], const Unit& u, int wr, int wc, int fr, int fq) const {
        const int rowb = u.pm * BM + wr * 64 + fr, col0 = u.pn * BM + wc * 64 + 16 * fq;
        const unsigned char* tg = sg + (size_t)(u.pm * 12 + 8 + u.pn) * 65536 + (((wr * 4 + wc) * 64 + fq * 16 + fr) * 16);
        u32x4 gw[2][4];
#pragma unroll
        for (int ai = 0; ai < 2; ++ai)
#pragma unroll
            for (int m = 0; m < 4; ++m) gw[ai][m] = *(const u32x4*)(tg + (ai * 4 + m) * 8192);
#pragma unroll
        for (int ai = 0; ai < 2; ++ai) {
            asm volatile("" : "+v"(gw[ai][0]), "+v"(gw[ai][1]), "+v"(gw[ai][2]), "+v"(gw[ai][3]));
#pragma unroll
            for (int m = 0; m < 4; ++m) { const size_t row = (size_t)(rowb + ai * HALF + m * 16);
#pragma unroll
                for (int bj = 0; bj < 2; ++bj) { const unsigned gx = bj ? gw[ai][m].z : gw[ai][m].x, gy = bj ? gw[ai][m].w : gw[ai][m].y;
                    const f32x2 a0 = __builtin_amdgcn_cvt_pk_f32_fp8((int)gx, false), a1 = __builtin_amdgcn_cvt_pk_f32_fp8((int)gx, true), b0 = __builtin_amdgcn_cvt_pk_f32_fp8((int)gy, false), b1 = __builtin_amdgcn_cvt_pk_f32_fp8((int)gy, true);
                    const f32x4 v0 = acc[ai][bj][m][0] * ((f32x4){a0[0], a0[1], a1[0], a1[1]} * 0.00390625f), v1 = acc[ai][bj][m][1] * ((f32x4){b0[0], b0[1], b1[0], b1[1]} * 0.00390625f);
                    st16<EPI_WT>(mrg + row * 1024 + col0 + bj * 8, pack8(v0, v1)); } } }
    }
};
struct EpiF32 {
    static constexpr int PERM = 3; static constexpr bool LDSBIAS = false;
    bf16* C;
    __device__ __forceinline__ void operator()(const f32x4 (&acc)[2][2][4][2], const Unit& u, int wr, int wc, int fr, int fq) const {
        const int rowb = u.pm * BM + wr * 64 + fr, col0 = u.pn * BM + wc * 64 + 16 * fq;
#pragma unroll
        for (int ai = 0; ai < 2; ++ai)
#pragma unroll
            for (int m = 0; m < 4; ++m) { bf16* rowp = C + (size_t)(rowb + ai * HALF + m * 16) * 1024 + col0;
#pragma unroll
                for (int bj = 0; bj < 2; ++bj) st16<EPI_WT>(rowp + bj * 8, pack8(acc[ai][bj][m][0], acc[ai][bj][m][1])); }
    }
};
struct EpiMoe1 {
    static constexpr bool PERM = true; static constexpr bool LDSBIAS = true;
    unsigned char* act; const float* b_gu; const LAS float* bl;
    __device__ __forceinline__ const float* bsrc(const Unit& u) const { return b_gu + (size_t)u.e * 2048 + u.pn * 256; }
    __device__ __forceinline__ void operator()(const f32x4 (&acc)[2][2][4][2], const Unit& u, int wr, int wc, int fr, int fq) const {
        const int rowb = u.pm * BM + wr * 64 + fr, j0 = u.pn * HALF + wc * 32 + 8 * fq; const LAS float* bb = bl + u.par * 256 + 2 * (wc * 32 + 8 * fq);
        f32x4 bq[4];
#pragma unroll
        for (int q = 0; q < 4; ++q) bq[q] = *(const LAS f32x4*)(bb + 4 * q);
        f32x4 bg[2], bu[2];
#pragma unroll
        for (int n = 0; n < 2; ++n) { bg[n] = (f32x4){bq[2 * n][0], bq[2 * n][2], bq[2 * n + 1][0], bq[2 * n + 1][2]}; bu[n] = (f32x4){bq[2 * n][1], bq[2 * n][3], bq[2 * n + 1][1], bq[2 * n + 1][3]}; }
#pragma unroll
        for (int ai = 0; ai < 2; ++ai) { if (ai == 1 && u.half) break;
#pragma unroll
            for (int m = 0; m < 4; ++m) { u32x2 w;
#pragma unroll
                for (int n = 0; n < 2; ++n) { const f32x4 hg = acc[ai][0][m][n] * 0.03125f + bg[n], hu = acc[ai][1][m][n] * 0.03125f + bu[n]; float o[4];
#pragma unroll
                    for (int i = 0; i < 4; ++i) { const float g = fminf(hg[i], 7.f), uu = fminf(fmaxf(hu[i], -7.f), 7.f); o[i] = (uu + 1.f) * (g * fast_rcp(1.f + fast_exp2(g * (-1.702f * LOG2E)))); }
                    w[n] = cvt4_fp8(o[0], o[1], o[2], o[3]); }
                st8<false>(act + (size_t)(rowb + ai * HALF + m * 16) * 1024 + j0, w); } }
    }
};
struct EpiMoe2 {
    static constexpr int PERM = 3; static constexpr bool LDSBIAS = true;
    bf16* yb; const float* b_dn; const LAS float* bl;
    __device__ __forceinline__ const float* bsrc(const Unit& u) const { return b_dn + (size_t)u.e * 1024 + u.pn * 256; }
    __device__ __forceinline__ void operator()(const f32x4 (&acc)[2][2][4][2], const Unit& u, int wr, int wc, int fr, int fq) const {
        const int rowb = u.pm * BM + wr * 64 + fr, col0 = u.pn * BM + wc * 64 + 16 * fq; const LAS float* bb = bl + u.par * 256 + wc * 64 + 16 * fq;
        f32x4 bva[2][2];
#pragma unroll
        for (int bj = 0; bj < 2; ++bj)
#pragma unroll
            for (int n = 0; n < 2; ++n) bva[bj][n] = *(const LAS f32x4*)(bb + bj * 8 + n * 4) * 16.f;
#define CL8(x_) __builtin_amdgcn_fmed3f((x_), -448.f, 448.f)
#pragma unroll
        for (int ai = 0; ai < 2; ++ai) { if (ai == 1 && u.half) break;
#pragma unroll
            for (int m = 0; m < 4; ++m) { u32x4 w;
#pragma unroll
                for (int bj = 0; bj < 2; ++bj)
#pragma unroll
                    for (int n = 0; n < 2; ++n) { const f32x4 y = acc[ai][bj][m][n] * 0.25f + bva[bj][n]; w[2 * bj + n] = cvt4_fp8(CL8(y[0]), CL8(y[1]), CL8(y[2]), CL8(y[3])); }
                *(u32x4*)((unsigned char*)yb + (size_t)(rowb + ai * HALF + m * 16) * 1024 + col0) = w; } }
#undef CL8
    }
};
}

#define XB_TMO      128
#define XB_XCNT(j)  (256  + 64 * (j))
#define XB_XSUB(j)  (1280 + 64 * (j))
#define XB_XGEN(j)  (2304 + 64 * (j))
#define XB_TOP      3328
#define XB_TOPGEN   3392
#define XCD_BAR_WORDS 3456
#define XB_SPIN_CAP (1u << 22)
__device__ __forceinline__ unsigned xb_ld(unsigned* p)              { return __hip_atomic_load(p, __ATOMIC_RELAXED, __HIP_MEMORY_SCOPE_AGENT); }
__device__ __forceinline__ unsigned xb_add(unsigned* p, unsigned v) { return __hip_atomic_fetch_add(p, v, __ATOMIC_RELAXED, __HIP_MEMORY_SCOPE_AGENT); }
__device__ __forceinline__ unsigned xb_xcc_id() { return (unsigned)__builtin_amdgcn_s_getreg((3 << 11) | 20) & 0xFu; }
#define XB_SPIN(cond, bar) do { unsigned _sp = 0; while (cond) { __builtin_amdgcn_s_sleep(1); \
    if ((++_sp & 255u) == 0u) { if (xb_ld(&(bar)[XB_TMO])) break; if (_sp > XB_SPIN_CAP) { atomicAdd(&(bar)[XB_TMO], 1u); break; } } } } while (0)
struct XcdBarrier { unsigned* bar; unsigned x; volatile LAS unsigned* st; };
__device__ __forceinline__ XcdBarrier xcd_barrier_post(unsigned* bar, volatile LAS unsigned* st, const bool t0) {
    XcdBarrier b; b.bar = bar; b.x = xb_xcc_id(); b.st = st;
    if (t0) (void)xb_add(&bar[XB_XCNT(b.x)], 1u);
    return b;
}
__device__ __forceinline__ void xcd_barrier_complete(unsigned* bar, unsigned x, unsigned& nloc, unsigned& nx) {
    const unsigned G = gridDim.x * gridDim.y * gridDim.z;
    unsigned sum, cnt, mine, sp = 0u;
    for (;;) {
        sum = 0u; cnt = 0u; mine = 0u;
#pragma unroll
        for (unsigned j = 0; j < 16; ++j) { const unsigned c = xb_ld(&bar[XB_XCNT(j)]); sum += c; cnt += (c > 0u) ? 1u : 0u; mine = (j == x) ? c : mine; }
        if (sum == G) break;
        __builtin_amdgcn_s_sleep(1);
        if ((++sp & 255u) == 0u) { if (xb_ld(&bar[XB_TMO])) break; if (sp > XB_SPIN_CAP) { atomicAdd(&bar[XB_TMO], 1u); break; } }
    }
    nloc = mine > 0u ? mine : 1u; nx = cnt > 0u ? cnt : 1u;
}
__device__ __forceinline__ void xcd_barrier(const XcdBarrier& b, const bool t0) {
    asm volatile("s_waitcnt vmcnt(0)" ::: "memory");
    __syncthreads();
    if (t0) {
        unsigned* bar = b.bar;
        __builtin_amdgcn_s_waitcnt(0);
        unsigned nloc = b.st[0], nx = b.st[1];
        if (nloc == 0u) { xcd_barrier_complete(bar, b.x, nloc, nx); b.st[0] = nloc; b.st[1] = nx; }
        const unsigned old = xb_add(&bar[XB_XSUB(b.x)], 1u);
        const unsigned gen = old / nloc;
        if (old + 1u == (gen + 1u) * nloc) {
            __builtin_amdgcn_fence(__ATOMIC_RELEASE, "agent");
            asm volatile("s_waitcnt vmcnt(0)" ::: "memory");
            const unsigned og = xb_add(&bar[XB_TOP], 1u);
            const unsigned tg = og / nx;
            if (og + 1u == (tg + 1u) * nx) xb_add(&bar[XB_TOPGEN], 1u);
            else XB_SPIN(xb_ld(&bar[XB_TOPGEN]) == tg, bar);
            __builtin_amdgcn_fence(__ATOMIC_ACQUIRE, "agent");
            xb_add(&bar[XB_XGEN(b.x)], 1u);
            asm volatile("s_waitcnt vmcnt(0)" ::: "memory");
        } else {
            XB_SPIN(xb_ld(&bar[XB_XGEN(b.x)]) == gen, bar);
            __builtin_amdgcn_fence(__ATOMIC_ACQUIRE, "agent");
            asm volatile("s_waitcnt vmcnt(0)" ::: "memory");
        }
    }
    __syncthreads();
}

struct MapGate { __device__ __forceinline__ int operator()(int c) const { return c >= 2324 ? c - 2324 : -1; } };
struct MapIdent { __device__ __forceinline__ int operator()(int c) const { return c; } };
struct MapGU { __device__ __forceinline__ int operator()(int c) const { const int j = c >> 1, up = c & 1; return ((j >> 7) << 8) + (up << 7) + (j & 127); } };
struct MapIn { __device__ __forceinline__ int operator()(int c) const {
    if (c < 768) return c;
    if (c < 772) return 2432 + (c - 768);
    if (c < 1028) return 1536 + (c - 772);
    if (c < 1284) return 1792 + (c - 1028);
    if (c < 1300) return -1;
    if (c < 1556) return 2048 + (c - 1300);
    if (c < 2324) return 768 + (c - 1556);
    return -1;
} };
template <class RowMap>
__device__ __forceinline__ void transpose_item_fp8(const float* W, int K, int N, unsigned char* WT, LAS float* scr, int item, int lane, RowMap rm, float sc) {
    const int nblk = (N + 31) / 32, kb = item / nblk, nb = item % nblk, k0 = 64 * kb, n0 = 32 * nb;
    const int nn = n0 + (lane & 31);
#pragma unroll 32
    for (int i = 0; i < 32; ++i) { const int kk = 2 * i + (lane >> 5); scr[kk * 33 + (lane & 31)] = nn < N ? W[(size_t)(k0 + kk) * N + nn] : 0.f; }
    asm volatile("s_waitcnt lgkmcnt(0)" ::: "memory");
    const int c = lane & 7;
#pragma unroll
    for (int j = 0; j < 4; ++j) { const int n = (lane >> 3) + 8 * j; const LAS float* s = scr + (8 * c) * 33 + n;
        const int row = (n0 + n < N) ? rm(n0 + n) : -1;
        if (row >= 0) { u32x2 o; o.x = cvt4_fp8(s[0 * 33] * sc, s[1 * 33] * sc, s[2 * 33] * sc, s[3 * 33] * sc); o.y = cvt4_fp8(s[4 * 33] * sc, s[5 * 33] * sc, s[6 * 33] * sc, s[7 * 33] * sc);
            *(u32x2*)(WT + (size_t)row * K + k0 + 8 * c) = o; } }
    asm volatile("s_waitcnt lgkmcnt(0)" ::: "memory");
}
template <class RowMap>
__device__ __forceinline__ void convert_item_fp8(const float* W, int K, int N, unsigned char* WT, int item, int lane, RowMap rm, float sc) {
    const int nblk = N / 64, kb = item / nblk, nb = item % nblk, k0 = 128 * kb, n0 = 64 * nb;
    const float* src = W + (size_t)k0 * N + n0 + lane;
    float v[128];
#pragma unroll
    for (int i = 0; i < 128; ++i) v[i] = src[(size_t)i * N];
#pragma unroll
    for (int g = 0; g < 8; ++g)
        asm volatile("" : "+v"(v[g * 16 + 0]), "+v"(v[g * 16 + 1]), "+v"(v[g * 16 + 2]), "+v"(v[g * 16 + 3]), "+v"(v[g * 16 + 4]), "+v"(v[g * 16 + 5]), "+v"(v[g * 16 + 6]), "+v"(v[g * 16 + 7]),
                          "+v"(v[g * 16 + 8]), "+v"(v[g * 16 + 9]), "+v"(v[g * 16 + 10]), "+v"(v[g * 16 + 11]), "+v"(v[g * 16 + 12]), "+v"(v[g * 16 + 13]), "+v"(v[g * 16 + 14]), "+v"(v[g * 16 + 15]));
    unsigned char* dst = WT + (size_t)rm(n0 + lane) * K + k0;
#pragma unroll
    for (int q = 0; q < 8; ++q) { u32x4 o;
        o.x = cvt4_fp8(v[q * 16 + 0] * sc, v[q * 16 + 1] * sc, v[q * 16 + 2] * sc, v[q * 16 + 3] * sc); o.y = cvt4_fp8(v[q * 16 + 4] * sc, v[q * 16 + 5] * sc, v[q * 16 + 6] * sc, v[q * 16 + 7] * sc);
        o.z = cvt4_fp8(v[q * 16 + 8] * sc, v[q * 16 + 9] * sc, v[q * 16 + 10] * sc, v[q * 16 + 11] * sc); o.w = cvt4_fp8(v[q * 16 + 12] * sc, v[q * 16 + 13] * sc, v[q * 16 + 14] * sc, v[q * 16 + 15] * sc);
        *(u32x4*)(dst + q * 16) = o; }
}
template <class RowMap>
__device__ __forceinline__ void transpose_item(const float* W, int K, int N, bf16* WT, LAS float* scr, int item, int lane, RowMap rm, int ldk = 0) {
    if (ldk == 0) ldk = K;
    const int nblk = (N + 31) / 32, kb = item / nblk, nb = item % nblk, k0 = 64 * kb, n0 = 32 * nb;
    const int nn = n0 + (lane & 31);
#pragma unroll 32
    for (int i = 0; i < 32; ++i) { const int kk = 2 * i + (lane >> 5); scr[kk * 33 + (lane & 31)] = nn < N ? W[(size_t)(k0 + kk) * N + nn] : 0.f; }
    asm volatile("s_waitcnt lgkmcnt(0)" ::: "memory");
    const int c = lane & 7;
#pragma unroll
    for (int j = 0; j < 4; ++j) { const int n = (lane >> 3) + 8 * j; const LAS float* s = scr + (8 * c) * 33 + n;
        const int row = (n0 + n < N) ? rm(n0 + n) : -1;
        if (row >= 0) { u32x4 o; o.x = cvt_pk_bf16(s[0 * 33], s[1 * 33]); o.y = cvt_pk_bf16(s[2 * 33], s[3 * 33]); o.z = cvt_pk_bf16(s[4 * 33], s[5 * 33]); o.w = cvt_pk_bf16(s[6 * 33], s[7 * 33]);
            *(u32x4*)(WT + (size_t)row * ldk + k0 + 8 * c) = o; } }
    asm volatile("s_waitcnt lgkmcnt(0)" ::: "memory");
}

__device__ __forceinline__ void transpose_item_win(const float* W, bf16* WT, unsigned char* WT8, LAS float* scr, int item, int lane) {
    const int K = 1024, N = D_IN; const int nblk = (N + 31) / 32, kb = item / nblk, nb = item % nblk, k0 = 64 * kb, n0 = 32 * nb;
    const int nn = n0 + (lane & 31);
#pragma unroll 32
    for (int i = 0; i < 32; ++i) { const int kk = 2 * i + (lane >> 5); scr[kk * 33 + (lane & 31)] = nn < N ? W[(size_t)(k0 + kk) * N + nn] : 0.f; }
    asm volatile("s_waitcnt lgkmcnt(0)" ::: "memory");
    const int c = lane & 7;
#pragma unroll
    for (int j = 0; j < 4; ++j) { const int n = (lane >> 3) + 8 * j; const LAS float* s = scr + (8 * c) * 33 + n;
        const int row = (n0 + n < N) ? MapIn()(n0 + n) : -1, row8 = (n0 + n < N) ? MapGate()(n0 + n) : -1;
        if (row >= 0) { u32x4 o; o.x = cvt_pk_bf16(s[0 * 33], s[1 * 33]); o.y = cvt_pk_bf16(s[2 * 33], s[3 * 33]); o.z = cvt_pk_bf16(s[4 * 33], s[5 * 33]); o.w = cvt_pk_bf16(s[6 * 33], s[7 * 33]);
            *(u32x4*)(WT + (size_t)row * K + k0 + 8 * c) = o; }
        if (row8 >= 0) { u32x2 o; o.x = cvt4_fp8(s[0 * 33] * 32.f, s[1 * 33] * 32.f, s[2 * 33] * 32.f, s[3 * 33] * 32.f); o.y = cvt4_fp8(s[4 * 33] * 32.f, s[5 * 33] * 32.f, s[6 * 33] * 32.f, s[7 * 33] * 32.f);
            *(u32x2*)(WT8 + (size_t)row8 * K + k0 + 8 * c) = o; } }
    asm volatile("s_waitcnt lgkmcnt(0)" ::: "memory");
}

struct Args { const float* in[18]; float* out; unsigned char* ws; int ph_lo, ph_hi; };

#define CAS __attribute__((address_space(4)))
#define KARG_IN(kp, i) (*(const float* const CAS*)((kp) + 8 * (i)))
#define KARG_OUT(kp) (*(float* const CAS*)((kp) + 144))
#define KARG_WS(kp) (*(unsigned char* const CAS*)((kp) + 152))
__device__ __forceinline__ void p0_prologue(const CAS unsigned char* kp, LAS unsigned char* lds, int vcu, int G, int tid) {
    const int lane = tid & 63, wave = tid >> 6;
    LAS float* scr = (LAS float*)(lds + wave * 16384);
    unsigned char* ws = KARG_WS(kp);
    const int gw = vcu * 8 + wave, NGW = G * 8;
    constexpr int I_IN = 16 * 169, I_BR = 4 * 32, I_OUT = 16 * 32, I_GU = 8 * 32, I_DN = 8 * 16;
    constexpr int PER_L = I_IN + 3 * I_BR + I_OUT + 32 * I_GU + 32 * I_DN;
    for (int it = gw; it < DEPTH * PER_L; it += NGW) {
        const int l = it / PER_L; int r = it % PER_L;
        if (r < I_IN) { transpose_item_win(KARG_IN(kp, 1) + (size_t)l * 1024 * D_IN, (bf16*)(ws + WS_WIN) + (size_t)l * NIN * 1024, (unsigned char*)(ws + WS_WIN8) + (size_t)l * 3072 * 1024, scr, r, lane); continue; } r -= I_IN;
        if (r < 3 * I_BR) { const int nb = r / I_BR; transpose_item(KARG_IN(kp, 6) + ((size_t)l * 3 + nb) * 256 * 1024, 256, 1024, (bf16*)(ws + WS_WBR) + (size_t)l * 1024 * 768 + nb * 256, scr, r % I_BR, lane, MapIdent(), 768); continue; } r -= 3 * I_BR;
        if (r < I_OUT) { transpose_item(KARG_IN(kp, 7) + (size_t)l * 1024 * 1024, 1024, 1024, (bf16*)(ws + WS_WOUT) + (size_t)l * 1024 * 1024, scr, r, lane, MapIdent()); continue; } r -= I_OUT;
        if (r < 32 * I_GU) { const int e = r / I_GU; convert_item_fp8(KARG_IN(kp, 12) + ((size_t)l * 32 + e) * 1024 * 2048, 1024, 2048, (unsigned char*)(ws + WS_WGU) + ((size_t)l * 32 + e) * 2048 * 1024, r % I_GU, lane, MapGU(), 32.f); continue; } r -= 32 * I_GU;
        { const int e = r / I_DN; convert_item_fp8(KARG_IN(kp, 14) + ((size_t)l * 32 + e) * 1024 * 1024, 1024, 1024, (unsigned char*)(ws + WS_WDN) + ((size_t)l * 32 + e) * 1024 * 1024, r % I_DN, lane, MapIdent(), 64.f); }
    }
    const int gt = vcu * 512 + tid, NT = G * 512;
    for (int i = gt; i < DEPTH * 128 * 1024; i += NT) { const int l = i >> 17, j = (i >> 10) & 127, k = i & 1023;
        const float* wr_ = KARG_IN(kp, 1) + ((size_t)l * 1024 + k) * D_IN + 1284; const float* au = KARG_IN(kp, 3) + (size_t)l * 16 * 128 + j; float s = 0.f;
#pragma unroll
        for (int r = 0; r < 16; ++r) s += wr_[r] * au[r * 128];
        ((bf16*)(ws + WS_WIN))[((size_t)l * NIN + 2304 + j) * 1024 + k] = (bf16)(cvt_pk_bf16(s, 0.f) & 0xffffu); }
    for (int i = gt; i < DEPTH * 124 * 1024 / 8; i += NT) { const int l = i / (124 * 128), rr = i % (124 * 128);
        *(u32x4*)((bf16*)(ws + WS_WIN) + ((size_t)l * NIN + 2436) * 1024 + (size_t)rr * 8) = (u32x4){0u, 0u, 0u, 0u}; }
    for (int i = gt; i < DEPTH * 32 * 1024; i += NT) { const int l = i >> 15, e = (i >> 10) & 31, k = i & 1023; const float w = KARG_IN(kp, 10)[((size_t)l * 1024 + k) * 32 + e];
        const unsigned hb = cvt_pk_bf16(w, 0.f) & 0xffffu; const float rem = w - __uint_as_float(hb << 16); const unsigned lb = cvt_pk_bf16(rem, 0.f) & 0xffffu;
        bf16* wt = (bf16*)(ws + WS_WRT) + (size_t)l * 65536; wt[e * 1024 + k] = (bf16)hb; wt[32768 + e * 1024 + k] = (bf16)lb; }
    for (int i = gt; i < S * D / 8; i += NT) { const f32x4 v0 = *(const f32x4*)(KARG_IN(kp, 0) + (size_t)i * 8), v1 = *(const f32x4*)(KARG_IN(kp, 0) + (size_t)i * 8 + 4);
        u32x4 o; o.x = cvt_pk_bf16(v0[0], v0[1]); o.y = cvt_pk_bf16(v0[2], v0[3]); o.z = cvt_pk_bf16(v1[0], v1[1]); o.w = cvt_pk_bf16(v1[2], v1[3]);
        *(u32x4*)((bf16*)(ws + WS_XB) + (size_t)i * 8) = o;
        u32x2 o8; o8.x = cvt4_fp8(v0[0], v0[1], v0[2], v0[3]); o8.y = cvt4_fp8(v1[0], v1[1], v1[2], v1[3]); *(u32x2*)((unsigned char*)(ws + WS_XB8) + (size_t)i * 8) = o8; }
}

__device__ __forceinline__ void gla_cumsum(LAS float* bb, LAS float* scn, int tid) {
    const int k = tid & 31, seg = (tid >> 5) & 7; float loc[8]; float run = 0.f;
    if (tid < 256) {
#pragma unroll
        for (int i = 0; i < 8; ++i) { run += bb[(seg * 8 + i) * 32 + k]; loc[i] = run; }
        scn[seg * 32 + k] = run; }
    __syncthreads();
    if (tid < 256) { float pre = 0.f;
#pragma unroll
        for (int s2 = 0; s2 < 7; ++s2) pre += (s2 < seg) ? scn[s2 * 32 + k] : 0.f;
#pragma unroll
        for (int i = 0; i < 8; ++i) bb[(seg * 8 + i) * 32 + k] = loc[i] + pre; }
    __syncthreads();
}
__device__ __forceinline__ void gla_local_unit(LAS unsigned char* lds, int tid, int ci, int h, const bf16* GQK, const bf16* GV, const float* LAp, float* U, float* DEC) {
    LAS float* kb = (LAS float*)lds;
    LAS float* vb = kb + 64 * 33;
    LAS float* bb = vb + 64 * 64;
    LAS float* scn = bb + 64 * 32;
    const int t0 = ci * 64; const int r = tid >> 3;
    { const int c4 = (tid & 7) * 4; const u32x2 w = *(const u32x2*)(GQK + (size_t)(t0 + r) * 256 + 128 + h * 32 + c4);
      kb[r * 33 + c4 + 0] = bf_lo(w.x); kb[r * 33 + c4 + 1] = bf_hi(w.x); kb[r * 33 + c4 + 2] = bf_lo(w.y); kb[r * 33 + c4 + 3] = bf_hi(w.y);
      const f32x4 a = *(const f32x4*)(LAp + (size_t)(t0 + r) * 128 + h * 32 + c4); *(LAS f32x4*)(bb + r * 32 + c4) = a; }
    { const int c8 = (tid & 7) * 8; const u32x4 w = *(const u32x4*)(GV + (size_t)(t0 + r) * 256 + h * 64 + c8);
      *(LAS f32x4*)(vb + r * 64 + c8) = (f32x4){bf_lo(w.x), bf_hi(w.x), bf_lo(w.y), bf_hi(w.y)}; *(LAS f32x4*)(vb + r * 64 + c8 + 4) = (f32x4){bf_lo(w.z), bf_hi(w.z), bf_lo(w.w), bf_hi(w.w)}; }
    __syncthreads();
    gla_cumsum(bb, scn, tid);
    for (int idx = tid; idx < 2048; idx += 512) { const int c = idx >> 5, k = idx & 31; kb[c * 33 + k] *= __expf(bb[63 * 32 + k] - bb[c * 32 + k]); }
    __syncthreads();
    { const int k = tid >> 4, v0 = (tid & 15) * 4; f32x4 acc = (f32x4){0.f, 0.f, 0.f, 0.f};
#pragma unroll 8
      for (int c = 0; c < 64; ++c) { const float kk = kb[c * 33 + k]; const f32x4 vv = *(const LAS f32x4*)(vb + c * 64 + v0); acc += vv * kk; }
      *(f32x4*)(U + ((size_t)(ci * 4 + h) * 32 + k) * 64 + v0) = acc; }
    if (tid < 32) DEC[(ci * 4 + h) * 32 + tid] = __expf(bb[63 * 32 + tid]);
    __syncthreads();
}
__device__ __forceinline__ void gla_out_unit(LAS unsigned char* lds, int tid, int ci, int h, const bf16* GQK, const bf16* GV, const bf16* GR, const float* LAp, const float* SST, const float* ng, bf16* Y) {
    LAS float* qb = (LAS float*)lds;
    LAS float* kb = qb + 64 * 33;
    LAS float* vb = kb + 64 * 33;
    LAS float* bb = vb + 64 * 64;
    LAS float* Ab = bb + 64 * 32;
    LAS float* Sb = Ab + 64 * 65;
    LAS float* scn = Sb + 32 * 64;
    const int t0 = ci * 64; const int r = tid >> 3;
    { const int c4 = (tid & 7) * 4; const u32x2 wq = *(const u32x2*)(GQK + (size_t)(t0 + r) * 256 + h * 32 + c4); const u32x2 wk = *(const u32x2*)(GQK + (size_t)(t0 + r) * 256 + 128 + h * 32 + c4);
      qb[r * 33 + c4 + 0] = bf_lo(wq.x); qb[r * 33 + c4 + 1] = bf_hi(wq.x); qb[r * 33 + c4 + 2] = bf_lo(wq.y); qb[r * 33 + c4 + 3] = bf_hi(wq.y);
      kb[r * 33 + c4 + 0] = bf_lo(wk.x); kb[r * 33 + c4 + 1] = bf_hi(wk.x); kb[r * 33 + c4 + 2] = bf_lo(wk.y); kb[r * 33 + c4 + 3] = bf_hi(wk.y);
      const f32x4 a = *(const f32x4*)(LAp + (size_t)(t0 + r) * 128 + h * 32 + c4); *(LAS f32x4*)(bb + r * 32 + c4) = a; }
    { const int c8 = (tid & 7) * 8; const u32x4 w = *(const u32x4*)(GV + (size_t)(t0 + r) * 256 + h * 64 + c8);
      *(LAS f32x4*)(vb + r * 64 + c8) = (f32x4){bf_lo(w.x), bf_hi(w.x), bf_lo(w.y), bf_hi(w.y)}; *(LAS f32x4*)(vb + r * 64 + c8 + 4) = (f32x4){bf_lo(w.z), bf_hi(w.z), bf_lo(w.w), bf_hi(w.w)}; }
    { const f32x4 s4 = *(const f32x4*)(SST + (size_t)(ci * 4 + h) * 2048 + tid * 4); *(LAS f32x4*)(Sb + tid * 4) = s4; }
    __syncthreads();
    gla_cumsum(bb, scn, tid);
    for (int idx = tid; idx < 2048; idx += 512) { const int c = idx >> 5, k = idx & 31; const float b = bb[c * 32 + k];
        qb[c * 33 + k] *= 0.17677669529663687f * __expf(b); kb[c * 33 + k] *= __expf(-b); }
    __syncthreads();
    { const int t = tid >> 3, s0 = (tid & 7) * 8; float a[8];
#pragma unroll
      for (int i = 0; i < 8; ++i) a[i] = 0.f;
      for (int k = 0; k < 32; ++k) { const float qv = qb[t * 33 + k];
#pragma unroll
          for (int i = 0; i < 8; ++i) a[i] += qv * kb[(s0 + i) * 33 + k]; }
#pragma unroll
      for (int i = 0; i < 8; ++i) Ab[t * 65 + s0 + i] = (s0 + i <= t) ? a[i] : 0.f; }
    __syncthreads();
    { const int t = tid >> 3, v0 = (tid & 7) * 8; f32x4 o0 = (f32x4){0.f, 0.f, 0.f, 0.f}, o1 = o0;
      for (int s = 0; s < 64; ++s) { const float av = Ab[t * 65 + s]; o0 += *(const LAS f32x4*)(vb + s * 64 + v0) * av; o1 += *(const LAS f32x4*)(vb + s * 64 + v0 + 4) * av; }
      for (int k = 0; k < 32; ++k) { const float qv = qb[t * 33 + k]; o0 += *(const LAS f32x4*)(Sb + k * 64 + v0) * qv; o1 += *(const LAS f32x4*)(Sb + k * 64 + v0 + 4) * qv; }
      float ss = o0[0] * o0[0] + o0[1] * o0[1] + o0[2] * o0[2] + o0[3] * o0[3] + o1[0] * o1[0] + o1[1] * o1[1] + o1[2] * o1[2] + o1[3] * o1[3];
      ss += shx(ss, 1); ss += shx(ss, 2); ss += shx(ss, 4);
      const float rinv = 1.0f / sqrtf(ss * (1.f / 64.f) + RMS_EPS);
      const size_t tok = (size_t)(t0 + t); const u32x4 gw = *(const u32x4*)(GR + tok * 256 + h * 64 + v0);
      const f32x4 g0 = *(const f32x4*)(ng + h * 64 + v0), g1 = *(const f32x4*)(ng + h * 64 + v0 + 4);
      float gr[8] = {bf_lo(gw.x), bf_hi(gw.x), bf_lo(gw.y), bf_hi(gw.y), bf_lo(gw.z), bf_hi(gw.z), bf_lo(gw.w), bf_hi(gw.w)}; float y[8];
#pragma unroll
      for (int i = 0; i < 4; ++i) { y[i] = o0[i] * rinv * g0[i] * (gr[i] * sigmoidf_(gr[i])); y[4 + i] = o1[i] * rinv * g1[i] * (gr[4 + i] * sigmoidf_(gr[4 + i])); }
      u32x4 w; w.x = cvt_pk_bf16(y[0], y[1]); w.y = cvt_pk_bf16(y[2], y[3]); w.z = cvt_pk_bf16(y[4], y[5]); w.w = cvt_pk_bf16(y[6], y[7]);
      *(u32x4*)(Y + tok * 768 + h * 64 + v0) = w; }
    __syncthreads();
}


typedef float f32x16g __attribute__((ext_vector_type(16)));
__device__ __forceinline__ bf16x8 pack8(const float* x) { u32x4 w; w.x = cvt_pk_bf16(x[0], x[1]); w.y = cvt_pk_bf16(x[2], x[3]); w.z = cvt_pk_bf16(x[4], x[5]); w.w = cvt_pk_bf16(x[6], x[7]); return __builtin_bit_cast(bf16x8, w); }
__device__ __forceinline__ void gla_wave_cumsum(const float* LAp, size_t tok, int h, int lane, float (&b)[32]) {
#pragma unroll
    for (int j = 0; j < 8; ++j) { const f32x4 a = *(const f32x4*)(LAp + tok * 128 + h * 32 + j * 4); b[j * 4] = a[0]; b[j * 4 + 1] = a[1]; b[j * 4 + 2] = a[2]; b[j * 4 + 3] = a[3]; }
#pragma unroll
    for (int o = 1; o < 64; o <<= 1) {
#pragma unroll
        for (int k = 0; k < 32; ++k) { const float y = shu(b[k], o); b[k] += (lane >= o) ? y : 0.f; } }
}
__device__ __forceinline__ void load32bf(const bf16* p, float (&x)[32]) {
#pragma unroll
    for (int j = 0; j < 4; ++j) { const u32x4 w = *(const u32x4*)(p + j * 8); x[j * 8] = bf_lo(w.x); x[j * 8 + 1] = bf_hi(w.x); x[j * 8 + 2] = bf_lo(w.y); x[j * 8 + 3] = bf_hi(w.y); x[j * 8 + 4] = bf_lo(w.z); x[j * 8 + 5] = bf_hi(w.z); x[j * 8 + 6] = bf_lo(w.w); x[j * 8 + 7] = bf_hi(w.w); }
}
__device__ __forceinline__ void gla_stage_vt(LAS unsigned char* wl, const bf16* GV, size_t tok, int h, int lane) {
    u32x4 w[8];
#pragma unroll
    for (int j = 0; j < 8; ++j) w[j] = *(const u32x4*)(GV + tok * 256 + h * 64 + j * 8);
    asm volatile("" : "+v"(w[0]), "+v"(w[1]), "+v"(w[2]), "+v"(w[3]), "+v"(w[4]), "+v"(w[5]), "+v"(w[6]), "+v"(w[7]));
#pragma unroll
    for (int j = 0; j < 8; ++j) { const unsigned ww[4] = {w[j].x, w[j].y, w[j].z, w[j].w};
#pragma unroll
        for (int e = 0; e < 4; ++e) { *(LAS bf16*)(wl + 8192 + (j * 8 + 2 * e) * 128 + lane * 2) = (bf16)(ww[e] & 0xffffu); *(LAS bf16*)(wl + 8192 + (j * 8 + 2 * e + 1) * 128 + lane * 2) = (bf16)(ww[e] >> 16); } }
}
__device__ __forceinline__ void gla_local_wave(LAS unsigned char* wl, int lane, int ci, int h, const bf16* GQK, const bf16* GV, const float* LAp, float* U, float* DEC) {
    const size_t tok = (size_t)ci * 64 + lane; const int r32 = lane & 31, hi = lane >> 5;
    float b[32]; gla_wave_cumsum(LAp, tok, h, lane, b);
    float kx[32]; load32bf(GQK + tok * 256 + 128 + h * 32, kx);
    float myl = 0.f;
#pragma unroll
    for (int k = 0; k < 32; ++k) { const float bl = __uint_as_float((unsigned)__builtin_amdgcn_readlane((int)__float_as_uint(b[k]), 63)); kx[k] *= __expf(bl - b[k]); myl = (lane == k) ? bl : myl;
        *(LAS bf16*)(wl + k * 128 + lane * 2) = (bf16)(cvt_pk_bf16(kx[k], 0.f) & 0xffffu); }
    if (lane < 32) DEC[(ci * 4 + h) * 32 + lane] = __expf(myl);
    gla_stage_vt(wl, GV, tok, h, lane);
    asm volatile("s_waitcnt lgkmcnt(0)" ::: "memory");
    f32x16g u0 = {}, u1 = {};
#pragma unroll
    for (int st = 0; st < 4; ++st) { const bf16x8 ka = *(const LAS bf16x8*)(wl + r32 * 128 + (8 * hi + 16 * st) * 2);
        const bf16x8 v0 = *(const LAS bf16x8*)(wl + 8192 + r32 * 128 + (8 * hi + 16 * st) * 2), v1 = *(const LAS bf16x8*)(wl + 8192 + (r32 + 32) * 128 + (8 * hi + 16 * st) * 2);
        u0 = __builtin_amdgcn_mfma_f32_32x32x16_bf16(ka, v0, u0, 0, 0, 0); u1 = __builtin_amdgcn_mfma_f32_32x32x16_bf16(ka, v1, u1, 0, 0, 0); }
    float* up = U + (size_t)(ci * 4 + h) * 2048;
#pragma unroll
    for (int r = 0; r < 16; ++r) { const int k = (r & 3) + 8 * (r >> 2) + 4 * hi; up[k * 64 + r32] = u0[r]; up[k * 64 + 32 + r32] = u1[r]; }
    asm volatile("s_waitcnt lgkmcnt(0)" ::: "memory");
}
__device__ __forceinline__ void gla_out_wave(LAS unsigned char* wl, int lane, int ci, int h, const bf16* GQK, const bf16* GV, const bf16* GR, const float* LAp, const float* SST, const float* ng, bf16* Y) {
    const size_t tok = (size_t)ci * 64 + lane; const int r32 = lane & 31, hi = lane >> 5;
    { float b[32]; gla_wave_cumsum(LAp, tok, h, lane, b);
      float qx[32], kx[32]; load32bf(GQK + tok * 256 + h * 32, qx); load32bf(GQK + tok * 256 + 128 + h * 32, kx);
#pragma unroll
      for (int k = 0; k < 32; ++k) { const float eb = __expf(b[k]); qx[k] *= 0.17677669529663687f * eb; kx[k] *= fast_rcp(eb); }
#pragma unroll
      for (int j = 0; j < 4; ++j) { *(LAS bf16x8*)(wl + lane * 64 + j * 16) = pack8(qx + j * 8); *(LAS bf16x8*)(wl + 4096 + lane * 64 + j * 16) = pack8(kx + j * 8); } }
    gla_stage_vt(wl, GV, tok, h, lane);
    asm volatile("s_waitcnt lgkmcnt(0)" ::: "memory");
    bf16x8 qf[2][2], kf[2][2];
#pragma unroll
    for (int tb = 0; tb < 2; ++tb)
#pragma unroll
        for (int st = 0; st < 2; ++st) { qf[tb][st] = *(const LAS bf16x8*)(wl + (r32 + 32 * tb) * 64 + (8 * hi + 16 * st) * 2); kf[tb][st] = *(const LAS bf16x8*)(wl + 4096 + (r32 + 32 * tb) * 64 + (8 * hi + 16 * st) * 2); }
    f32x16g a00 = {}, a01 = {}, a11 = {};
#pragma unroll
    for (int st = 0; st < 2; ++st) { a00 = __builtin_amdgcn_mfma_f32_32x32x16_bf16(kf[0][st], qf[0][st], a00, 0, 0, 0); a01 = __builtin_amdgcn_mfma_f32_32x32x16_bf16(kf[0][st], qf[1][st], a01, 0, 0, 0); a11 = __builtin_amdgcn_mfma_f32_32x32x16_bf16(kf[1][st], qf[1][st], a11, 0, 0, 0); }
    bf16x8 p00[2], p01[2], p11[2];
    { float t0[16], t1[16], t2[16];
#pragma unroll
      for (int r = 0; r < 16; ++r) { const bool keep = ((r & 3) + 8 * (r >> 2) + 4 * hi) <= r32; t0[r] = keep ? a00[r] : 0.f; t1[r] = a01[r]; t2[r] = keep ? a11[r] : 0.f; }
      p00[0] = pack8(t0); p00[1] = pack8(t0 + 8); p01[0] = pack8(t1); p01[1] = pack8(t1 + 8); p11[0] = pack8(t2); p11[1] = pack8(t2 + 8); }
    f32x16g o[2][2] = {};
    const float* sp = SST + (size_t)(ci * 4 + h) * 2048;
#pragma unroll
    for (int vb = 0; vb < 2; ++vb) {
#pragma unroll
        for (int sb = 0; sb < 2; ++sb)
#pragma unroll
            for (int j = 0; j < 2; ++j) { const LAS unsigned char* vp = wl + 8192 + (r32 + 32 * vb) * 128 + (32 * sb + 16 * j + 4 * hi) * 2;
                const u32x2 lo = *(const LAS u32x2*)vp, hh = *(const LAS u32x2*)(vp + 16); const bf16x8 vf = __builtin_bit_cast(bf16x8, (u32x4){lo.x, lo.y, hh.x, hh.y});
                if (sb == 0) { o[vb][0] = __builtin_amdgcn_mfma_f32_32x32x16_bf16(vf, p00[j], o[vb][0], 0, 0, 0); o[vb][1] = __builtin_amdgcn_mfma_f32_32x32x16_bf16(vf, p01[j], o[vb][1], 0, 0, 0); }
                else o[vb][1] = __builtin_amdgcn_mfma_f32_32x32x16_bf16(vf, p11[j], o[vb][1], 0, 0, 0); }
#pragma unroll
        for (int st = 0; st < 2; ++st) { float sx[8];
#pragma unroll
            for (int e = 0; e < 8; ++e) sx[e] = sp[(8 * hi + 16 * st + e) * 64 + r32 + 32 * vb];
            const bf16x8 sf = pack8(sx);
            o[vb][0] = __builtin_amdgcn_mfma_f32_32x32x16_bf16(sf, qf[0][st], o[vb][0], 0, 0, 0); o[vb][1] = __builtin_amdgcn_mfma_f32_32x32x16_bf16(sf, qf[1][st], o[vb][1], 0, 0, 0); } }
#pragma unroll
    for (int tb = 0; tb < 2; ++tb) { float ss = 0.f;
#pragma unroll
        for (int vb = 0; vb < 2; ++vb)
#pragma unroll
            for (int r = 0; r < 16; ++r) ss += o[vb][tb][r] * o[vb][tb][r];
        { auto rr = __builtin_amdgcn_permlane32_swap(__float_as_uint(ss), __float_as_uint(ss), false, false); ss = __uint_as_float(rr[0]) + __uint_as_float(rr[1]); }
        const float rinv = 1.0f / sqrtf(ss * (1.f / 64.f) + RMS_EPS); const size_t t = (size_t)ci * 64 + r32 + 32 * tb;
#pragma unroll
        for (int vb = 0; vb < 2; ++vb)
#pragma unroll
            for (int g = 0; g < 4; ++g) { const int v0 = 32 * vb + 8 * g + 4 * hi; const u32x2 gw = *(const u32x2*)(GR + t * 256 + h * 64 + v0); const f32x4 gn = *(const f32x4*)(ng + h * 64 + v0);
                const float gr[4] = {bf_lo(gw.x), bf_hi(gw.x), bf_lo(gw.y), bf_hi(gw.y)}; float y[4];
#pragma unroll
                for (int i = 0; i < 4; ++i) y[i] = o[vb][tb][4 * g + i] * rinv * gn[i] * (gr[i] * sigmoidf_(gr[i]));
                u32x2 w; w.x = cvt_pk_bf16(y[0], y[1]); w.y = cvt_pk_bf16(y[2], y[3]); *(u32x2*)(Y + t * 768 + h * 64 + v0) = w; } }
    asm volatile("s_waitcnt lgkmcnt(0)" ::: "memory");
}
namespace attn {
using s16x4 = __attribute__((ext_vector_type(4))) short;
using f32x16 = __attribute__((ext_vector_type(16))) float;
constexpr int DM = 256;
constexpr int NW = 8, QBLK = 32, KVBLK = 64;
constexpr int NSLOT = 3, SLOTB = 8192;
constexpr int LDS_K = 0, LDS_V = NSLOT * SLOTB, LDS_WS = 2 * NSLOT * SLOTB, LDS_OST = LDS_WS + NW * 64 * 4, LDS_CK = LDS_OST + NW * 4096, LDS_ENT = LDS_CK + 8192, LDS_BYTES = LDS_ENT + NW * 128;
__device__ __forceinline__ int crow(int r, int hi) { return (r & 3) + 8 * (r >> 2) + 4 * hi; }
#define SBAR() __builtin_amdgcn_sched_barrier(0)
__device__ __forceinline__ void cmask(f32x16& p0, f32x16& p1, int jb, int qrel, int hi) {
  const float NEG = -INFINITY; int kb = 64 * jb + 4 * hi;
#pragma unroll
  for (int r = 0; r < 16; ++r) { int kv = kb + (r & 3) + 8 * (r >> 2); if (kv > qrel) p0[r] = NEG; if (kv + 32 > qrel) p1[r] = NEG; }
}
__device__ __forceinline__ void glds16(const void* gbase, unsigned voff, unsigned lds_dst) { unsigned keep;
  asm volatile("s_mov_b32 %0, m0\n\ts_mov_b32 m0, %3\n\ts_nop 0\n\tglobal_load_lds_dwordx4 %1, %2\n\ts_mov_b32 m0, %0" : "=&s"(keep) : "v"(voff), "s"(gbase), "s"(lds_dst) : "memory"); }
__device__ __forceinline__ float max3f(float a, float b, float c) { float r; asm("v_max3_f32 %0, %1, %2, %3" : "=v"(r) : "v"(a), "v"(b), "v"(c)); return r; }
__device__ __forceinline__ float max2f(float a, float b) { float r; asm("v_max_f32_e32 %0, %1, %2" : "=v"(r) : "v"(a), "v"(b)); return r; }
__device__ __forceinline__ float fadd_s(float a, float b) { float r; asm("v_add_f32_e32 %0, %1, %2" : "=v"(r) : "v"(a), "v"(b)); return r; }
__device__ __forceinline__ float fsub_s(float a, float b) { float r; asm("v_sub_f32_e32 %0, %1, %2" : "=v"(r) : "v"(a), "v"(b)); return r; }
__device__ __forceinline__ unsigned cvtpk_s(float lo, float hi) { f32x2 v = {lo, hi}; bf16x2_t b = __builtin_convertvector(v, bf16x2_t); return __builtin_bit_cast(unsigned, b); }
#define WAIT_BAR(N) asm volatile("s_waitcnt vmcnt(" #N ") lgkmcnt(0)\n\ts_barrier" ::: "memory")
typedef __attribute__((address_space(3))) const char* lds_cptr;
typedef short v4i16_t __attribute__((ext_vector_type(4)));
__device__ __forceinline__ void qkt(f32x16& p0, f32x16& p1, const char* Kslot, const bf16x8* qr, int r32, int hi) {
  const char* kb = Kslot + hi * 1024 + r32 * 16;
#pragma unroll
  for (int d0 = 0; d0 < 4; ++d0) {
    const bf16x8 b0 = *reinterpret_cast<const bf16x8*>(kb + d0 * 2048);
    const bf16x8 b1 = *reinterpret_cast<const bf16x8*>(kb + d0 * 2048 + 512);
    p0 = __builtin_amdgcn_mfma_f32_32x32x16_bf16(b0, qr[d0], p0, 0, 0, 0); p1 = __builtin_amdgcn_mfma_f32_32x32x16_bf16(b1, qr[d0], p1, 0, 0, 0); }
}
__device__ __forceinline__ void kload8(bf16x8* kf, lds_cptr kp) {
  kf[0] = *(const LAS bf16x8*)(kp);        kf[1] = *(const LAS bf16x8*)(kp + 512);
  kf[2] = *(const LAS bf16x8*)(kp + 2048); kf[3] = *(const LAS bf16x8*)(kp + 2560);
  kf[4] = *(const LAS bf16x8*)(kp + 4096); kf[5] = *(const LAS bf16x8*)(kp + 4608);
  kf[6] = *(const LAS bf16x8*)(kp + 6144); kf[7] = *(const LAS bf16x8*)(kp + 6656);
}
__device__ __forceinline__ void kload2(bf16x8* kf, lds_cptr kp, int j) { kf[2 * j] = *(const LAS bf16x8*)(kp + j * 2048); kf[2 * j + 1] = *(const LAS bf16x8*)(kp + j * 2048 + 512); }
__device__ __forceinline__ s16x4 vtr(lds_cptr p) { return __builtin_bit_cast(s16x4, __builtin_amdgcn_ds_read_tr16_b64_v4i16((LAS v4i16_t*)p)); }
__device__ __forceinline__ float rowmax(const f32x16& p0, const f32x16& p1) {
  float a = max3f(p0[0], p0[1], p1[0]), b = max3f(p0[2], p0[3], p1[1]); a = max3f(a, p1[2], p1[3]);
#pragma unroll
  for (int r = 4; r < 16; r += 4) { a = max3f(a, p0[r], p0[r + 1]); b = max3f(b, p0[r + 2], p0[r + 3]); a = max3f(a, p1[r], p1[r + 1]); b = max3f(b, p1[r + 2], p1[r + 3]); }
  const float m = max2f(a, b);
  auto rr = __builtin_amdgcn_permlane32_swap(__float_as_uint(m), __float_as_uint(m), false, false);
  return max2f(__uint_as_float(rr[0]), __uint_as_float(rr[1]));
}
__device__ __forceinline__ void pv(f32x16* o, int vb, bf16x8 pa0, bf16x8 pa1, bf16x8 pa2, bf16x8 pa3) {
#pragma unroll
  for (int d0 = 0; d0 < 2; ++d0) { s16x4 lo[4], hi[4];
#pragma unroll
    for (int ks = 0; ks < 4; ++ks) {
      asm volatile("ds_read_b64_tr_b16 %0,%1 offset:%c2" : "=&v"(lo[ks]) : "v"(vb), "i"(d0 * 4096 + ks * 1024) : "memory");
      asm volatile("ds_read_b64_tr_b16 %0,%1 offset:%c2" : "=&v"(hi[ks]) : "v"(vb), "i"(d0 * 4096 + ks * 1024 + 512) : "memory"); }
    asm volatile("s_waitcnt lgkmcnt(0)" ::: "memory"); SBAR();
#define PK(k) (bf16x8){lo[k][0], lo[k][1], lo[k][2], lo[k][3], hi[k][0], hi[k][1], hi[k][2], hi[k][3]}
    o[d0] = __builtin_amdgcn_mfma_f32_32x32x16_bf16(pa0, PK(0), o[d0], 0, 0, 0);
    o[d0] = __builtin_amdgcn_mfma_f32_32x32x16_bf16(pa1, PK(1), o[d0], 0, 0, 0);
    o[d0] = __builtin_amdgcn_mfma_f32_32x32x16_bf16(pa2, PK(2), o[d0], 0, 0, 0);
    o[d0] = __builtin_amdgcn_mfma_f32_32x32x16_bf16(pa3, PK(3), o[d0], 0, 0, 0);
#undef PK
  }
}

template <int THRL> __device__ __forceinline__ void attn_unit(const bf16* Qrow, const bf16* __restrict__ Kh, const bf16* __restrict__ Vh, const int NT, const bool band,
                                                             const float cq, const float* ckg, const int dest, bf16* PO, float* LSEp, char* shm, const int tid) {
  const int lane = tid & 63, r32 = lane & 31, hi = lane >> 5; const int wid = __builtin_amdgcn_readfirstlane(tid >> 6);
  const unsigned lds0 = (unsigned)(uintptr_t)shm;
  float* wsf = (float*)(shm + LDS_WS) + wid * 64;
  f32x4 ckv = (f32x4){0.f, 0.f, 0.f, 0.f};
  if (ckg && tid * 4 < NT * 64) ckv = *(const f32x4*)(ckg + tid * 4);
  const unsigned koff = (unsigned)(lane * DM + wid * 8) * 2u;
  const unsigned voff = (unsigned)((16 * (wid & 3) + (lane >> 2)) * DM + (wid >> 2) * 32 + (lane & 3) * 8) * 2u;
  const unsigned kdst = lds0 + LDS_K + wid * 1024, vdst = lds0 + LDS_V + wid * 1024;
#define DMA_K(t, slot) glds16(Kh + (long)(t) * KVBLK * DM, koff, (unsigned)__builtin_amdgcn_readfirstlane(kdst + (slot)))
#define DMA_V(t, slot) glds16(Vh + (long)(t) * KVBLK * DM, voff, (unsigned)__builtin_amdgcn_readfirstlane(vdst + (slot)))
  const char* Kbase = shm + LDS_K; bf16x8 kf[8];
  const lds_cptr shm3 = (lds_cptr)shm; const lds_cptr kp0 = shm3 + LDS_K + hi * 1024 + r32 * 16; const lds_cptr vp0 = shm3 + LDS_V + ((lane >> 4) & 1) * 32 + (lane & 3) * 8 + (4 * hi + ((lane & 15) >> 2)) * 64;
  const LAS f32x4* ck4 = (const LAS f32x4*)(shm3 + LDS_CK) + hi;
  DMA_K(0, 0); DMA_V(0, 0); DMA_K(1, SLOTB);
  bf16x8 qr[4];
#pragma unroll
  for (int d0 = 0; d0 < 4; ++d0) qr[d0] = *reinterpret_cast<const bf16x8*>(&Qrow[d0 * 16 + hi * 8]);
  *(LAS f32x4*)((LAS char*)shm3 + LDS_CK + tid * 16) = ckv;
  if (hi == 0) *(LAS int*)((LAS char*)shm3 + LDS_ENT + wid * 128 + r32 * 4) = dest;
  float mhat = 0.f, l_reg = 0.f, nb = cq; f32x16 o[2]; o[0] = f32x16{}; o[1] = f32x16{};
  const int qrel = wid * QBLK + r32;
#define CMASK(P0, P1, t) do { int jb_ = (t) - (NT - 4); if (band && jb_ >= 0) cmask(P0, P1, jb_, qrel, hi); } while (0)
#define BINIT(P0, P1, t) do { _Pragma("unroll") for (int g_ = 0; g_ < 4; ++g_) { const f32x4 a_ = ck4[16 * (t) + 2 * g_], b_ = ck4[16 * (t) + 8 + 2 * g_]; \
      _Pragma("unroll") for (int i_ = 0; i_ < 4; ++i_) { P0[4 * g_ + i_] = nb - a_[i_]; P1[4 * g_ + i_] = nb - b_[i_]; } } } while (0)
  bool resc = false;
#define START(P0, P1) do { const float rm = rowmax(P0, P1); resc = false; \
    { const float dl = rm; mhat = fadd_s(mhat, dl); nb = fsub_s(nb, dl); \
      _Pragma("unroll") for (int r = 0; r < 16; ++r) { P0[r] = fsub_s(P0[r], dl); P1[r] = fsub_s(P1[r], dl); } } \
    _Pragma("unroll") for (int r = 0; r < 16; ++r) P0[r] = __builtin_amdgcn_exp2f(P0[r]); } while (0)
#define RESC() do { if (resc) { asm volatile("s_waitcnt lgkmcnt(0)" ::: "memory"); \
      _Pragma("unroll") for (int d_ = 0; d_ < 2; ++d_) _Pragma("unroll") for (int r = 0; r < 16; ++r) o[d_][r] *= wsf[crow(r, hi)]; } } while (0)
  f32x16 pA0, pA1, pB0, pB1;
  int sl_prev = 0, sl_cur = 0, sl_next = SLOTB;
#define ROT() do { sl_prev = sl_cur; sl_cur = sl_next; sl_next = (sl_next == (NSLOT - 1) * SLOTB) ? 0 : sl_next + SLOTB; } while (0)
  DMA_K(2, 2 * SLOTB);
  WAIT_BAR(3);
  BINIT(pA0, pA1, 0);
  qkt(pA0, pA1, Kbase, qr, r32, hi); asm volatile("s_nop 15\n\ts_nop 7" : "+v"(pA0), "+v"(pA1)); CMASK(pA0, pA1, 0);
  START(pA0, pA1);
  _Pragma("unroll") for (int r = 0; r < 16; ++r) pA1[r] = __builtin_amdgcn_exp2f(pA1[r]);
  BINIT(pB0, pB1, 1);
  WAIT_BAR(0);
  DMA_K(3, 0); DMA_V(1, SLOTB);
  ROT();
  kload8(kf, kp0 + sl_cur);
  WAIT_BAR(2);
  s16x4 vlo[8], vhi[8]; u32x4 pw0, pw1, pw2, pw3;
#define PKW(P, B) cvtpk_s(P[B], P[B + 1])
#define PAF(k) __builtin_bit_cast(bf16x8, pw##k)
#define VFR(i) (bf16x8){vlo[i][0], vlo[i][1], vlo[i][2], vlo[i][3], vhi[i][0], vhi[i][1], vhi[i][2], vhi[i][3]}
#define PIN(x) asm volatile("" : "+v"(x))
#define MX3(a, b, c) __builtin_fmaxf(__builtin_fmaxf((a), (b)), (c))
#define GAPA(MF, A0, A1, A2, A3, W0, W1, PW) do { MF; sacc += A0; sacc += A1; sacc += A2; sacc += A3; PIN(sacc); W0; W1; PIN(PW); SBAR(); } while (0)
#define EX(v) __builtin_amdgcn_exp2f(v)
#define GAPB(MF, X, B) do { MF; X[B] = EX(X[B]); X[B + 1] = EX(X[B + 1]); X[B + 2] = EX(X[B + 2]); X[B + 3] = EX(X[B + 3]); PIN(X); SBAR(); } while (0)
#define VRD(i) do { vlo[i] = vtr(vp_ + (((i) >> 2) * 4096 + ((i) & 3) * 1024)); vhi[i] = vtr(vp_ + (((i) >> 2) * 4096 + ((i) & 3) * 1024 + 512)); } while (0)
#define KRD(G, j) do { if (G) { kload2(kf, kp0 + sl_next, j); SBAR(); } } while (0)
#define BRD(G, P0, P1, t, g) do { if (G) { const f32x4 a_ = ck4[16 * ((t) + 1) + 2 * (g)], b_ = ck4[16 * ((t) + 1) + 8 + 2 * (g)]; \
      P0[4 * (g)] = a_[0]; P0[4 * (g) + 1] = a_[1]; P0[4 * (g) + 2] = a_[2]; P0[4 * (g) + 3] = a_[3]; P1[4 * (g)] = b_[0]; P1[4 * (g) + 1] = b_[1]; P1[4 * (g) + 2] = b_[2]; P1[4 * (g) + 3] = b_[3]; SBAR(); } } while (0)
#define BSB(G, P0, P1) do { if (G) { _Pragma("unroll") for (int r = 0; r < 16; ++r) { P0[r] = nb - P0[r]; P1[r] = nb - P1[r]; } PIN(P0); PIN(P1); SBAR(); } } while (0)
#define STEP(C0, C1, P0, P1, t, GK, GV, GL) do { SBAR(); \
    const lds_cptr vp_ = vp0 + sl_prev; \
    VRD(0); SBAR(); float sacc = (P0[0] + P0[1]); \
    GAPA(C0 = __builtin_amdgcn_mfma_f32_32x32x16_bf16(kf[0], qr[0], C0, 0, 0, 0), P0[2], P0[3], P0[4], P0[5],     pw0[0] = PKW(P0, 0), pw0[1] = PKW(P0, 2), pw0); \
    VRD(4); SBAR(); GAPA(C1 = __builtin_amdgcn_mfma_f32_32x32x16_bf16(kf[1], qr[0], C1, 0, 0, 0), P0[6], P0[7], P0[8], P0[9],     pw0[2] = PKW(P0, 4), pw0[3] = PKW(P0, 6), pw0); \
    VRD(1); SBAR(); GAPA(C0 = __builtin_amdgcn_mfma_f32_32x32x16_bf16(kf[2], qr[1], C0, 0, 0, 0),   P0[10], P0[11], P0[12], P0[13], pw1[0] = PKW(P0, 8), pw1[1] = PKW(P0, 10), pw1); \
    VRD(5); SBAR(); GAPA(C1 = __builtin_amdgcn_mfma_f32_32x32x16_bf16(kf[3], qr[1], C1, 0, 0, 0),   P0[14], P0[15], P1[0], P1[1],   pw1[2] = PKW(P0, 12), pw1[3] = PKW(P0, 14), pw1); \
    VRD(2); SBAR(); GAPA(C0 = __builtin_amdgcn_mfma_f32_32x32x16_bf16(kf[4], qr[2], C0, 0, 0, 0),   P1[2], P1[3], P1[4], P1[5],     pw2[0] = PKW(P1, 0), pw2[1] = PKW(P1, 2), pw2); \
    VRD(6); SBAR(); GAPA(C1 = __builtin_amdgcn_mfma_f32_32x32x16_bf16(kf[5], qr[2], C1, 0, 0, 0),   P1[6], P1[7], P1[8], P1[9],     pw2[2] = PKW(P1, 4), pw2[3] = PKW(P1, 6), pw2); \
    VRD(3); SBAR(); GAPA(C0 = __builtin_amdgcn_mfma_f32_32x32x16_bf16(kf[6], qr[3], C0, 0, 0, 0),   P1[10], P1[11], P1[12], P1[13], pw3[0] = PKW(P1, 8), pw3[1] = PKW(P1, 10), pw3); \
    VRD(7); SBAR(); GAPA(C1 = __builtin_amdgcn_mfma_f32_32x32x16_bf16(kf[7], qr[3], C1, 0, 0, 0),   P1[14], P1[15], 0.f, 0.f,       pw3[2] = PKW(P1, 12), pw3[3] = PKW(P1, 14), pw3); \
    l_reg += sacc; \
    if (GK) { DMA_K((t) + 3, sl_cur); } if (GV) { DMA_V((t) + 1, sl_next); } \
    CMASK(C0, C1, t); \
    { float a = MX3(C0[0], C0[1], C1[0]), b = MX3(C0[2], C0[3], C1[1]); a = MX3(a, C1[2], C1[3]); \
      _Pragma("unroll") for (int r = 4; r < 16; r += 4) { a = MX3(a, C0[r], C0[r + 1]); b = MX3(b, C0[r + 2], C0[r + 3]); a = MX3(a, C1[r], C1[r + 1]); b = MX3(b, C1[r + 2], C1[r + 3]); } \
      float rm = __builtin_fmaxf(a, b); { auto rr = __builtin_amdgcn_permlane32_swap(__float_as_uint(rm), __float_as_uint(rm), false, false); rm = __builtin_fmaxf(__uint_as_float(rr[0]), __uint_as_float(rr[1])); } \
      resc = false; \
      if (__builtin_expect(__any(rm > (float)THRL), 0)) { const float dl = __builtin_fmaxf(rm, 0.f); mhat += dl; nb -= dl; \
        _Pragma("unroll") for (int r = 0; r < 16; ++r) { C0[r] -= dl; C1[r] -= dl; } \
        const float f = __builtin_amdgcn_exp2f(-dl); l_reg *= f; if (hi == 0) wsf[r32] = f; resc = true; } } \
    SBAR(); \
    BRD(GL, P0, P1, t, 0); BRD(GL, P0, P1, t, 1); \
    GAPB(o[0] = __builtin_amdgcn_mfma_f32_32x32x16_bf16(PAF(0), VFR(0), o[0], 0, 0, 0), C0, 0); \
    BRD(GL, P0, P1, t, 2); BRD(GL, P0, P1, t, 3); \
    GAPB(o[1] = __builtin_amdgcn_mfma_f32_32x32x16_bf16(PAF(0), VFR(4), o[1], 0, 0, 0), C0, 4); \
    KRD(GL, 0); GAPB(o[0] = __builtin_amdgcn_mfma_f32_32x32x16_bf16(PAF(1), VFR(1), o[0], 0, 0, 0), C0, 8); \
    KRD(GL, 1); GAPB(o[1] = __builtin_amdgcn_mfma_f32_32x32x16_bf16(PAF(1), VFR(5), o[1], 0, 0, 0), C0, 12); \
    KRD(GL, 2); GAPB(o[0] = __builtin_amdgcn_mfma_f32_32x32x16_bf16(PAF(2), VFR(2), o[0], 0, 0, 0), C1, 0); \
    KRD(GL, 3); GAPB(o[1] = __builtin_amdgcn_mfma_f32_32x32x16_bf16(PAF(2), VFR(6), o[1], 0, 0, 0), C1, 4); \
    GAPB(o[0] = __builtin_amdgcn_mfma_f32_32x32x16_bf16(PAF(3), VFR(3), o[0], 0, 0, 0), C1, 8); \
    GAPB(o[1] = __builtin_amdgcn_mfma_f32_32x32x16_bf16(PAF(3), VFR(7), o[1], 0, 0, 0), C1, 12); \
    BSB(GL, P0, P1); \
    } while (0)
  int t = 1;
#undef CMASK
#define CMASK(P0, P1, t) do {} while (0)
  for (; t + 5 < NT; t += 2) {
    STEP(pB0, pB1, pA0, pA1, t, true, true, true);     WAIT_BAR(2); RESC(); ROT();
    STEP(pA0, pA1, pB0, pB1, t + 1, true, true, true); WAIT_BAR(2); RESC(); ROT();
  }
#undef CMASK
#define CMASK(P0, P1, t) do { int jb_ = (t) - (NT - 4); if (band && jb_ >= 0) cmask(P0, P1, jb_, qrel, hi); } while (0)
#define ENDW(tt) do { if ((tt) + 3 < NT) { WAIT_BAR(2); } else if ((tt) + 2 < NT) { WAIT_BAR(1); } else { WAIT_BAR(0); } } while (0)
  for (; t + 1 < NT; t += 2) {
    STEP(pB0, pB1, pA0, pA1, t, (t + 3 < NT), (t + 1 < NT), (t + 1 < NT));         ENDW(t);     RESC(); ROT();
    STEP(pA0, pA1, pB0, pB1, t + 1, (t + 4 < NT), (t + 2 < NT), (t + 2 < NT));     ENDW(t + 1); RESC(); ROT();
  }
  STEP(pB0, pB1, pA0, pA1, NT - 1, false, false, false); RESC();
  { float sacc = pB0[0] + pB0[1]; _Pragma("unroll") for (int r = 2; r < 16; ++r) sacc += pB0[r]; _Pragma("unroll") for (int r = 0; r < 16; ++r) sacc += pB1[r]; l_reg += sacc;
    pw0 = (u32x4){PKW(pB0, 0), PKW(pB0, 2), PKW(pB0, 4), PKW(pB0, 6)}; pw1 = (u32x4){PKW(pB0, 8), PKW(pB0, 10), PKW(pB0, 12), PKW(pB0, 14)}; pw2 = (u32x4){PKW(pB1, 0), PKW(pB1, 2), PKW(pB1, 4), PKW(pB1, 6)}; pw3 = (u32x4){PKW(pB1, 8), PKW(pB1, 10), PKW(pB1, 12), PKW(pB1, 14)};
    const int vb0 = (int)(lds0 + LDS_V) + ((lane >> 4) & 1) * 32 + (lane & 3) * 8 + (4 * hi + ((lane & 15) >> 2)) * 64;
    SBAR(); pv(o, vb0 + sl_cur, PAF(0), PAF(1), PAF(2), PAF(3)); }
#undef PKW
#undef PAF
#undef VFR
#undef PIN
#undef MX3
#undef GAPA
#undef GAPB
#undef EX
#undef VRD
#undef KRD
#undef BRD
#undef BSB
#undef STEP
#undef ENDW
  { auto rr = __builtin_amdgcn_permlane32_swap(__float_as_uint(l_reg), __float_as_uint(l_reg), false, false); l_reg = __uint_as_float(rr[0]) + __uint_as_float(rr[1]); }
  if (hi == 0) { wsf[32 + r32] = l_reg; const int de0 = *(const LAS int*)((LAS char*)shm3 + LDS_ENT + wid * 128 + r32 * 4); if (de0 >= 0) LSEp[de0] = mhat + __builtin_amdgcn_logf(l_reg); }
  asm volatile("s_waitcnt lgkmcnt(0)" ::: "memory");
  float rli[16];
#pragma unroll
  for (int r = 0; r < 16; ++r) rli[r] = __builtin_amdgcn_rcpf(wsf[32 + crow(r, hi)]);
  { bf16* stg = (bf16*)(shm + LDS_OST) + wid * 2048;
#pragma unroll
    for (int r = 0; r < 16; ++r) { const int orow = crow(r, hi);
#pragma unroll
      for (int d0 = 0; d0 < 2; ++d0) stg[orow * 64 + d0 * 32 + r32] = (bf16)(cvtpk_s(o[d0][r] * rli[r], 0.f) & 0xffffu); }
    asm volatile("s_waitcnt lgkmcnt(0)" ::: "memory");
    const LAS int* ents = (const LAS int*)((LAS char*)shm3 + LDS_ENT + wid * 128);
#pragma unroll
    for (int i = 0; i < 4; ++i) { const int row = i * 8 + (lane >> 3), ch = lane & 7; const u32x4 v = *(const u32x4*)(stg + row * 64 + ch * 8); const int de = ents[row];
      if (de >= 0) *(u32x4*)(PO + (size_t)de * 64 + ch * 8) = v; } }
  asm volatile("s_waitcnt lgkmcnt(0)\n\ts_barrier" ::: "memory");
#undef DMA_K
#undef DMA_V
#undef CMASK
#undef BINIT
#undef START
#undef RESC
#undef ROT
}
#undef SBAR
#undef WAIT_BAR
}

__device__ __forceinline__ void load16(const bf16* p, float (&v)[16]) {
    const u32x4 a = *(const u32x4*)p, b = *(const u32x4*)(p + 8);
    v[0] = bf_lo(a.x); v[1] = bf_hi(a.x); v[2] = bf_lo(a.y); v[3] = bf_hi(a.y); v[4] = bf_lo(a.z); v[5] = bf_hi(a.z); v[6] = bf_lo(a.w); v[7] = bf_hi(a.w);
    v[8] = bf_lo(b.x); v[9] = bf_hi(b.x); v[10] = bf_lo(b.y); v[11] = bf_hi(b.y); v[12] = bf_lo(b.z); v[13] = bf_hi(b.z); v[14] = bf_lo(b.w); v[15] = bf_hi(b.w);
}
__device__ __forceinline__ void moba_gate_batch(LAS unsigned char* lds, int tid, int b, const bf16* MQ, const float* KM, int* QL, unsigned* MCNT) {
    typedef float f32x16 __attribute__((ext_vector_type(16)));
    LAS int* hist = (LAS int*)(lds + 65536);
    LAS int* base = hist + 256;
    const int own = (b * 128) >> 8, nsel = own < 3 ? own : 3;
    const int lane = tid & 63, r32 = lane & 31, hi = lane >> 5, w = tid >> 6, h = w & 3, th = w >> 2;
    if (tid < 256) hist[tid] = 0;
    __syncthreads();
    LAS int* sres = base + 256;
    if (own > 0) {
        bf16x8 kh[2][4], kl[2][4];
#pragma unroll
        for (int nb = 0; nb < 2; ++nb)
#pragma unroll
            for (int st = 0; st < 4; ++st) { const float* kp = KM + ((size_t)h * 64 + r32 + 32 * nb) * 64 + 8 * hi + 16 * st; const f32x4 a = *(const f32x4*)kp, c = *(const f32x4*)(kp + 4);
                const float x[8] = {a[0], a[1], a[2], a[3], c[0], c[1], c[2], c[3]}; float lo[8]; u32x4 hw;
                hw.x = cvt_pk_bf16(x[0], x[1]); hw.y = cvt_pk_bf16(x[2], x[3]); hw.z = cvt_pk_bf16(x[4], x[5]); hw.w = cvt_pk_bf16(x[6], x[7]);
                const unsigned hh[4] = {hw.x, hw.y, hw.z, hw.w};
#pragma unroll
                for (int e = 0; e < 4; ++e) { lo[2 * e] = x[2 * e] - bf_lo(hh[e]); lo[2 * e + 1] = x[2 * e + 1] - bf_hi(hh[e]); }
                kh[nb][st] = __builtin_bit_cast(bf16x8, hw); kl[nb][st] = pack8(lo); }
#pragma unroll 1
        for (int g = 0; g < 2; ++g) { const int t = b * 128 + th * 64 + g * 32 + r32;
            f32x16 a0 = {}, a1 = {};
#pragma unroll
            for (int st = 0; st < 4; ++st) { const bf16x8 qf = *(const bf16x8*)(MQ + (size_t)t * 256 + h * 64 + 8 * hi + 16 * st);
                a0 = __builtin_amdgcn_mfma_f32_32x32x16_bf16(kh[0][st], qf, a0, 0, 0, 0); a0 = __builtin_amdgcn_mfma_f32_32x32x16_bf16(kl[0][st], qf, a0, 0, 0, 0);
                a1 = __builtin_amdgcn_mfma_f32_32x32x16_bf16(kh[1][st], qf, a1, 0, 0, 0); a1 = __builtin_amdgcn_mfma_f32_32x32x16_bf16(kl[1][st], qf, a1, 0, 0, 0); }
            float v0 = -INFINITY, v1 = -INFINITY, v2 = -INFINITY; int i0 = 0, i1 = 0, i2 = 0;
#pragma unroll
            for (int nb = 0; nb < 2; ++nb)
#pragma unroll
                for (int r = 0; r < 16; ++r) { const int n = (r & 3) + 8 * (r >> 2) + 4 * hi + 32 * nb; const float s = (n < own) ? (nb == 0 ? a0[r] : a1[r]) : -INFINITY;
                    if (s > v0) { v2 = v1; i2 = i1; v1 = v0; i1 = i0; v0 = s; i0 = n; }
                    else if (s > v1) { v2 = v1; i2 = i1; v1 = s; i1 = n; }
                    else if (s > v2) { v2 = s; i2 = n; } }
            float pv[3]; int pi[3];
            { const float mv[3] = {v0, v1, v2}; const int mi[3] = {i0, i1, i2};
#pragma unroll
              for (int c = 0; c < 3; ++c) { auto rv = __builtin_amdgcn_permlane32_swap(__float_as_uint(mv[c]), __float_as_uint(mv[c]), false, false); pv[c] = __uint_as_float(hi ? rv[0] : rv[1]);
                  auto ri = __builtin_amdgcn_permlane32_swap((unsigned)mi[c], (unsigned)mi[c], false, false); pi[c] = (int)(hi ? ri[0] : ri[1]); } }
            float cv[6] = {v0, v1, v2, pv[0], pv[1], pv[2]}; int cix[6] = {i0, i1, i2, pi[0], pi[1], pi[2]};
#pragma unroll
            for (int s3 = 0; s3 < 3; ++s3) { float bv = -INFINITY; int bi = 0x7fffffff, bc = 0;
#pragma unroll
                for (int c = 0; c < 6; ++c) { const bool better = (cv[c] > bv) || (cv[c] == bv && cix[c] < bi); if (better) { bv = cv[c]; bi = cix[c]; bc = c; } }
#pragma unroll
                for (int c = 0; c < 6; ++c) if (c == bc) { cv[c] = -INFINITY; cix[c] = 0x7fffffff; }
                if (hi == 0 && s3 < nsel) { const int rnk = __hip_atomic_fetch_add(hist + h * 64 + bi, 1, __ATOMIC_RELAXED, __HIP_MEMORY_SCOPE_WORKGROUP); sres[((w * 2 + g) * 32 + r32) * 3 + s3] = (bi << 16) | rnk; } }
        }
    }
    __syncthreads();
    if (tid < 256) { const int c = hist[tid]; base[tid] = c > 0 ? (int)__hip_atomic_fetch_add(MCNT + tid, (unsigned)c, __ATOMIC_RELAXED, __HIP_MEMORY_SCOPE_AGENT) : 0; }
    __syncthreads();
    if (own > 0 && hi == 0) {
#pragma unroll
        for (int g = 0; g < 2; ++g) { const int t = b * 128 + th * 64 + g * 32 + r32;
#pragma unroll
            for (int s3 = 0; s3 < 3; ++s3) if (s3 < nsel) { const int pk = sres[((w * 2 + g) * 32 + r32) * 3 + s3]; const int bi = pk >> 16, rnk = pk & 0xffff; QL[((size_t)h * 63 + bi) * 16384 + base[h * 64 + bi] + rnk] = t * 4 + s3; } } }
    __syncthreads();
}

__device__ __forceinline__ void moe_table(const unsigned* cntg, LAS int* tab, int tid) {
    if (tid < 64) { const int e = tid; const int c = e < 32 ? (int)__hip_atomic_load(cntg + e, __ATOMIC_RELAXED, __HIP_MEMORY_SCOPE_AGENT) : 0; const int nt = (c + 255) >> 8;
        const int tail = (c > 0 && ((c - 1) & 255) < 128) ? 1 : 0;
        int incl = nt, itail = tail;
#pragma unroll
        for (int o = 1; o < 64; o <<= 1) { const int y = shu(incl, o), z = shu(itail, o); if (e >= o) { incl += y; itail += z; } }
        if (e < 32) { tab[e] = c; tab[32 + e] = incl - nt; tab[96 + e] = ((incl - nt) - (itail - tail)) | ((itail - tail) << 10) | (tail << 16); }
        if (e == 31) { tab[64] = incl; tab[65] = incl; tab[66] = incl - itail; } }
    __syncthreads();
    const int ntl = tab[65], nfull = tab[66];
    for (int m = tid; m < ntl; m += 512) { int e = 0;
        for (int j = 1; j < 32; ++j) if (tab[32 + j] <= m) e = j;
        tab[128 + m] = e;
        const int pk = tab[96 + e], i = m - tab[32 + e], nte = (tab[e] + 255) >> 8;
        const int k = ((pk >> 16) & 1) && i == nte - 1 ? nfull + ((pk >> 10) & 63) : (pk & 1023) + i;
        tab[448 + k] = m; }
    __syncthreads();
}

__device__ __forceinline__ void ln1_router_block(LAS unsigned char* lds, int tid, int blk, const bf16* XB, const bf16* Y, const float* g1, const float* b1, const float* brt, const bf16* WRT,
                                                 bf16* X1, unsigned char* X1F, unsigned* CNT, int* TOK, int* TE, int* TP, float* TG) {
    typedef float f32x16 __attribute__((ext_vector_type(16)));
    LAS float* part = (LAS float*)lds;
    LAS int* hist = (LAS int*)(lds + RT_OFF); LAS int* base = hist + 32; LAS int* sel_e = base + 32; LAS int* sel_r = sel_e + 256; LAS float* sel_g = (LAS float*)(sel_r + 256);
    const int lane = tid & 63, wave = tid >> 6;
    if (tid < 32) hist[tid] = 0;
    { u32x2 yn[2][4], xn[2][4];
      { const size_t t = (size_t)blk * 64 + wave * 8;
#pragma unroll
        for (int r = 0; r < 2; ++r)
#pragma unroll
            for (int j = 0; j < 4; ++j) { const int c = 4 * lane + 256 * j; yn[r][j] = *(const u32x2*)(Y + (t + r) * 1024 + c); xn[r][j] = *(const u32x2*)(XB + (t + r) * 1024 + c); } }
      f32x4 gv[4], bv[4];
#pragma unroll
      for (int j = 0; j < 4; ++j) { gv[j] = *(const f32x4*)(g1 + 4 * lane + 256 * j); bv[j] = *(const f32x4*)(b1 + 4 * lane + 256 * j); }
#pragma unroll 1
      for (int rr = 0; rr < 8; rr += 2) {
        const size_t t = (size_t)blk * 64 + wave * 8 + rr;
        f32x4 v[2][4]; float s[2] = {0.f, 0.f};
#pragma unroll
        for (int r = 0; r < 2; ++r)
#pragma unroll
            for (int j = 0; j < 4; ++j) { v[r][j] = (f32x4){bf_lo(xn[r][j].x), bf_hi(xn[r][j].x), bf_lo(xn[r][j].y), bf_hi(xn[r][j].y)} * ALPHA + (f32x4){bf_lo(yn[r][j].x), bf_hi(yn[r][j].x), bf_lo(yn[r][j].y), bf_hi(yn[r][j].y)}; s[r] += (v[r][j][0] + v[r][j][1]) + (v[r][j][2] + v[r][j][3]); }
        if (rr < 6) {
#pragma unroll
            for (int r = 0; r < 2; ++r)
#pragma unroll
                for (int j = 0; j < 4; ++j) { const int c = 4 * lane + 256 * j; yn[r][j] = *(const u32x2*)(Y + (t + 2 + r) * 1024 + c); xn[r][j] = *(const u32x2*)(XB + (t + 2 + r) * 1024 + c); } }
        float mean[2], s2[2] = {0.f, 0.f}, rstd[2];
#pragma unroll
        for (int o = 1; o < 64; o <<= 1) { s[0] += shx(s[0], o); s[1] += shx(s[1], o); }
#pragma unroll
        for (int r = 0; r < 2; ++r) { mean[r] = s[r] * (1.f / 1024.f);
#pragma unroll
            for (int j = 0; j < 4; ++j) { v[r][j] = v[r][j] - mean[r]; s2[r] += (v[r][j][0] * v[r][j][0] + v[r][j][1] * v[r][j][1]) + (v[r][j][2] * v[r][j][2] + v[r][j][3] * v[r][j][3]); } }
#pragma unroll
        for (int o = 1; o < 64; o <<= 1) { s2[0] += shx(s2[0], o); s2[1] += shx(s2[1], o); }
#pragma unroll
        for (int r = 0; r < 2; ++r) { rstd[r] = 1.f / sqrtf(s2[r] * (1.f / 1024.f) + LN_EPS);
#pragma unroll
            for (int j = 0; j < 4; ++j) { const int c = 4 * lane + 256 * j; v[r][j] = v[r][j] * rstd[r] * gv[j] + bv[j];
                u32x2 w; w.x = cvt_pk_bf16(v[r][j][0], v[r][j][1]); w.y = cvt_pk_bf16(v[r][j][2], v[r][j][3]); *(u32x2*)(X1 + (t + r) * 1024 + c) = w;
                *(unsigned*)(X1F + (t + r) * 1024 + c) = cvt4_fp8(v[r][j][0], v[r][j][1], v[r][j][2], v[r][j][3]); } } } }
    asm volatile("s_waitcnt vmcnt(0)" ::: "memory");
    __syncthreads();
    { const int r32 = lane & 31, hi = lane >> 5, grp = wave & 1, kq = wave >> 1;
      const bf16* xr = X1 + ((size_t)blk * 64 + grp * 32 + r32) * 1024 + kq * 256 + hi * 8;
      const bf16* wh = WRT + (size_t)r32 * 1024 + kq * 256 + hi * 8;
      f32x16 acc = {};
#pragma unroll
      for (int half = 0; half < 2; ++half) { bf16x8 xf[8], wf[8], wl[8];
#pragma unroll
          for (int s = 0; s < 8; ++s) { const int ko = (half * 8 + s) * 16; xf[s] = *(const bf16x8*)(xr + ko); wf[s] = *(const bf16x8*)(wh + ko); wl[s] = *(const bf16x8*)(wh + 32768 + ko); }
#pragma unroll
          for (int s = 0; s < 8; ++s) { acc = __builtin_amdgcn_mfma_f32_32x32x16_bf16(wf[s], xf[s], acc, 0, 0, 0); acc = __builtin_amdgcn_mfma_f32_32x32x16_bf16(wl[s], xf[s], acc, 0, 0, 0); } }
      LAS float* pw = part + ((size_t)wave * 32 + r32) * 36 + 4 * hi;
#pragma unroll
      for (int g = 0; g < 4; ++g) *(LAS f32x4*)(pw + 8 * g) = (f32x4){acc[4 * g], acc[4 * g + 1], acc[4 * g + 2], acc[4 * g + 3]}; }
    __syncthreads();
    if (tid < 64) { const int grp = tid >> 5, tk = tid & 31; float lv[32];
#pragma unroll
        for (int e4 = 0; e4 < 8; ++e4) { f32x4 x = *(const f32x4*)(brt + e4 * 4);
#pragma unroll
            for (int q = 0; q < 4; ++q) x += *(const LAS f32x4*)(part + ((size_t)(q * 2 + grp) * 32 + tk) * 36 + e4 * 4);
            lv[e4 * 4] = x[0]; lv[e4 * 4 + 1] = x[1]; lv[e4 * 4 + 2] = x[2]; lv[e4 * 4 + 3] = x[3]; }
        float tv[4]; int ti[4];
#pragma unroll
        for (int k = 0; k < 4; ++k) { float bvv = -INFINITY; int bi = 0;
#pragma unroll
            for (int e = 0; e < 32; ++e) { const bool taken = (k > 0 && ti[0] == e) || (k > 1 && ti[1] == e) || (k > 2 && ti[2] == e); if (!taken && lv[e] > bvv) { bvv = lv[e]; bi = e; } }
            tv[k] = bvv; ti[k] = bi; }
        const float e1 = __expf(tv[1] - tv[0]), e2 = __expf(tv[2] - tv[0]), e3 = __expf(tv[3] - tv[0]); const float inv = 1.f / (1.f + e1 + e2 + e3);
        const float gk[4] = {inv, e1 * inv, e2 * inv, e3 * inv};
#pragma unroll
        for (int k = 0; k < 4; ++k) { const int rk = __hip_atomic_fetch_add(hist + ti[k], 1, __ATOMIC_RELAXED, __HIP_MEMORY_SCOPE_WORKGROUP); sel_e[tid * 4 + k] = ti[k]; sel_r[tid * 4 + k] = rk; sel_g[tid * 4 + k] = gk[k]; } }
    __syncthreads();
    if (tid < 32) { const int c = hist[tid]; base[tid] = c > 0 ? (int)__hip_atomic_fetch_add(CNT + tid, (unsigned)c, __ATOMIC_RELAXED, __HIP_MEMORY_SCOPE_AGENT) : 0; }
    __syncthreads();
    if (tid < 256) { const int tl = tid >> 2; const int t = blk * 64 + tl; const int e = sel_e[tid], pos = base[e] + sel_r[tid];
        TOK[e * 16384 + pos] = t; TE[(size_t)t * 4 + (tid & 3)] = e; TP[(size_t)t * 4 + (tid & 3)] = pos; TG[(size_t)t * 4 + (tid & 3)] = sel_g[tid]; }
    __syncthreads();
}

__device__ __forceinline__ void ln2_rows8(int lane, int t0, const bf16* X1, const bf16* YB, const LAS int* tab, const int* TE, const int* TP, const float* TG, const float* g2, const float* b2, bf16* XB, unsigned char* XB8, float* outp) {
    int slot_l = 0; float g_l = 0.f;
    if (lane < 32) { const int e = TE[(size_t)t0 * 4 + lane], pos = TP[(size_t)t0 * 4 + lane]; g_l = TG[(size_t)t0 * 4 + lane]; slot_l = tab[32 + e] * 256 + pos; }
    f32x4 gv[4], bv[4];
#pragma unroll
    for (int j = 0; j < 4; ++j) { gv[j] = *(const f32x4*)(g2 + 4 * lane + 256 * j); bv[j] = *(const f32x4*)(b2 + 4 * lane + 256 * j); }
    const unsigned char* YB8 = (const unsigned char*)YB;
    for (int rp = 0; rp < 8; rp += 2) {
        u32x2 xw[2][4]; unsigned yw[2][4][4]; float gg[2][4];
#pragma unroll
        for (int r = 0; r < 2; ++r) { const size_t t = (size_t)t0 + rp + r;
#pragma unroll
            for (int j = 0; j < 4; ++j) xw[r][j] = *(const u32x2*)(X1 + t * 1024 + 4 * lane + 256 * j);
#pragma unroll
            for (int k = 0; k < 4; ++k) { const size_t slot = (size_t)__builtin_amdgcn_readlane(slot_l, (rp + r) * 4 + k); gg[r][k] = __uint_as_float(__builtin_amdgcn_readlane(__float_as_uint(g_l), (rp + r) * 4 + k)) * 0.0625f;
#pragma unroll
                for (int j = 0; j < 4; ++j) yw[r][k][j] = *(const unsigned*)(YB8 + slot * 1024 + 4 * lane + 256 * j); } }
#pragma unroll
        for (int r = 0; r < 2; ++r) { const size_t t = (size_t)t0 + rp + r; f32x4 v[4]; float s = 0.f;
#pragma unroll
            for (int j = 0; j < 4; ++j) { v[j] = (f32x4){bf_lo(xw[r][j].x), bf_hi(xw[r][j].x), bf_lo(xw[r][j].y), bf_hi(xw[r][j].y)} * ALPHA;
#pragma unroll
                for (int k = 0; k < 4; ++k) { const f32x2 lo2 = __builtin_amdgcn_cvt_pk_f32_fp8((int)yw[r][k][j], false), hi2 = __builtin_amdgcn_cvt_pk_f32_fp8((int)yw[r][k][j], true); v[j] += (f32x4){lo2[0], lo2[1], hi2[0], hi2[1]} * gg[r][k]; }
                s += (v[j][0] + v[j][1]) + (v[j][2] + v[j][3]); }
            const float mean = wave_sum(s) * (1.f / 1024.f); float s2 = 0.f;
#pragma unroll
            for (int j = 0; j < 4; ++j) { v[j] = v[j] - mean; s2 += (v[j][0] * v[j][0] + v[j][1] * v[j][1]) + (v[j][2] * v[j][2] + v[j][3] * v[j][3]); }
            const float rstd = 1.f / sqrtf(wave_sum(s2) * (1.f / 1024.f) + LN_EPS);
#pragma unroll
            for (int j = 0; j < 4; ++j) { const int c = 4 * lane + 256 * j; v[j] = v[j] * rstd * gv[j] + bv[j];
                u32x2 w; w.x = cvt_pk_bf16(v[j][0], v[j][1]); w.y = cvt_pk_bf16(v[j][2], v[j][3]); *(u32x2*)(XB + t * 1024 + c) = w;
                *(unsigned*)(XB8 + t * 1024 + c) = cvt4_fp8(v[j][0], v[j][1], v[j][2], v[j][3]);
                if (outp) *(f32x4*)(outp + t * 1024 + c) = v[j]; } }
    }
}

constexpr int NFOX_FULL = 928, NFOX = 1152;
__device__ __forceinline__ void fox_item(int idx, int& h, int& qb, int& p, int& NT, bool& band) {
    if (idx < NFOX_FULL) { h = idx / 232; const int k = idx % 232; int pp = 0, base = 0;
#pragma unroll
        for (int j = 0; j < 7; ++j) { const int cnt = 57 - 8 * j; if (k >= base + cnt && pp == j) { base += cnt; pp = j + 1; } }
        p = pp; qb = 8 * pp + 7 + (k - base); NT = 32; band = (8 * (pp + 1) == qb + 1); }
    else { const int i2 = idx - NFOX_FULL, cls = i2 >> 5, w = i2 & 31, r = 7 - cls; h = w >> 3; p = w & 7; qb = 8 * p + r - 1; NT = 4 * r; band = true; }
}
__device__ __forceinline__ void attn_item(int item, int nsel_items, const LAS int* mpre, unsigned char* ws, const unsigned* mcnt, char* shm, const int tid) {
    const int lane = tid & 63, r32 = lane & 31; const int wid = __builtin_amdgcn_readfirstlane(tid >> 6);
    const bf16* PROJ = (const bf16*)(ws + WS_PROJ);
    const int rw = wid * 32 + r32;
    int h, NT, tok, dest, kv0, tq; bool band; float cq = 0.f; const float* ckg = nullptr; bf16* PO; float* LSEp;
    if (item < NFOX) { int qb, p; fox_item(item, h, qb, p, NT, band);
        const float* CF = (const float*)(ws + WS_CF) + (size_t)h * S;
        tok = qb * 256 + rw; kv0 = p * 2048; dest = (tok * 4 + h) * 8 + p; tq = 0;
        PO = (bf16*)(ws + WS_POF); LSEp = (float*)(ws + WS_LSF);
        { const float* QN = (const float*)(ws + WS_NRM) + h * 256; const float* KN = QN + 1024;
          const float qm = fmaxf(fmaxf(QN[qb * 4], QN[qb * 4 + 1]), fmaxf(QN[qb * 4 + 2], QN[qb * 4 + 3])), ko = fmaxf(fmaxf(KN[qb * 4], KN[qb * 4 + 1]), fmaxf(KN[qb * 4 + 2], KN[qb * 4 + 3]));
          const int nfree = band ? NT - 4 : NT; const int ti = lane & 31; bool sk = false;
          if (ti < nfree) sk = qm * (KN[kv0 / 64 + ti] + ko) + (CF[qb * 256] - CF[kv0 + ti * 64 + 63]) < -40.f;
          const unsigned long long bal = __ballot(sk); int ns = __builtin_ctzll(~(bal & 0xffffffffull) | (1ull << 32));
          ns = __builtin_amdgcn_readfirstlane(ns) & ~1;
          if (!band && NT - ns < 4) { if (ns >= NT) { if (tid < 256) LSEp[((qb * 256 + tid) * 4 + h) * 8 + p] = -1e30f; return; } ns = NT - 4; }
          kv0 += ns * 64; NT -= ns; }
        cq = CF[tok]; ckg = CF + kv0;
    } else { int j; NT = 4; tq = 3; PO = (bf16*)(ws + WS_POM); LSEp = (float*)(ws + WS_LSM);
        if (item < NFOX + nsel_items) { const int k = item - NFOX; int lo = 0, hi_ = 252;
            while (hi_ - lo > 1) { const int mid = (lo + hi_) >> 1; if (mpre[mid] <= k) lo = mid; else hi_ = mid; }
            const int hj = lo, c = k - mpre[hj]; h = hj / 63; j = hj % 63; const int n = (int)mcnt[h * 64 + j] - c * 256;
            const int e = rw < n ? ((const int*)(ws + WS_QL))[((size_t)h * 63 + j) * 16384 + c * 256 + rw] : -1;
            tok = e < 0 ? 0 : (e >> 2); dest = e < 0 ? -1 : (tok * 4 + h) * 4 + (e & 3); band = false; }
        else { const int k = item - NFOX - nsel_items; h = k >> 6; j = k & 63; tok = j * 256 + rw; dest = (tok * 4 + h) * 4 + 3; band = true; }
        kv0 = j * 256; }
    attn::attn_unit<8>(PROJ + (size_t)tq * S * 256 + (size_t)tok * 256 + h * 64, PROJ + (size_t)(tq + 1) * S * 256 + (size_t)kv0 * 256 + h * 64, PROJ + (size_t)(tq + 2) * S * 256 + (size_t)kv0 * 256 + h * 64,
                       NT, band, cq, ckg, dest, PO, LSEp, shm, tid);
}
__device__ __forceinline__ void combine_token(int lane, int tok, unsigned char* ws) {
    const int h = lane >> 4, d4 = (lane & 15) * 4; bf16* YS = (bf16*)(ws + WS_YS);
    const int np = (tok >> 11) + 1; const float* LF = (const float*)(ws + WS_LSF) + ((size_t)tok * 4 + h) * 8; const bf16* PF = (const bf16*)(ws + WS_POF) + ((size_t)tok * 4 + h) * 8 * 64 + d4;
    const int own = tok >> 8, nsel = own < 3 ? own : 3; const float* LM = (const float*)(ws + WS_LSM) + ((size_t)tok * 4 + h) * 4; const bf16* PM = (const bf16*)(ws + WS_POM) + ((size_t)tok * 4 + h) * 4 * 64 + d4;
    float lf[8], lm[4]; u32x2 xf[8], xm[4];
#pragma unroll
    for (int p = 0; p < 8; ++p) { const bool on = p < np; lf[p] = on ? LF[p] : -INFINITY; xf[p] = on ? *(const u32x2*)(PF + p * 64) : (u32x2){0u, 0u}; }
#pragma unroll
    for (int s = 0; s < 4; ++s) { const bool on = s < nsel || s == 3; lm[s] = on ? LM[s] : -INFINITY; xm[s] = on ? *(const u32x2*)(PM + s * 64) : (u32x2){0u, 0u}; }
    { float m = lf[0];
#pragma unroll
      for (int p = 1; p < 8; ++p) m = fmaxf(m, lf[p]);
      float den = 0.f; f32x4 acc = (f32x4){0.f, 0.f, 0.f, 0.f};
#pragma unroll
      for (int p = 0; p < 8; ++p) { const float w = fast_exp2(lf[p] - m); den += w; acc += (f32x4){bf_lo(xf[p].x), bf_hi(xf[p].x), bf_lo(xf[p].y), bf_hi(xf[p].y)} * w; }
      const float inv = 1.f / den; u32x2 o; o.x = cvt_pk_bf16(acc[0] * inv, acc[1] * inv); o.y = cvt_pk_bf16(acc[2] * inv, acc[3] * inv);
      *(u32x2*)(YS + (size_t)tok * 768 + h * 64 + d4) = o; }
    { float m = lm[3];
#pragma unroll
      for (int s = 0; s < 3; ++s) m = fmaxf(m, lm[s]);
      float den = 0.f; f32x4 acc = (f32x4){0.f, 0.f, 0.f, 0.f};
#pragma unroll
      for (int s = 0; s < 4; ++s) { const float w = fast_exp2(lm[s] - m); den += w; acc += (f32x4){bf_lo(xm[s].x), bf_hi(xm[s].x), bf_lo(xm[s].y), bf_hi(xm[s].y)} * w; }
      const float inv = 1.f / den; u32x2 o; o.x = cvt_pk_bf16(acc[0] * inv, acc[1] * inv); o.y = cvt_pk_bf16(acc[2] * inv, acc[3] * inv);
      *(u32x2*)(YS + (size_t)tok * 768 + 512 + h * 64 + d4) = o; }
}
__global__ void __launch_bounds__(512, 2) mk_fwd(Args args_in_kernarg) {
    extern __shared__ __attribute__((aligned(16))) unsigned char lds_raw[];
    LAS unsigned char* lds = (LAS unsigned char*)lds_raw;
    const int tid0 = threadIdx.x; const int wave0 = __builtin_amdgcn_readfirstlane(tid0 >> 6);
    const int G = gridDim.x; const int bx = blockIdx.x; const int vcu = (G % 8 == 0) ? (bx % 8) * (G / 8) + bx / 8 : bx;
    const CAS unsigned char* const kargs = (const CAS unsigned char*)__builtin_amdgcn_kernarg_segment_ptr();
    for (int u = tid0; u < (LDS_BYTES - LDSCTL_OFF) / 4; u += 512) ((LAS unsigned*)(lds + LDSCTL_OFF))[u] = 0u;
    __syncthreads();
    const int lo = *(const CAS int*)(kargs + 160), hi = *(const CAS int*)(kargs + 164);
    XcdBarrier bar; bar.bar = (unsigned*)KARG_WS(kargs) + CW_BAR; bar.x = 0; bar.st = nullptr;
    if (hi - lo > 1) bar = xcd_barrier_post((unsigned*)KARG_WS(kargs) + CW_BAR, (volatile LAS unsigned*)(lds + MISC_OFF) + 8, tid0 == 0);
#if PROBE_MASK
    unsigned long long probe_t0 = 0;
#define PROBE_T0() probe_t0 = __builtin_amdgcn_s_memrealtime()
#define PROBE_END(p) do { if ((PROBE_MASK >> (p)) & 1) { asm volatile("s_waitcnt vmcnt(0)" ::: "memory"); const unsigned long long t1_ = __builtin_amdgcn_s_memrealtime(), dt_ = t1_ - probe_t0; \
        if (probe_t0 != 0) while (__builtin_amdgcn_s_memrealtime() - t1_ < dt_) __builtin_amdgcn_s_sleep(8); } probe_t0 = 0; } while (0)
#else
#define PROBE_T0() do {} while (0)
#define PROBE_END(p) do {} while (0)
#endif
#define IN(k) (lo <= (k) && (k) < hi)
#define SEAM(k) do { if (IN(k) && IN((k) + 1)) { const CAS unsigned char* kq_ = kargs; asm volatile("" : "+s"(kq_)); XcdBarrier b2_ = bar; b2_.bar = (unsigned*)KARG_WS(kq_) + CW_BAR; \
        xcd_barrier(b2_, wave0 == 0 && lane_id_now() == 0u); } } while (0)
#define PHASE_PTRS() const CAS unsigned char* kp = kargs; asm volatile("" : "+s"(kp)); unsigned char* const ws = KARG_WS(kp); (void)ws; \
    int tid = wave0 * 64 + (int)lane_id_now(); asm volatile("" : "+v"(tid)); const int lane = tid & 63, wave = __builtin_amdgcn_readfirstlane(tid >> 6); (void)lane; (void)wave
#define PROJ_ ((bf16*)(ws + WS_PROJ))
#define FQ_ (PROJ_)
#define FK_ (PROJ_ + (size_t)1 * S * 256)
#define FV_ (PROJ_ + (size_t)2 * S * 256)
#define MQ_ (PROJ_ + (size_t)3 * S * 256)
#define MK_ (PROJ_ + (size_t)4 * S * 256)
#define MV_ (PROJ_ + (size_t)5 * S * 256)
#define GQK_ (PROJ_ + (size_t)6 * S * 256)
#define GV_ (PROJ_ + (size_t)7 * S * 256)
#define GR_ (PROJ_ + (size_t)8 * S * 256)
    LAS int* const tab = (LAS int*)(lds + TAB_OFF);

    if (IN(0)) { PROBE_T0(); PHASE_PTRS(); p0_prologue(kp, lds, vcu, G, tid); }
    PROBE_END(15); SEAM(0);

    for (int l = 0; l < DEPTH; ++l) {
        const int pb = 1 + l * NPH;
        if (hi <= pb || lo >= pb + NPH) continue;
        if (IN(pb + 0)) { PROBE_T0(); PHASE_PTRS();
            { pg8::DenseOrder So; So.init(S, NIN, 1024, (const bf16*)(ws + WS_WIN) + (size_t)l * NIN * 1024, G, bx);
              pg8::EpiIn E{PROJ_, (bf16*)(ws + WS_SG), (float*)(ws + WS_LA), (float*)(ws + WS_FFL), KARG_IN(kp, 4) + l * 128, KARG_IN(kp, 2) + l * 4};
              pg8::gemm_phase<pg8::EpiIn, pg8::DenseOrder, true, false>(lds, (const bf16*)(ws + WS_XB), 1024, 1024, So, E, tid); }
            asm volatile("s_waitcnt vmcnt(0)" ::: "memory"); __syncthreads();
            { int Kq = 1024; asm volatile("" : "+s"(Kq));
              pg8::DenseOrder So; So.init(S, 3072, Kq, (const bf16*)(ws + WS_WIN8 + (size_t)l * 3072 * 1024), G, bx); So.K = Kq; So.split = (G == 256) ? 128 : 0;
              pg8::EpiGate E{(unsigned char*)(ws + WS_SG)};
              pg8::gemm_phase<pg8::EpiGate, pg8::DenseOrder, true, false, true>(lds, (const bf16*)(ws + WS_XB8), Kq, Kq, So, E, tid); }
        }
        PROBE_END(0); SEAM(pb + 0);
        if (IN(pb + 1)) { PROBE_T0(); PHASE_PTRS();
            const bf16* MK = MK_; float* KM = (float*)(ws + WS_KM);
            for (int wj = vcu * 8 + wave; wj < 1024 + 2048 + 256; wj += G * 8) {
                if (wj < 1024) gla_local_wave(lds + wave * 16384, lane, wj >> 2, wj & 3, GQK_, GV_, (const float*)(ws + WS_LA), (float*)(ws + WS_U), (float*)(ws + WS_DEC));
                else if (wj < 3072) {
                    const int idx = wj - 1024, tile = idx >> 3, which = (idx >> 2) & 1, h = idx & 3;
                    const bf16* src_ = PROJ_ + (size_t)which * S * 256 + (size_t)(tile * 64 + lane) * 256 + h * 64; float ss = 0.f;
#pragma unroll
                    for (int c = 0; c < 8; ++c) { const u32x4 w = *(const u32x4*)(src_ + c * 8); const float a0 = bf_lo(w.x), a1 = bf_hi(w.x), a2 = bf_lo(w.y), a3 = bf_hi(w.y), a4 = bf_lo(w.z), a5 = bf_hi(w.z), a6 = bf_lo(w.w), a7 = bf_hi(w.w);
                        ss += (a0 * a0 + a1 * a1) + (a2 * a2 + a3 * a3) + (a4 * a4 + a5 * a5) + (a6 * a6 + a7 * a7); }
                    float nm = sqrtf(ss);
#pragma unroll
                    for (int o = 1; o < 64; o <<= 1) nm = fmaxf(nm, shx(nm, o));
                    if (lane == 0) ((float*)(ws + WS_NRM))[(which * 4 + h) * 256 + tile] = nm; }
                else {
                    const int hj = wj - 3072, h = hj >> 6, j = hj & 63, kp = lane >> 4, dq = lane & 15;
                    const bf16* mk = MK_ + (size_t)(j * 256 + kp) * 256 + h * 64 + dq * 4; f32x4 s4 = (f32x4){0.f, 0.f, 0.f, 0.f};
#pragma unroll 1
                    for (int ib = 0; ib < 64; ib += 16) { u32x2 w[16];
#pragma unroll
                        for (int i = 0; i < 16; ++i) w[i] = *(const u32x2*)(mk + (size_t)(ib + i) * 4 * 256);
                        asm volatile("" : "+v"(w[0]), "+v"(w[1]), "+v"(w[2]), "+v"(w[3]), "+v"(w[4]), "+v"(w[5]), "+v"(w[6]), "+v"(w[7]), "+v"(w[8]), "+v"(w[9]), "+v"(w[10]), "+v"(w[11]), "+v"(w[12]), "+v"(w[13]), "+v"(w[14]), "+v"(w[15]));
#pragma unroll
                        for (int i = 0; i < 16; ++i) s4 += (f32x4){bf_lo(w[i].x), bf_hi(w[i].x), bf_lo(w[i].y), bf_hi(w[i].y)}; }
#pragma unroll
                    for (int c = 0; c < 4; ++c) { s4[c] += shx(s4[c], 16); s4[c] += shx(s4[c], 32); }
                    if (kp == 0) *(f32x4*)((float*)(ws + WS_KM) + (size_t)(h * 64 + j) * 64 + dq * 4) = s4 * (1.f / 256.f); }
            }
        }
        PROBE_END(1); SEAM(pb + 1);
        if (IN(pb + 2)) { PROBE_T0(); PHASE_PTRS();
            for (int job = vcu; job < 128 + 4 + 128; job += G) {
                if (job < 128) {
                    const float* DEC = (const float*)(ws + WS_DEC); const float* Ub = (const float*)(ws + WS_U); float* SST = (float*)(ws + WS_SST);
                    LAS float* cd = (LAS float*)lds; LAS float* cu = cd + 512;
                    const int e = job * 64 + lane; const float* dp = DEC + (size_t)wave * 32 * 128 + (e >> 6); const float* up = Ub + (size_t)wave * 32 * 8192 + e; float* sp = SST + (size_t)wave * 32 * 8192 + e;
                    float d[32], u[32];
#pragma unroll
                    for (int k = 0; k < 32; ++k) { d[k] = dp[k * 128]; u[k] = up[(size_t)k * 8192]; }
                    float dd = 1.f, uu = 0.f;
#pragma unroll
                    for (int k = 0; k < 32; ++k) { uu = uu * d[k] + u[k]; dd *= d[k]; }
                    cd[wave * 64 + lane] = dd; cu[wave * 64 + lane] = uu;
                    __syncthreads();
                    float s = 0.f;
                    for (int g2 = 0; g2 < wave; ++g2) s = s * cd[g2 * 64 + lane] + cu[g2 * 64 + lane];
#pragma unroll
                    for (int k = 0; k < 32; ++k) { sp[(size_t)k * 8192] = s; s = s * d[k] + u[k]; }
                    __syncthreads(); }
                else if (job < 132) { const float* FFL = (const float*)(ws + WS_FFL); float* CF = (float*)(ws + WS_CF);
                    const int h = job - 128; LAS float* wt = (LAS float*)lds; const f32x4* sp4 = (const f32x4*)(FFL + (size_t)h * S + tid * 32); f32x4 x[8];
#pragma unroll
                    for (int i = 0; i < 8; ++i) x[i] = sp4[i];
                    float run = 0.f;
#pragma unroll
                    for (int i = 0; i < 8; ++i) { x[i][0] += run; x[i][1] += x[i][0]; x[i][2] += x[i][1]; x[i][3] += x[i][2]; run = x[i][3]; }
                    float tot = run;
#pragma unroll
                    for (int o = 1; o < 64; o <<= 1) { const float y = shu(tot, o); if (lane >= o) tot += y; }
                    if (lane == 63) wt[wave] = tot;
                    __syncthreads();
                    float pre = tot - run;
                    for (int w = 0; w < wave; ++w) pre += wt[w];
                    f32x4* dp4 = (f32x4*)(CF + (size_t)h * S + tid * 32);
#pragma unroll
                    for (int i = 0; i < 8; ++i) dp4[i] = (x[i] + pre) * LOG2E;
                    __syncthreads(); }
                else moba_gate_batch(lds, tid, 127 - (job - 132), MQ_, (const float*)(ws + WS_KM), (int*)(ws + WS_QL), (unsigned*)ws + CW_MCNT + l * 256);
            }
        }
        PROBE_END(2); SEAM(pb + 2);
        if (IN(pb + 3)) { PROBE_T0(); PHASE_PTRS();
            bf16* const YS = (bf16*)(ws + WS_YS);
            for (int wj = vcu * 8 + wave; wj < 1024; wj += G * 8) gla_out_wave(lds + wave * 16384, lane, wj >> 2, wj & 3, GQK_, GV_, GR_, (const float*)(ws + WS_LA), (const float*)(ws + WS_SST), KARG_IN(kp, 5) + l * 256, YS + 256);
            __syncthreads();
            LAS int* const mpre = (LAS int*)(lds + RT_OFF); LAS int* const qslot = mpre + 256;
            const unsigned* mcnt = (const unsigned*)ws + CW_MCNT + l * 256; unsigned* qhead = (unsigned*)ws + CW_Q + l * 64;
            if (tid < 64) { int c4[4]; int s4 = 0;
#pragma unroll
                for (int i = 0; i < 4; ++i) { const int hj = tid * 4 + i; const int c = hj < 252 ? (int)mcnt[(hj / 63) * 64 + hj % 63] : 0; c4[i] = (c + 255) >> 8; s4 += c4[i]; }
                int incl = s4;
#pragma unroll
                for (int o = 1; o < 64; o <<= 1) { const int y = shu(incl, o); if (tid >= o) incl += y; }
                int run = incl - s4;
#pragma unroll
                for (int i = 0; i < 4; ++i) { if (tid * 4 + i <= 252) mpre[tid * 4 + i] = run; run += c4[i]; } }
            if (tid == 0) qslot[0] = (int)__hip_atomic_fetch_add(qhead, 1u, __ATOMIC_RELAXED, __HIP_MEMORY_SCOPE_AGENT);
            __syncthreads();
            const int nsel_items = mpre[252], total = NFOX + nsel_items + 256;
            int cur = qslot[0];
            __syncthreads();
            while (cur < total) {
                int nxt = 0;
                if (tid == 0) nxt = (int)__hip_atomic_fetch_add(qhead, 1u, __ATOMIC_RELAXED, __HIP_MEMORY_SCOPE_AGENT);
                attn_item(cur, nsel_items, mpre, ws, mcnt, (char*)lds_raw, tid);
                if (tid == 0) qslot[0] = nxt;
                __syncthreads();
                cur = qslot[0];
                __syncthreads();
            }
        }
        PROBE_END(3); SEAM(pb + 3);
        if (IN(pb + 4)) { PROBE_T0(); PHASE_PTRS();
            for (int t = (vcu * 8 + wave) * 8; t < S; t += G * 64) {
#pragma unroll 2
                for (int i = 0; i < 8; ++i) combine_token(lane, t + i, ws); }
        }
        PROBE_END(4); SEAM(pb + 4);
        if (IN(pb + 5)) { PROBE_T0(); PHASE_PTRS();
            int Kl = 768; asm volatile("" : "+s"(Kl));
            pg8::DenseOrder So; So.init(S, 1024, Kl, (const bf16*)(ws + WS_WBR) + (size_t)l * 1024 * 768, G, bx);
            pg8::EpiLift E{(const unsigned char*)(ws + WS_SG), (bf16*)(ws + WS_MRG)};
            pg8::gemm_phase<pg8::EpiLift, pg8::DenseOrder, true, false, false, true>(lds, (const bf16*)(ws + WS_YS), Kl, Kl, So, E, tid);
        }
        PROBE_END(5); SEAM(pb + 5);
        if (IN(pb + 6)) { PROBE_T0(); PHASE_PTRS();
            pg8::DenseOrder So; So.init(S, 1024, 1024, (const bf16*)(ws + WS_WOUT) + (size_t)l * 1024 * 1024, G, bx);
            pg8::EpiF32 E{(bf16*)(ws + WS_Y)};
            pg8::gemm_phase<pg8::EpiF32, pg8::DenseOrder, true, false>(lds, (const bf16*)(ws + WS_MRG), 1024, 1024, So, E, tid);
        }
        PROBE_END(6); SEAM(pb + 6);
        if (IN(pb + 7)) { PROBE_T0(); PHASE_PTRS();
            for (int blk = vcu; blk < S / 64; blk += G)
                ln1_router_block(lds, tid, blk, (const bf16*)(ws + WS_XB), (const bf16*)(ws + WS_Y), KARG_IN(kp, 8) + l * 1024, KARG_IN(kp, 9) + l * 1024, KARG_IN(kp, 11) + l * 32, (const bf16*)(ws + WS_WRT) + (size_t)l * 65536, (bf16*)(ws + WS_X1), (unsigned char*)(ws + WS_X1F),
                                 (unsigned*)ws + CW_CNT + l * 64, (int*)(ws + WS_TOK), (int*)(ws + WS_TE), (int*)(ws + WS_TP), (float*)(ws + WS_TG));
        }
        PROBE_END(7); SEAM(pb + 7);
        if (IN(pb + 8)) { PROBE_T0(); PHASE_PTRS();
            moe_table((const unsigned*)ws + CW_CNT + l * 64, tab, tid);
            pg8::MoeOrder So{G, vcu, 8, tab[65], tab, (const int*)(ws + WS_TOK), (const char*)(ws + WS_WGU) + (size_t)l * 32 * 2048 * 1024, (size_t)2048 * 1024, 1024};
            pg8::EpiMoe1 E{(unsigned char*)(ws + WS_ACT), KARG_IN(kp, 13) + (size_t)l * 32 * 2048, (const LAS float*)(lds + RT_OFF)};
            int Kq = 1024; asm volatile("" : "+s"(Kq));
            pg8::gemm_phase<pg8::EpiMoe1, pg8::MoeOrder, true, true, true, false, true>(lds, (const bf16*)(ws + WS_X1F), Kq, Kq, So, E, tid);
        }
        PROBE_END(8); SEAM(pb + 8);
        if (IN(pb + 9)) { PROBE_T0(); PHASE_PTRS();
            moe_table((const unsigned*)ws + CW_CNT + l * 64, tab, tid);
            pg8::MoeOrder So{G, vcu, 4, tab[65], tab, nullptr, (const char*)(ws + WS_WDN) + (size_t)l * 32 * 1024 * 1024, (size_t)1024 * 1024, 1024};
            pg8::EpiMoe2 E{(bf16*)(ws + WS_YB), KARG_IN(kp, 15) + (size_t)l * 32 * 1024, (const LAS float*)(lds + RT_OFF)};
            int Kq = 1024; asm volatile("" : "+s"(Kq));
            pg8::gemm_phase<pg8::EpiMoe2, pg8::MoeOrder, true, false, true, false, true>(lds, (const bf16*)(ws + WS_ACT), Kq, Kq, So, E, tid);
        }
        PROBE_END(9); SEAM(pb + 9);
        if (IN(pb + 10)) { PROBE_T0(); PHASE_PTRS();
            moe_table((const unsigned*)ws + CW_CNT + l * 64, tab, tid);
            float* outp = (l == DEPTH - 1) ? KARG_OUT(kp) : nullptr;
            for (int t0 = (vcu * 8 + wave) * 8; t0 < S; t0 += G * 64) ln2_rows8(lane, t0, (const bf16*)(ws + WS_X1), (const bf16*)(ws + WS_YB), tab, (const int*)(ws + WS_TE), (const int*)(ws + WS_TP), (const float*)(ws + WS_TG),
                                                                            KARG_IN(kp, 16) + l * 1024, KARG_IN(kp, 17) + l * 1024, (bf16*)(ws + WS_XB), (unsigned char*)(ws + WS_XB8), outp);
        }
        PROBE_END(10); SEAM(pb + 10);
    }
#undef IN
#undef SEAM
}

extern "C" void kernel_launch(void* const* d_in, const int* in_sizes, int n_in, void* d_out, int out_size, void* d_ws, size_t ws_size, hipStream_t stream) {
    static int grid = 0;
    if (grid == 0) {
        if (n_in != 18 || out_size != S * D || ws_size < WS_END) { fprintf(stderr, "kernel_launch: unexpected shapes (n_in %d out %d ws %zu, need %zu)\n", n_in, out_size, ws_size, (size_t)WS_END); grid = -1; return; }
        int dev = 0, cus = 0, per_cu = 0;
        if (hipGetDevice(&dev) != hipSuccess || hipDeviceGetAttribute(&cus, hipDeviceAttributeMultiprocessorCount, dev) != hipSuccess) { grid = -1; return; }
        if (hipFuncSetAttribute((const void*)mk_fwd, hipFuncAttributeMaxDynamicSharedMemorySize, LDS_BYTES) != hipSuccess) { fprintf(stderr, "kernel_launch: hipFuncSetAttribute failed\n"); grid = -1; return; }
        if (hipOccupancyMaxActiveBlocksPerMultiprocessor(&per_cu, (const void*)mk_fwd, 512, LDS_BYTES) != hipSuccess || per_cu < 1) fprintf(stderr, "kernel_launch: occupancy query says %d\n", per_cu);
        (void)hipGetLastError();
        grid = cus;
    }
    if (grid < 0) return;
    (void)hipMemsetAsync((char*)d_ws + WS_CTL, 0, CTL_ZERO_BYTES, stream);
    Args a{};
    for (int i = 0; i < 18; ++i) a.in[i] = (const float*)d_in[i];
    a.out = (float*)d_out; a.ws = (unsigned char*)d_ws;
#if MK_PER_PHASE
    for (int p = 0; p < NPHASE; ++p) { a.ph_lo = p; a.ph_hi = p + 1; hipLaunchKernelGGL(mk_fwd, dim3(grid), dim3(512), LDS_BYTES, stream, a); }
#else
    a.ph_lo = 0; a.ph_hi = NPHASE;
    hipLaunchKernelGGL(mk_fwd, dim3(grid), dim3(512), LDS_BYTES, stream, a);
#endif
}
```

```cpp
#include <hip/hip_runtime.h>
#include <cstdio>
#include <cstdint>

#ifndef MK_PER_PHASE
#define MK_PER_PHASE 0
#endif

#ifndef PROBE_MASK
#define PROBE_MASK 0
#endif
#define LAS __attribute__((address_space(3)))
#define GAS __attribute__((address_space(1)))
typedef unsigned short bf16;
typedef short bf16x8 __attribute__((ext_vector_type(8)));
typedef float f32x4 __attribute__((ext_vector_type(4)));
typedef float f32x2 __attribute__((ext_vector_type(2)));
typedef unsigned u32x4 __attribute__((ext_vector_type(4)));
typedef unsigned u32x2 __attribute__((ext_vector_type(2)));
typedef int v8i32_t __attribute__((ext_vector_type(8)));
typedef short bf16x16_t __attribute__((ext_vector_type(16)));

constexpr int S = 16384, D = 1024, DEPTH = 4;
constexpr int D_IN = 5396, NIN = 2560;
constexpr int NE = 32;
constexpr int NSLOT = 73728;
constexpr float ALPHA = 1.6817928305074290f;
constexpr float LOG2E = 1.4426950408889634f;
constexpr float C2 = 0.125f * LOG2E;
constexpr float LN_EPS = 1e-5f, RMS_EPS = 1e-6f;
constexpr int NPH = 11;
constexpr int NPHASE = 1 + DEPTH * NPH;

constexpr size_t MiB = 1ull << 20;
constexpr size_t WS_CTL = 0, CTL_ZERO_BYTES = 1 * MiB;
constexpr size_t WS_WIN = 1 * MiB;
constexpr size_t WS_WBR = WS_WIN + 44 * MiB;
constexpr size_t WS_WOUT = WS_WBR + 6 * MiB;
constexpr size_t WS_WGU = WS_WOUT + 8 * MiB;
constexpr size_t WS_WDN = WS_WGU + 512 * MiB;
constexpr size_t WS_XB = WS_WDN + 256 * MiB;
constexpr size_t WS_X1 = WS_XB + 32 * MiB;
constexpr size_t WS_PROJ = WS_X1 + 32 * MiB;
constexpr size_t WS_SG = WS_PROJ + 72 * MiB;
constexpr size_t WS_LA = WS_SG + 96 * MiB;
constexpr size_t WS_FFL = WS_LA + 8 * MiB;
constexpr size_t WS_CF = WS_FFL + 1 * MiB;
constexpr size_t WS_YS = WS_CF + 1 * MiB;
constexpr size_t WS_T = WS_YS + 24 * MiB;
constexpr size_t WS_MRG = WS_T + 64 * MiB;
constexpr size_t WS_Y = WS_MRG + 32 * MiB;
constexpr size_t WS_ACT = WS_Y + 64 * MiB;
constexpr size_t WS_YB = WS_ACT + 144 * MiB;
constexpr size_t WS_U = WS_YB + 144 * MiB;
constexpr size_t WS_SST = WS_U + 8 * MiB;
constexpr size_t WS_DEC = WS_SST + 8 * MiB;
constexpr size_t WS_KM = WS_DEC + 1 * MiB;
constexpr size_t WS_NRM = WS_KM + 256 * 1024;
constexpr size_t WS_SEL = WS_KM + 1 * MiB;
constexpr size_t WS_QL = WS_SEL + 1 * MiB;
constexpr size_t WS_TOK = WS_QL + 16 * MiB;
constexpr size_t WS_TE = WS_TOK + 2 * MiB;
constexpr size_t WS_TP = WS_TE + 1 * MiB;
constexpr size_t WS_TG = WS_TP + 1 * MiB;
constexpr size_t WS_POF = WS_TG + 1 * MiB;
constexpr size_t WS_LSF = WS_POF + 64 * MiB;
constexpr size_t WS_POM = WS_LSF + 2 * MiB;
constexpr size_t WS_LSM = WS_POM + 32 * MiB;
constexpr size_t WS_WBP = WS_LSM + 1 * MiB;
constexpr size_t WS_XB8 = WS_WBP + 17 * MiB;
constexpr size_t WS_WIN8 = WS_WBP + 33 * MiB;
constexpr size_t WS_X1F = WS_WBP + 1 * MiB;
constexpr size_t WS_WRT = WS_WBP;
constexpr size_t WS_END = WS_WBP + 46 * MiB;
constexpr int CW_BAR = 4096;
constexpr int CW_CNT = 16384;
constexpr int CW_MCNT = 20480;
constexpr int CW_Q = 24576;

constexpr int RING_BYTES = 131072;
constexpr int LDSCTL_OFF = RING_BYTES, MISC_OFF = LDSCTL_OFF + 320;
constexpr int TAB_OFF = RING_BYTES + 1024;
constexpr int RT_OFF = RING_BYTES + 4096;
constexpr int LDS_BYTES = 147456;

__device__ __forceinline__ float bf_lo(unsigned w) { return __uint_as_float(w << 16); }
__device__ __forceinline__ float bf_hi(unsigned w) { return __uint_as_float(w & 0xffff0000u); }
__device__ __forceinline__ float bf2f(bf16 b) { return __uint_as_float((unsigned)b << 16); }
typedef __bf16 bf16x2_t __attribute__((ext_vector_type(2)));
__device__ __forceinline__ unsigned cvt_pk_bf16(float lo, float hi) { f32x2 v = {lo, hi}; bf16x2_t b = __builtin_convertvector(v, bf16x2_t); return __builtin_bit_cast(unsigned, b); }
__device__ __forceinline__ unsigned cvt4_fp8(float a, float b, float c, float d) { int w = 0; w = __builtin_amdgcn_cvt_pk_fp8_f32(a, b, w, false); w = __builtin_amdgcn_cvt_pk_fp8_f32(c, d, w, true); return (unsigned)w; }
__device__ __forceinline__ float fast_exp2(float x) { return __builtin_amdgcn_exp2f(x); }
__device__ __forceinline__ float fast_rcp(float x) { return __builtin_amdgcn_rcpf(x); }
__device__ __forceinline__ float sigmoidf_(float x) { return fast_rcp(1.f + fast_exp2(-x * LOG2E)); }
__device__ __forceinline__ float logsigmoidf_(float x) { return fminf(x, 0.f) - __logf(1.f + __expf(-fabsf(x))); }
__device__ __forceinline__ unsigned lane_id_now() { unsigned r; asm volatile("v_mbcnt_lo_u32_b32 %0, -1, 0\n\tv_mbcnt_hi_u32_b32 %0, -1, %0" : "=v"(r)); return r; }
__device__ __forceinline__ int shx(int v, int m) { const int ln = (int)lane_id_now(); return __builtin_amdgcn_ds_bpermute((ln ^ m) << 2, v); }
__device__ __forceinline__ float shx(float v, int m) { return __uint_as_float((unsigned)shx((int)__float_as_uint(v), m)); }
__device__ __forceinline__ int shu(int v, int d) { const int ln = (int)lane_id_now(); const int s = ln - d; return __builtin_amdgcn_ds_bpermute((s < 0 ? ln : s) << 2, v); }
__device__ __forceinline__ float shu(float v, int d) { return __uint_as_float((unsigned)shu((int)__float_as_uint(v), d)); }
__device__ __forceinline__ float wave_sum(float v) {
#pragma unroll
    for (int o = 1; o < 64; o <<= 1) v += shx(v, o);
    return v;
}

namespace pg8 {
constexpr int BM = 256, BK = 64, HALF = 128, HTB = HALF * BK * 2, NXCD = 8, WGM = 8;
__device__ __forceinline__ int lds_byte(int r, int c) { const int st = (r >> 4) * 2 + (c >> 5), rr = r & 15, cc = c & 31, ob = rr * 64 + cc * 2; return st * 1024 + (ob ^ (((ob >> 9) & 1) << 5)); }
__device__ __forceinline__ void stage_rc(int b, int& R, int& C) { const int st = b / 1024, sb = b % 1024, swz = sb ^ (((sb >> 9) & 1) << 5); R = (st >> 1) * 16 + swz / 64; C = (st & 1) * 32 + (swz % 64) / 2; }
__device__ __forceinline__ int perm32(int rho) { const int n = rho >> 4, i = rho & 15; return 8 * (i >> 2) + 4 * n + (i & 3); }

struct Unit { int pm, pn, e, half, par; };

struct DenseOrder {
    int nM, nN, nwg, G, c; const char* Bt; int K; int split = 0;
    __device__ void init(int M, int N, int K_, const bf16* Bt_, int G_, int c_) { nM = M / BM; nN = N / BM; nwg = nM * nN; G = G_; c = c_; Bt = (const char*)Bt_; K = K_ * 2; }
    __device__ bool next(int i, Unit& u) const {
        long L = (long)i * G + c;
        if (split > 0 && i >= 2) { if (c < split || i >= 4) return false; L = 2l * G + (long)(i - 2) * (G - split) + (c - split); }
        if (L >= nwg) return false;
        int wgid = (int)L; { const int q = nwg / NXCD, r = nwg % NXCD, xcd = wgid % NXCD, off = wgid / NXCD; wgid = (xcd < r ? xcd * (q + 1) : r * (q + 1) + (xcd - r) * q) + off; }
        const int nig = WGM * nN, gid = wgid / nig, fm = gid * WGM, gsz = (nM - fm) < WGM ? (nM - fm) : WGM;
        u.pm = fm + ((wgid % nig) % gsz); u.pn = (wgid % nig) / gsz; u.e = 0; return true;
    }
    __device__ __forceinline__ unsigned arow(const Unit& u, int r) const { return (unsigned)(u.pm * BM + r); }
    __device__ __forceinline__ const char* bbase(const Unit& u) const { return Bt + (size_t)u.pn * BM * K; }
};

struct MoeOrder {
    int G, c, NN, ntiles; const LAS int* tab; const int* toklist; const char* Bt; size_t ebytes; int K;
    __device__ bool next(int i, Unit& u) const {
        const int L = i * G + c; if (L >= ntiles * NN) return false;
        const int k = L / NN; u.pm = tab[448 + k]; u.pn = L % NN; u.e = tab[128 + u.pm]; u.half = k >= tab[66] ? 1 : 0; return true;
    }
    __device__ __forceinline__ unsigned arow(const Unit& u, int r) const {
        if (!toklist) return (unsigned)(u.pm * BM + r);
        const int rr = (u.pm - tab[32 + u.e]) * BM + r;
        return rr < tab[u.e] ? (unsigned)toklist[u.e * 16384 + rr] : 0u;
    }
    __device__ __forceinline__ const char* bbase(const Unit& u) const { return Bt + (size_t)u.e * ebytes + (size_t)u.pn * BM * K; }
};

template <class Epi, class Sched, bool ALIGN_EPI, bool GATHER, bool FP8 = false, bool HOOK = false, bool TAILS = false>
__device__ __forceinline__ void gemm_phase(LAS unsigned char* lds, const bf16* Abase, const int K, const int lda, const Sched& S, const Epi& E, const int tid_in) {
    int tid_ = tid_in; asm volatile("" : "+v"(tid_));
    const int tid = tid_, wid = __builtin_amdgcn_readfirstlane(tid >> 6), lane = tid & 63, wr = wid >> 2, wc = wid & 3, fr = lane & 15, fq = lane >> 4;
    constexpr int EB = FP8 ? 1 : 2;
    const int nt = K * EB / 128;
    unsigned voffA[2], voffB[2];
#pragma unroll
    for (int i = 0; i < 2; ++i) { int R, C; stage_rc(tid * 16 + i * 8192, R, C); const int Rb = Epi::PERM == 3 ? ((R >> 5) * 64 + ((R >> 2) & 3) * 16 + ((R >> 4) & 1) * 4 + (R & 3)) : Epi::PERM ? ((R & ~31) + perm32(R & 31)) : R;
        voffA[i] = (unsigned)(R * lda * EB + C * 2); voffB[i] = (unsigned)(Rb * K * EB + C * 2); }
    LAS u32x4* const stash = (LAS u32x4*)(lds + RING_BYTES + 8192) + tid;
    const size_t kstep = (size_t)(BK * 2);
    const size_t hstep = (size_t)(Epi::PERM == 3 ? 8 : HALF) * K * EB;
    const size_t hstepA = (size_t)HALF * lda * EB;
    const unsigned ldsw = (unsigned)wid * 1024u;
    const unsigned ldsbase = (unsigned)(uintptr_t)lds;
    const int aoff = lds_byte(wr * 64 + fr, fq * 8), boff = lds_byte(wc * 32 + fr, fq * 8);
    const char* gA = (const char*)Abase;
#define PG8_SA(b, h) (((b) * 2 + (h)) * HTB)
#define PG8_SB(b, h) ((4 + (b) * 2 + (h)) * HTB)
#define PG8_STAGE(bufoff, gbase, voff) do { _Pragma("unroll") for (int _i = 0; _i < 2; ++_i) { unsigned keep_; \
        asm volatile("s_mov_b32 %0, m0\n\ts_mov_b32 m0, %3\n\ts_nop 0\n\tglobal_load_lds_dwordx4 %1, %2\n\ts_mov_b32 m0, %0" : "=&s"(keep_) \
            : "v"((voff)[_i]), "s"((const char*)(gbase)), "s"((unsigned)__builtin_amdgcn_readfirstlane(ldsbase + (unsigned)(bufoff) + ldsw + _i * 8192u)) : "memory"); } } while (0)
#define PG8_LD32(addr) __builtin_bit_cast(v8i32_t, __builtin_shufflevector(*(const LAS u32x4*)(addr), *(const LAS u32x4*)((addr) + 1024), 0, 1, 2, 3, 4, 5, 6, 7))
#define PG8_LDA(dst, b, h) do { if constexpr (FP8) { _Pragma("unroll") for (int m = 0; m < 4; ++m) dst##8[m] = PG8_LD32(lds + PG8_SA(b, h) + aoff + m * 2048); } \
        else { _Pragma("unroll") for (int m = 0; m < 4; ++m) _Pragma("unroll") for (int k = 0; k < 2; ++k) dst[m][k] = *(const LAS bf16x8*)(lds + PG8_SA(b, h) + aoff + m * 2048 + k * 1024); } } while (0)
#define PG8_LDB(dst, b, h) do { if constexpr (FP8) { _Pragma("unroll") for (int n = 0; n < 2; ++n) dst##8[n] = PG8_LD32(lds + PG8_SB(b, h) + boff + n * 2048); } \
        else { _Pragma("unroll") for (int n = 0; n < 2; ++n) _Pragma("unroll") for (int k = 0; k < 2; ++k) dst[n][k] = *(const LAS bf16x8*)(lds + PG8_SB(b, h) + boff + n * 2048 + k * 1024); } } while (0)
#define PG8_CAT(x) __builtin_bit_cast(v8i32_t, __builtin_shufflevector(__builtin_bit_cast(u32x4, x[0]), __builtin_bit_cast(u32x4, x[1]), 0, 1, 2, 3, 4, 5, 6, 7))
#define PG8_MMA(ai, bj, At, Bt) do { __builtin_amdgcn_s_setprio(1); \
        if constexpr (FP8) { _Pragma("unroll") for (int m = 0; m < 4; ++m) _Pragma("unroll") for (int n = 0; n < 2; ++n) \
            acc[ai][bj][m][n] = __builtin_amdgcn_mfma_scale_f32_16x16x128_f8f6f4(Bt##8[n], At##8[m], acc[ai][bj][m][n], 0, 0, 0, 0x7f7f7f7f, 0, 0x7f7f7f7f); } \
        else { _Pragma("unroll") for (int m = 0; m < 4; ++m) _Pragma("unroll") for (int n = 0; n < 2; ++n) _Pragma("unroll") for (int k = 0; k < 2; ++k) \
            acc[ai][bj][m][n] = __builtin_amdgcn_mfma_f32_16x16x32_bf16(Bt[n][k], At[m][k], acc[ai][bj][m][n], 0, 0, 0); } \
        __builtin_amdgcn_s_setprio(0); } while (0)
#define PG8_WAIT_V(n) asm volatile("s_waitcnt vmcnt(" #n ")" ::: "memory")
#define PG8_WAIT_L(n) asm volatile("s_waitcnt lgkmcnt(" #n ")" ::: "memory")
#define PG8_BAR __builtin_amdgcn_s_barrier()
#define PG8_SCHED __builtin_amdgcn_sched_barrier(0)
#define PG8_AOFF(dst, u) do { _Pragma("unroll") for (int _h = 0; _h < 2; ++_h) _Pragma("unroll") for (int _i = 0; _i < 2; ++_i) { int _R, _C; stage_rc(tid * 16 + _i * 8192, _R, _C); \
        dst[_h][_i] = S.arow(u, _h * HALF + _R) * (unsigned)(lda * EB) + (unsigned)(_C * 2); } } while (0)
    Unit cur, nxt; int ui = 0;
    if (!S.next(0, cur)) return;
    f32x4 acc[2][2][4][2];
#pragma unroll
    for (int a = 0; a < 2; ++a)
#pragma unroll
        for (int b = 0; b < 2; ++b)
#pragma unroll
            for (int m = 0; m < 4; ++m)
#pragma unroll
                for (int n = 0; n < 2; ++n) acc[a][b][m][n] = (f32x4){0.f, 0.f, 0.f, 0.f};
    bf16x8 At[4][2], B0[2][2], B1[2][2];
    v8i32_t At8[4], B08[2], B18[2];
    unsigned curA[2][2];
    const char* cA = gA;
    if constexpr (GATHER) { PG8_AOFF(curA, cur); }
    else { cA = gA + (size_t)S.arow(cur, 0) * lda * EB; }
#define PG8_STA(bufoff, ptr, h) do { if constexpr (GATHER) { PG8_STAGE(bufoff, ptr, curA[h]); } else { PG8_STAGE(bufoff, (ptr) + (h) * hstepA, voffA); } } while (0)
    const char* cB = S.bbase(cur);
    PG8_STAGE(PG8_SB(0, 0), cB, voffB); PG8_STAGE(PG8_SB(0, 1), cB + hstep, voffB); PG8_STA(PG8_SA(0, 0), cA, 0); PG8_STA(PG8_SA(0, 1), cA, 1);
    if (wr == 1) PG8_BAR;
    PG8_WAIT_V(2); PG8_BAR;
    PG8_STAGE(PG8_SB(1, 0), cB + kstep, voffB); PG8_STA(PG8_SA(1, 0), cA + kstep, 0); PG8_STAGE(PG8_SB(1, 1), cB + hstep + kstep, voffB);
    PG8_WAIT_V(6); PG8_BAR;
    for (;;) {
        if constexpr (Epi::LDSBIAS) {
            cur.par = ui & 1;
            if (wid == 0) { const unsigned long long bp_ = (unsigned long long)(uintptr_t)E.bsrc(cur);
                const char* bsrc_ = (const char*)(uintptr_t)(((unsigned long long)(unsigned)__builtin_amdgcn_readfirstlane((int)(bp_ >> 32)) << 32) | (unsigned)__builtin_amdgcn_readfirstlane((int)bp_));
                unsigned keep_; asm volatile("s_mov_b32 %0, m0\n\ts_mov_b32 m0, %3\n\ts_nop 0\n\tglobal_load_lds_dwordx4 %1, %2\n\ts_mov_b32 m0, %0" : "=&s"(keep_)
                : "v"((unsigned)(lane * 16)), "s"(bsrc_), "s"((unsigned)__builtin_amdgcn_readfirstlane(ldsbase + (unsigned)RT_OFF + (unsigned)cur.par * 1024u)) : "memory"); } }
        const bool has_next = S.next(ui + 1, nxt);
        const char* nB = cB; const char* nA = cA;
        if (has_next) { nB = S.bbase(nxt);
            if constexpr (GATHER) { unsigned na[2][2]; PG8_AOFF(na, nxt); *stash = (u32x4){na[0][0], na[0][1], na[1][0], na[1][1]}; }
            else nA = gA + (size_t)S.arow(nxt, 0) * lda * EB; }
#define PG8_KLOOP(FULL) \
        for (int t = 0; t < nt; t += 2) { \
            if constexpr (HOOK) { if (t == 4 || t == 8) { int fr_ = fr, fq_ = fq; asm volatile("" : "+v"(fr_), "+v"(fq_)); E.hook(acc, cur, t >> 2, wr, wc, fr_, fq_); } } \
            const bool last = (t == nt - 2); \
            const char* a1 = cA + (size_t)(t + 1) * kstep; \
            const char* a2 = last ? nA : cA + (size_t)(t + 2) * kstep; const char* b2 = last ? nB : cB + (size_t)(t + 2) * kstep; \
            const char* a3 = a2 + kstep; const char* b3 = b2 + kstep; \
            PG8_LDB(B0, 0, 0); PG8_LDB(B1, 0, 1); PG8_SCHED; PG8_LDA(At, 0, 0); PG8_STA(PG8_SA(1, 1), a1, 1); \
            if constexpr (GATHER) { if (last && has_next) { const u32x4 na = *stash; curA[0][0] = na.x; curA[0][1] = na.y; curA[1][0] = na.z; curA[1][1] = na.w; } } \
            PG8_WAIT_V(8); PG8_WAIT_L(0); PG8_BAR; PG8_MMA(0, 0, At, B0); PG8_MMA(0, 1, At, B1); PG8_BAR; PG8_SCHED; \
            if (FULL) { PG8_LDA(At, 0, 1); } PG8_STAGE(PG8_SB(0, 0), b2, voffB); PG8_STAGE(PG8_SB(0, 1), b2 + hstep, voffB); PG8_STA(PG8_SA(0, 0), a2, 0); \
            PG8_WAIT_V(8); PG8_WAIT_L(0); PG8_BAR; if (FULL) { PG8_MMA(1, 0, At, B0); PG8_MMA(1, 1, At, B1); } PG8_BAR; PG8_SCHED; \
            PG8_LDB(B0, 1, 0); PG8_LDB(B1, 1, 1); PG8_SCHED; PG8_LDA(At, 1, 0); PG8_STA(PG8_SA(0, 1), a2, 1); \
            PG8_WAIT_V(8); PG8_WAIT_L(0); PG8_BAR; PG8_MMA(0, 0, At, B0); PG8_MMA(0, 1, At, B1); PG8_BAR; PG8_SCHED; \
            if (FULL) { PG8_LDA(At, 1, 1); } PG8_STAGE(PG8_SB(1, 0), b3, voffB); PG8_STAGE(PG8_SB(1, 1), b3 + hstep, voffB); PG8_STA(PG8_SA(1, 0), a3, 0); \
            PG8_WAIT_V(8); PG8_WAIT_L(0); PG8_BAR; if (FULL) { PG8_MMA(1, 0, At, B0); PG8_MMA(1, 1, At, B1); } PG8_BAR; PG8_SCHED; \
        }
        if constexpr (TAILS) { if (cur.half) { PG8_KLOOP(0) } else { PG8_KLOOP(1) } } else { PG8_KLOOP(1) }
#undef PG8_KLOOP
        if constexpr (ALIGN_EPI) { if (wr == 0) PG8_BAR; }
        { int fr_ = fr, fq_ = fq; asm volatile("" : "+v"(fr_), "+v"(fq_)); E(acc, cur, wr, wc, fr_, fq_); }
        if (!has_next) break;
#pragma unroll
        for (int a = 0; a < 2; ++a)
#pragma unroll
            for (int b = 0; b < 2; ++b)
#pragma unroll
                for (int m = 0; m < 4; ++m)
#pragma unroll
                    for (int n = 0; n < 2; ++n) acc[a][b][m][n] = (f32x4){0.f, 0.f, 0.f, 0.f};
        cur = nxt; cB = nB; cA = nA; ++ui;
        if constexpr (ALIGN_EPI) { if (wr == 1) PG8_BAR; }
    }
    PG8_WAIT_V(0);
    if constexpr (!ALIGN_EPI) { if (wr == 0) PG8_BAR; }
    PG8_BAR;
#undef PG8_SA
#undef PG8_SB
#undef PG8_STAGE
#undef PG8_LDA
#undef PG8_LD32
#undef PG8_LDB
#undef PG8_MMA
#undef PG8_CAT
#undef PG8_WAIT_V
#undef PG8_WAIT_L
#undef PG8_BAR
#undef PG8_SCHED
#undef PG8_AOFF
#undef PG8_STA
}

template <bool WT> __device__ __forceinline__ void st16(void* p, const u32x4 v) {
    if constexpr (WT) asm volatile("global_store_dwordx4 %0, %1, off sc1" :: "v"(p), "v"(v) : "memory");
    else *(u32x4*)p = v;
}
template <bool WT> __device__ __forceinline__ void st8(void* p, const u32x2 v) {
    if constexpr (WT) asm volatile("global_store_dwordx2 %0, %1, off sc1" :: "v"(p), "v"(v) : "memory");
    else *(u32x2*)p = v;
}
#ifndef EPI_WT
#define EPI_WT false
#endif
__device__ __forceinline__ u32x4 pack8(const f32x4 a, const f32x4 b) { u32x4 w; w.x = cvt_pk_bf16(a[0], a[1]); w.y = cvt_pk_bf16(a[2], a[3]); w.z = cvt_pk_bf16(b[0], b[1]); w.w = cvt_pk_bf16(b[2], b[3]); return w; }
struct EpiIn {
    static constexpr bool PERM = true; static constexpr bool LDSBIAS = false;
    bf16* proj; bf16* sg; float* la; float* ffl; const float* a_b; const float* fb;
    __device__ __forceinline__ void operator()(const f32x4 (&acc)[2][2][4][2], const Unit& u, int wr, int wc, int fr, int fq) const {
        const int pn = u.pn, rowb = u.pm * BM + wr * 64 + fr, cl0 = wc * 32 + 8 * fq;
        if (pn < 9) {
            bf16* base = proj + (size_t)pn * S * 256; const float sc = (pn == 0 || pn == 3) ? C2 : 1.f;
#pragma unroll
            for (int ai = 0; ai < 2; ++ai)
#pragma unroll
                for (int m = 0; m < 4; ++m) { bf16* rowp = base + (size_t)(rowb + ai * HALF + m * 16) * 256 + cl0;
#pragma unroll
                    for (int bj = 0; bj < 2; ++bj) st16<EPI_WT>(rowp + bj * HALF, pack8(acc[ai][bj][m][0] * sc, acc[ai][bj][m][1] * sc)); }
        } else {
#pragma unroll
            for (int n = 0; n < 2; ++n) { const f32x4 bv = *(const f32x4*)(a_b + cl0 + n * 4);
#pragma unroll
                for (int ai = 0; ai < 2; ++ai)
#pragma unroll
                    for (int m = 0; m < 4; ++m) { const f32x4 v = acc[ai][0][m][n] + bv; f32x4 o;
                        o[0] = logsigmoidf_(v[0]) * 0.0625f; o[1] = logsigmoidf_(v[1]) * 0.0625f; o[2] = logsigmoidf_(v[2]) * 0.0625f; o[3] = logsigmoidf_(v[3]) * 0.0625f;
                        *(f32x4*)(la + (size_t)(rowb + ai * HALF + m * 16) * 128 + cl0 + n * 4) = o; } }
            if (wc == 0 && fq == 0) { const f32x4 bv = *(const f32x4*)fb;
#pragma unroll
                for (int ai = 0; ai < 2; ++ai)
#pragma unroll
                    for (int m = 0; m < 4; ++m) { const f32x4 v = acc[ai][1][m][0] + bv; f32x4 o;
                        o[0] = logsigmoidf_(v[0]); o[1] = logsigmoidf_(v[1]); o[2] = logsigmoidf_(v[2]); o[3] = logsigmoidf_(v[3]);
                        const size_t r_ = (size_t)(rowb + ai * HALF + m * 16); ffl[r_] = o[0]; ffl[S + r_] = o[1]; ffl[2 * (size_t)S + r_] = o[2]; ffl[3 * (size_t)S + r_] = o[3]; } }
        }
    }
};
#define GQ(g_) fmaxf(256.f * (g_), 0.001953125f)
struct EpiGate {
    static constexpr bool PERM = true; static constexpr bool LDSBIAS = false;
    unsigned char* sg;
    __device__ __forceinline__ void operator()(const f32x4 (&acc)[2][2][4][2], const Unit& u, int wr, int wc, int fr, int fq) const {
        unsigned char* base = sg + (size_t)(u.pm * 12 + u.pn) * 65536 + (((wr * 4 + wc) * 64 + fq * 16 + fr) * 16);
        constexpr float KS = -0.03125f * LOG2E;
#pragma unroll
        for (int ai = 0; ai < 2; ++ai)
#pragma unroll
            for (int m = 0; m < 4; ++m) { u32x4 w;
#pragma unroll
                for (int bj = 0; bj < 2; ++bj) { const f32x4 v0 = acc[ai][bj][m][0], v1 = acc[ai][bj][m][1];
                    w[2 * bj]     = cvt4_fp8(GQ(fast_rcp(1.f + fast_exp2(v0[0] * KS))), GQ(fast_rcp(1.f + fast_exp2(v0[1] * KS))), GQ(fast_rcp(1.f + fast_exp2(v0[2] * KS))), GQ(fast_rcp(1.f + fast_exp2(v0[3] * KS))));
                    w[2 * bj + 1] = cvt4_fp8(GQ(fast_rcp(1.f + fast_exp2(v1[0] * KS))), GQ(fast_rcp(1.f + fast_exp2(v1[1] * KS))), GQ(fast_rcp(1.f + fast_exp2(v1[2] * KS))), GQ(fast_rcp(1.f + fast_exp2(v1[3] * KS)))); }
                *(u32x4*)(base + (ai * 4 + m) * 8192) = w; }
    }
};
#undef GQ
struct EpiLift {
    static constexpr bool PERM = true; static constexpr bool LDSBIAS = false;
    const unsigned char* sg; bf16* mrg;
    __device__ __forceinline__ void hook(f32x4 (&acc)[2][2][4][2], const Unit& u, int seg, int wr, int wc, int fr, int fq) const {
        const unsigned char* ta = sg + (size_t)(u.pm * 12 + (seg - 1) * 4 + u.pn) * 65536 + (((wr * 4 + wc) * 64 + fq * 16 + fr) * 16);
        u32x4 ga[2][2], gb[2][2];
#define LIFT_LOAD(buf, ai, mh) do { _Pragma("unroll") for (int mm = 0; mm < 2; ++mm) { const int i_ = (ai) * 4 + (mh) * 2 + mm; ga[buf][mm] = *(const u32x4*)(ta + i_ * 8192); gb[buf][mm] = *(const u32x4*)(ta + 4 * 65536 + i_ * 8192); } } while (0)
#define LIFT_PIN(buf) asm volatile("" : "+v"(ga[buf][0]), "+v"(ga[buf][1]), "+v"(gb[buf][0]), "+v"(gb[buf][1]))
#define LIFT_R4(aw, bw) ({ const f32x2 al_ = __builtin_amdgcn_cvt_pk_f32_fp8((int)(aw), false), ah_ = __builtin_amdgcn_cvt_pk_f32_fp8((int)(aw), true), bl_ = __builtin_amdgcn_cvt_pk_f32_fp8((int)(bw), false), bh_ = __builtin_amdgcn_cvt_pk_f32_fp8((int)(bw), true); \
            (f32x4){al_[0] * fast_rcp(bl_[0]), al_[1] * fast_rcp(bl_[1]), ah_[0] * fast_rcp(bh_[0]), ah_[1] * fast_rcp(bh_[1])}; })
#define LIFT_COMP(buf, ai, mh) do { _Pragma("unroll") for (int mm = 0; mm < 2; ++mm) { const u32x4 a = ga[buf][mm], b = gb[buf][mm]; const int m_ = (mh) * 2 + mm; \
            acc[ai][0][m_][0] *= LIFT_R4(a.x, b.x); acc[ai][0][m_][1] *= LIFT_R4(a.y, b.y); acc[ai][1][m_][0] *= LIFT_R4(a.z, b.z); acc[ai][1][m_][1] *= LIFT_R4(a.w, b.w); } } while (0)
        LIFT_LOAD(0, 0, 0); LIFT_LOAD(1, 0, 1);
        LIFT_PIN(0); LIFT_COMP(0, 0, 0); LIFT_LOAD(0, 1, 0);
        LIFT_PIN(1); LIFT_COMP(1, 0, 1); LIFT_LOAD(1, 1, 1);
        LIFT_PIN(0); LIFT_COMP(0, 1, 0);
        LIFT_PIN(1); LIFT_COMP(1, 1, 1);
#undef LIFT_LOAD
#undef LIFT_PIN
#undef LIFT_R4
#undef LIFT_COMP
    }
    __device__ __forceinline__ void operator()(const f32x4 (&acc)[2][2][4][2], const Unit& u, int wr, int wc, int fr, int fq) const {
        const int rowb = u.pm * BM + wr * 64 + fr, col0 = u.pn * BM + wc * 32 + 8 * fq;
        const unsigned char* tg = sg + (size_t)(u.pm * 12 + 8 + u.pn) * 65536 + (((wr * 4 + wc) * 64 + fq * 16 + fr) * 16);
        u32x4 gw[2][4];
#pragma unroll
        for (int ai = 0; ai < 2; ++ai)
#pragma unroll
            for (int m = 0; m < 4; ++m) gw[ai][m] = *(const u32x4*)(tg + (ai * 4 + m) * 8192);
#pragma unroll
        for (int ai = 0; ai < 2; ++ai) {
            asm volatile("" : "+v"(gw[ai][0]), "+v"(gw[ai][1]), "+v"(gw[ai][2]), "+v"(gw[ai][3]));
#pragma unroll
            for (int m = 0; m < 4; ++m) { const size_t row = (size_t)(rowb + ai * HALF + m * 16);
#pragma unroll
                for (int bj = 0; bj < 2; ++bj) { const unsigned gx = bj ? gw[ai][m].z : gw[ai][m].x, gy = bj ? gw[ai][m].w : gw[ai][m].y;
                    const f32x2 a0 = __builtin_amdgcn_cvt_pk_f32_fp8((int)gx, false), a1 = __builtin_amdgcn_cvt_pk_f32_fp8((int)gx, true), b0 = __builtin_amdgcn_cvt_pk_f32_fp8((int)gy, false), b1 = __builtin_amdgcn_cvt_pk_f32_fp8((int)gy, true);
                    const f32x4 v0 = acc[ai][bj][m][0] * ((f32x4){a0[0], a0[1], a1[0], a1[1]} * 0.00390625f), v1 = acc[ai][bj][m][1] * ((f32x4){b0[0], b0[1], b1[0], b1[1]} * 0.00390625f);
                    st16<EPI_WT>(mrg + row * 1024 + col0 + bj * HALF, pack8(v0, v1)); } } }
    }
};
struct EpiF32 {
    static constexpr int PERM = 3; static constexpr bool LDSBIAS = false;
    bf16* C;
    __device__ __forceinline__ void operator()(const f32x4 (&acc)[2][2][4][2], const Unit& u, int wr, int wc, int fr, int fq) const {
        const int rowb = u.pm * BM + wr * 64 + fr, col0 = u.pn * BM + wc * 64 + 16 * fq;
#pragma unroll
        for (int ai = 0; ai < 2; ++ai)
#pragma unroll
            for (int m = 0; m < 4; ++m) { bf16* rowp = C + (size_t)(rowb + ai * HALF + m * 16) * 1024 + col0;
#pragma unroll
                for (int bj = 0; bj < 2; ++bj) st16<EPI_WT>(rowp + bj * 8, pack8(acc[ai][bj][m][0], acc[ai][bj][m][1])); }
    }
};
struct EpiMoe1 {
    static constexpr bool PERM = true; static constexpr bool LDSBIAS = true;
    unsigned char* act; const float* b_gu; const LAS float* bl;
    __device__ __forceinline__ const float* bsrc(const Unit& u) const { return b_gu + (size_t)u.e * 2048 + u.pn * 256; }
    __device__ __forceinline__ void operator()(const f32x4 (&acc)[2][2][4][2], const Unit& u, int wr, int wc, int fr, int fq) const {
        const int rowb = u.pm * BM + wr * 64 + fr, j0 = u.pn * HALF + wc * 32 + 8 * fq; const LAS float* bb = bl + u.par * 256 + 2 * (wc * 32 + 8 * fq);
        f32x4 bq[4];
#pragma unroll
        for (int q = 0; q < 4; ++q) bq[q] = *(const LAS f32x4*)(bb + 4 * q);
        f32x4 bg[2], bu[2];
#pragma unroll
        for (int n = 0; n < 2; ++n) { bg[n] = (f32x4){bq[2 * n][0], bq[2 * n][2], bq[2 * n + 1][0], bq[2 * n + 1][2]}; bu[n] = (f32x4){bq[2 * n][1], bq[2 * n][3], bq[2 * n + 1][1], bq[2 * n + 1][3]}; }
#pragma unroll
        for (int ai = 0; ai < 2; ++ai) { if (ai == 1 && u.half) break;
#pragma unroll
            for (int m = 0; m < 4; ++m) { u32x2 w;
#pragma unroll
                for (int n = 0; n < 2; ++n) { const f32x4 hg = acc[ai][0][m][n] * 0.03125f + bg[n], hu = acc[ai][1][m][n] * 0.03125f + bu[n]; float o[4];
#pragma unroll
                    for (int i = 0; i < 4; ++i) { const float g = fminf(hg[i], 7.f), uu = fminf(fmaxf(hu[i], -7.f), 7.f); o[i] = (uu + 1.f) * (g * fast_rcp(1.f + fast_exp2(g * (-1.702f * LOG2E)))); }
                    w[n] = cvt4_fp8(o[0], o[1], o[2], o[3]); }
                st8<false>(act + (size_t)(rowb + ai * HALF + m * 16) * 1024 + j0, w); } }
    }
};
struct EpiMoe2 {
    static constexpr int PERM = 3; static constexpr bool LDSBIAS = true;
    bf16* yb; const float* b_dn; const LAS float* bl;
    __device__ __forceinline__ const float* bsrc(const Unit& u) const { return b_dn + (size_t)u.e * 1024 + u.pn * 256; }
    __device__ __forceinline__ void operator()(const f32x4 (&acc)[2][2][4][2], const Unit& u, int wr, int wc, int fr, int fq) const {
        const int rowb = u.pm * BM + wr * 64 + fr, col0 = u.pn * BM + wc * 64 + 16 * fq; const LAS float* bb = bl + u.par * 256 + wc * 64 + 16 * fq;
        f32x4 bva[2][2];
#pragma unroll
        for (int bj = 0; bj < 2; ++bj)
#pragma unroll
            for (int n = 0; n < 2; ++n) bva[bj][n] = *(const LAS f32x4*)(bb + bj * 8 + n * 4) * 16.f;
#define CL8(x_) __builtin_amdgcn_fmed3f((x_), -448.f, 448.f)
#pragma unroll
        for (int ai = 0; ai < 2; ++ai) { if (ai == 1 && u.half) break;
#pragma unroll
            for (int m = 0; m < 4; ++m) { u32x4 w;
#pragma unroll
                for (int bj = 0; bj < 2; ++bj)
#pragma unroll
                    for (int n = 0; n < 2; ++n) { const f32x4 y = acc[ai][bj][m][n] * 0.25f + bva[bj][n]; w[2 * bj + n] = cvt4_fp8(CL8(y[0]), CL8(y[1]), CL8(y[2]), CL8(y[3])); }
                *(u32x4*)((unsigned char*)yb + (size_t)(rowb + ai * HALF + m * 16) * 1024 + col0) = w; } }
#undef CL8
    }
};
}

#define XB_TMO      128
#define XB_XCNT(j)  (256  + 64 * (j))
#define XB_XSUB(j)  (1280 + 64 * (j))
#define XB_XGEN(j)  (2304 + 64 * (j))
#define XB_TOP      3328
#define XB_TOPGEN   3392
#define XCD_BAR_WORDS 3456
#define XB_SPIN_CAP (1u << 22)
__device__ __forceinline__ unsigned xb_ld(unsigned* p)              { return __hip_atomic_load(p, __ATOMIC_RELAXED, __HIP_MEMORY_SCOPE_AGENT); }
__device__ __forceinline__ unsigned xb_add(unsigned* p, unsigned v) { return __hip_atomic_fetch_add(p, v, __ATOMIC_RELAXED, __HIP_MEMORY_SCOPE_AGENT); }
__device__ __forceinline__ unsigned xb_xcc_id() { return (unsigned)__builtin_amdgcn_s_getreg((3 << 11) | 20) & 0xFu; }
#define XB_SPIN(cond, bar) do { unsigned _sp = 0; while (cond) { __builtin_amdgcn_s_sleep(1); \
    if ((++_sp & 255u) == 0u) { if (xb_ld(&(bar)[XB_TMO])) break; if (_sp > XB_SPIN_CAP) { atomicAdd(&(bar)[XB_TMO], 1u); break; } } } } while (0)
struct XcdBarrier { unsigned* bar; unsigned x; volatile LAS unsigned* st; };
__device__ __forceinline__ XcdBarrier xcd_barrier_post(unsigned* bar, volatile LAS unsigned* st, const bool t0) {
    XcdBarrier b; b.bar = bar; b.x = xb_xcc_id(); b.st = st;
    if (t0) (void)xb_add(&bar[XB_XCNT(b.x)], 1u);
    return b;
}
__device__ __forceinline__ void xcd_barrier_complete(unsigned* bar, unsigned x, unsigned& nloc, unsigned& nx) {
    const unsigned G = gridDim.x * gridDim.y * gridDim.z;
    unsigned sum, cnt, mine, sp = 0u;
    for (;;) {
        sum = 0u; cnt = 0u; mine = 0u;
#pragma unroll
        for (unsigned j = 0; j < 16; ++j) { const unsigned c = xb_ld(&bar[XB_XCNT(j)]); sum += c; cnt += (c > 0u) ? 1u : 0u; mine = (j == x) ? c : mine; }
        if (sum == G) break;
        __builtin_amdgcn_s_sleep(1);
        if ((++sp & 255u) == 0u) { if (xb_ld(&bar[XB_TMO])) break; if (sp > XB_SPIN_CAP) { atomicAdd(&bar[XB_TMO], 1u); break; } }
    }
    nloc = mine > 0u ? mine : 1u; nx = cnt > 0u ? cnt : 1u;
}
__device__ __forceinline__ void xcd_barrier(const XcdBarrier& b, const bool t0) {
    asm volatile("s_waitcnt vmcnt(0)" ::: "memory");
    __syncthreads();
    if (t0) {
        unsigned* bar = b.bar;
        __builtin_amdgcn_s_waitcnt(0);
        unsigned nloc = b.st[0], nx = b.st[1];
        if (nloc == 0u) { xcd_barrier_complete(bar, b.x, nloc, nx); b.st[0] = nloc; b.st[1] = nx; }
        const unsigned old = xb_add(&bar[XB_XSUB(b.x)], 1u);
        const unsigned gen = old / nloc;
        if (old + 1u == (gen + 1u) * nloc) {
            __builtin_amdgcn_fence(__ATOMIC_RELEASE, "agent");
            asm volatile("s_waitcnt vmcnt(0)" ::: "memory");
            const unsigned og = xb_add(&bar[XB_TOP], 1u);
            const unsigned tg = og / nx;
            if (og + 1u == (tg + 1u) * nx) xb_add(&bar[XB_TOPGEN], 1u);
            else XB_SPIN(xb_ld(&bar[XB_TOPGEN]) == tg, bar);
            __builtin_amdgcn_fence(__ATOMIC_ACQUIRE, "agent");
            xb_add(&bar[XB_XGEN(b.x)], 1u);
            asm volatile("s_waitcnt vmcnt(0)" ::: "memory");
        } else {
            XB_SPIN(xb_ld(&bar[XB_XGEN(b.x)]) == gen, bar);
            __builtin_amdgcn_fence(__ATOMIC_ACQUIRE, "agent");
            asm volatile("s_waitcnt vmcnt(0)" ::: "memory");
        }
    }
    __syncthreads();
}

struct MapGate { __device__ __forceinline__ int operator()(int c) const { return c >= 2324 ? c - 2324 : -1; } };
struct MapIdent { __device__ __forceinline__ int operator()(int c) const { return c; } };
struct MapGU { __device__ __forceinline__ int operator()(int c) const { const int j = c >> 1, up = c & 1; return ((j >> 7) << 8) + (up << 7) + (j & 127); } };
struct MapIn { __device__ __forceinline__ int operator()(int c) const {
    if (c < 768) return c;
    if (c < 772) return 2432 + (c - 768);
    if (c < 1028) return 1536 + (c - 772);
    if (c < 1284) return 1792 + (c - 1028);
    if (c < 1300) return -1;
    if (c < 1556) return 2048 + (c - 1300);
    if (c < 2324) return 768 + (c - 1556);
    return -1;
} };
template <class RowMap>
__device__ __forceinline__ void transpose_item_fp8(const float* W, int K, int N, unsigned char* WT, LAS float* scr, int item, int lane, RowMap rm, float sc) {
    const int nblk = (N + 31) / 32, kb = item / nblk, nb = item % nblk, k0 = 64 * kb, n0 = 32 * nb;
    const int nn = n0 + (lane & 31);
#pragma unroll 32
    for (int i = 0; i < 32; ++i) { const int kk = 2 * i + (lane >> 5); scr[kk * 33 + (lane & 31)] = nn < N ? W[(size_t)(k0 + kk) * N + nn] : 0.f; }
    asm volatile("s_waitcnt lgkmcnt(0)" ::: "memory");
    const int c = lane & 7;
#pragma unroll
    for (int j = 0; j < 4; ++j) { const int n = (lane >> 3) + 8 * j; const LAS float* s = scr + (8 * c) * 33 + n;
        const int row = (n0 + n < N) ? rm(n0 + n) : -1;
        if (row >= 0) { u32x2 o; o.x = cvt4_fp8(s[0 * 33] * sc, s[1 * 33] * sc, s[2 * 33] * sc, s[3 * 33] * sc); o.y = cvt4_fp8(s[4 * 33] * sc, s[5 * 33] * sc, s[6 * 33] * sc, s[7 * 33] * sc);
            *(u32x2*)(WT + (size_t)row * K + k0 + 8 * c) = o; } }
    asm volatile("s_waitcnt lgkmcnt(0)" ::: "memory");
}
template <class RowMap>
__device__ __forceinline__ void convert_item_fp8(const float* W, int K, int N, unsigned char* WT, LAS unsigned char* scr, int item, int lane, RowMap rm, float sc) {
    const int nblk = N / 64, kb = item / nblk, nb = item % nblk, k0 = 128 * kb, n0 = 64 * nb;
    const float* src = W + (size_t)k0 * N + n0 + lane;
    float v[128];
#pragma unroll
    for (int i = 0; i < 128; ++i) v[i] = src[(size_t)i * N];
#pragma unroll
    for (int g = 0; g < 8; ++g)
        asm volatile("" : "+v"(v[g * 16 + 0]), "+v"(v[g * 16 + 1]), "+v"(v[g * 16 + 2]), "+v"(v[g * 16 + 3]), "+v"(v[g * 16 + 4]), "+v"(v[g * 16 + 5]), "+v"(v[g * 16 + 6]), "+v"(v[g * 16 + 7]),
                          "+v"(v[g * 16 + 8]), "+v"(v[g * 16 + 9]), "+v"(v[g * 16 + 10]), "+v"(v[g * 16 + 11]), "+v"(v[g * 16 + 12]), "+v"(v[g * 16 + 13]), "+v"(v[g * 16 + 14]), "+v"(v[g * 16 + 15]));
    LAS unsigned char* mine = scr + lane * 144;
#pragma unroll
    for (int q = 0; q < 8; ++q) { u32x4 o;
        o.x = cvt4_fp8(v[q * 16 + 0] * sc, v[q * 16 + 1] * sc, v[q * 16 + 2] * sc, v[q * 16 + 3] * sc); o.y = cvt4_fp8(v[q * 16 + 4] * sc, v[q * 16 + 5] * sc, v[q * 16 + 6] * sc, v[q * 16 + 7] * sc);
        o.z = cvt4_fp8(v[q * 16 + 8] * sc, v[q * 16 + 9] * sc, v[q * 16 + 10] * sc, v[q * 16 + 11] * sc); o.w = cvt4_fp8(v[q * 16 + 12] * sc, v[q * 16 + 13] * sc, v[q * 16 + 14] * sc, v[q * 16 + 15] * sc);
        *(LAS u32x4*)(mine + q * 16) = o; }
    asm volatile("s_waitcnt lgkmcnt(0)" ::: "memory");
    const int rsub = lane >> 3, ch = lane & 7;
#pragma unroll
    for (int i = 0; i < 8; ++i) { const int n = i * 8 + rsub; const u32x4 o = *(const LAS u32x4*)(scr + n * 144 + ch * 16);
        *(u32x4*)(WT + (size_t)rm(n0 + n) * K + k0 + ch * 16) = o; }
    asm volatile("s_waitcnt lgkmcnt(0)" ::: "memory");
}
template <class RowMap>
__device__ __forceinline__ void transpose_item(const float* W, int K, int N, bf16* WT, LAS float* scr, int item, int lane, RowMap rm, int ldk = 0) {
    if (ldk == 0) ldk = K;
    const int nblk = (N + 31) / 32, kb = item / nblk, nb = item % nblk, k0 = 64 * kb, n0 = 32 * nb;
    const int nn = n0 + (lane & 31);
#pragma unroll 32
    for (int i = 0; i < 32; ++i) { const int kk = 2 * i + (lane >> 5); scr[kk * 33 + (lane & 31)] = nn < N ? W[(size_t)(k0 + kk) * N + nn] : 0.f; }
    asm volatile("s_waitcnt lgkmcnt(0)" ::: "memory");
    const int c = lane & 7;
#pragma unroll
    for (int j = 0; j < 4; ++j) { const int n = (lane >> 3) + 8 * j; const LAS float* s = scr + (8 * c) * 33 + n;
        const int row = (n0 + n < N) ? rm(n0 + n) : -1;
        if (row >= 0) { u32x4 o; o.x = cvt_pk_bf16(s[0 * 33], s[1 * 33]); o.y = cvt_pk_bf16(s[2 * 33], s[3 * 33]); o.z = cvt_pk_bf16(s[4 * 33], s[5 * 33]); o.w = cvt_pk_bf16(s[6 * 33], s[7 * 33]);
            *(u32x4*)(WT + (size_t)row * ldk + k0 + 8 * c) = o; } }
    asm volatile("s_waitcnt lgkmcnt(0)" ::: "memory");
}

__device__ __forceinline__ void transpose_item_win(const float* W, bf16* WT, unsigned char* WT8, LAS float* scr, int item, int lane) {
    const int K = 1024, N = D_IN; const int nblk = (N + 31) / 32, kb = item / nblk, nb = item % nblk, k0 = 64 * kb, n0 = 32 * nb;
    const int nn = n0 + (lane & 31);
#pragma unroll 32
    for (int i = 0; i < 32; ++i) { const int kk = 2 * i + (lane >> 5); scr[kk * 33 + (lane & 31)] = nn < N ? W[(size_t)(k0 + kk) * N + nn] : 0.f; }
    asm volatile("s_waitcnt lgkmcnt(0)" ::: "memory");
    const int c = lane & 7;
#pragma unroll
    for (int j = 0; j < 4; ++j) { const int n = (lane >> 3) + 8 * j; const LAS float* s = scr + (8 * c) * 33 + n;
        const int row = (n0 + n < N) ? MapIn()(n0 + n) : -1, row8 = (n0 + n < N) ? MapGate()(n0 + n) : -1;
        if (row >= 0) { u32x4 o; o.x = cvt_pk_bf16(s[0 * 33], s[1 * 33]); o.y = cvt_pk_bf16(s[2 * 33], s[3 * 33]); o.z = cvt_pk_bf16(s[4 * 33], s[5 * 33]); o.w = cvt_pk_bf16(s[6 * 33], s[7 * 33]);
            *(u32x4*)(WT + (size_t)row * K + k0 + 8 * c) = o; }
        if (row8 >= 0) { u32x2 o; o.x = cvt4_fp8(s[0 * 33] * 32.f, s[1 * 33] * 32.f, s[2 * 33] * 32.f, s[3 * 33] * 32.f); o.y = cvt4_fp8(s[4 * 33] * 32.f, s[5 * 33] * 32.f, s[6 * 33] * 32.f, s[7 * 33] * 32.f);
            *(u32x2*)(WT8 + (size_t)row8 * K + k0 + 8 * c) = o; } }
    asm volatile("s_waitcnt lgkmcnt(0)" ::: "memory");
}

struct Args { const float* in[18]; float* out; unsigned char* ws; int ph_lo, ph_hi; };

#define CAS __attribute__((address_space(4)))
#define KARG_IN(kp, i) (*(const float* const CAS*)((kp) + 8 * (i)))
#define KARG_OUT(kp) (*(float* const CAS*)((kp) + 144))
#define KARG_WS(kp) (*(unsigned char* const CAS*)((kp) + 152))
__device__ __forceinline__ void p0_prologue(const CAS unsigned char* kp, LAS unsigned char* lds, int vcu, int G, int tid) {
    const int lane = tid & 63, wave = tid >> 6;
    LAS float* scr = (LAS float*)(lds + wave * 16384);
    unsigned char* ws = KARG_WS(kp);
    const int gw = vcu * 8 + wave, NGW = G * 8;
    constexpr int I_IN = 16 * 169, I_BR = 4 * 32, I_OUT = 16 * 32, I_GU = 8 * 32, I_DN = 8 * 16;
    constexpr int PER_L = I_IN + 3 * I_BR + I_OUT + 32 * I_GU + 32 * I_DN;
    for (int it = gw; it < DEPTH * PER_L; it += NGW) {
        const int l = it / PER_L; int r = it % PER_L;
        if (r < I_IN) { transpose_item_win(KARG_IN(kp, 1) + (size_t)l * 1024 * D_IN, (bf16*)(ws + WS_WIN) + (size_t)l * NIN * 1024, (unsigned char*)(ws + WS_WIN8) + (size_t)l * 3072 * 1024, scr, r, lane); continue; } r -= I_IN;
        if (r < 3 * I_BR) { const int nb = r / I_BR; transpose_item(KARG_IN(kp, 6) + ((size_t)l * 3 + nb) * 256 * 1024, 256, 1024, (bf16*)(ws + WS_WBR) + (size_t)l * 1024 * 768 + nb * 256, scr, r % I_BR, lane, MapIdent(), 768); continue; } r -= 3 * I_BR;
        if (r < I_OUT) { transpose_item(KARG_IN(kp, 7) + (size_t)l * 1024 * 1024, 1024, 1024, (bf16*)(ws + WS_WOUT) + (size_t)l * 1024 * 1024, scr, r, lane, MapIdent()); continue; } r -= I_OUT;
        if (r < 32 * I_GU) { const int e = r / I_GU; convert_item_fp8(KARG_IN(kp, 12) + ((size_t)l * 32 + e) * 1024 * 2048, 1024, 2048, (unsigned char*)(ws + WS_WGU) + ((size_t)l * 32 + e) * 2048 * 1024, (LAS unsigned char*)scr, r % I_GU, lane, MapGU(), 32.f); continue; } r -= 32 * I_GU;
        { const int e = r / I_DN; convert_item_fp8(KARG_IN(kp, 14) + ((size_t)l * 32 + e) * 1024 * 1024, 1024, 1024, (unsigned char*)(ws + WS_WDN) + ((size_t)l * 32 + e) * 1024 * 1024, (LAS unsigned char*)scr, r % I_DN, lane, MapIdent(), 64.f); }
    }
    const int gt = vcu * 512 + tid, NT = G * 512;
    for (int i = gt; i < DEPTH * 128 * 1024; i += NT) { const int l = i >> 17, j = (i >> 10) & 127, k = i & 1023;
        const float* wr_ = KARG_IN(kp, 1) + ((size_t)l * 1024 + k) * D_IN + 1284; const float* au = KARG_IN(kp, 3) + (size_t)l * 16 * 128 + j; float s = 0.f;
#pragma unroll
        for (int r = 0; r < 16; ++r) s += wr_[r] * au[r * 128];
        ((bf16*)(ws + WS_WIN))[((size_t)l * NIN + 2304 + j) * 1024 + k] = (bf16)(cvt_pk_bf16(s, 0.f) & 0xffffu); }
    for (int i = gt; i < DEPTH * 124 * 1024 / 8; i += NT) { const int l = i / (124 * 128), rr = i % (124 * 128);
        *(u32x4*)((bf16*)(ws + WS_WIN) + ((size_t)l * NIN + 2436) * 1024 + (size_t)rr * 8) = (u32x4){0u, 0u, 0u, 0u}; }
    for (int i = gt; i < DEPTH * 32 * 1024; i += NT) { const int l = i >> 15, e = (i >> 10) & 31, k = i & 1023; const float w = KARG_IN(kp, 10)[((size_t)l * 1024 + k) * 32 + e];
        const unsigned hb = cvt_pk_bf16(w, 0.f) & 0xffffu; const float rem = w - __uint_as_float(hb << 16); const unsigned lb = cvt_pk_bf16(rem, 0.f) & 0xffffu;
        bf16* wt = (bf16*)(ws + WS_WRT) + (size_t)l * 65536; wt[e * 1024 + k] = (bf16)hb; wt[32768 + e * 1024 + k] = (bf16)lb; }
    for (int i = gt; i < S * D / 8; i += NT) { const f32x4 v0 = *(const f32x4*)(KARG_IN(kp, 0) + (size_t)i * 8), v1 = *(const f32x4*)(KARG_IN(kp, 0) + (size_t)i * 8 + 4);
        u32x4 o; o.x = cvt_pk_bf16(v0[0], v0[1]); o.y = cvt_pk_bf16(v0[2], v0[3]); o.z = cvt_pk_bf16(v1[0], v1[1]); o.w = cvt_pk_bf16(v1[2], v1[3]);
        *(u32x4*)((bf16*)(ws + WS_XB) + (size_t)i * 8) = o;
        u32x2 o8; o8.x = cvt4_fp8(v0[0], v0[1], v0[2], v0[3]); o8.y = cvt4_fp8(v1[0], v1[1], v1[2], v1[3]); *(u32x2*)((unsigned char*)(ws + WS_XB8) + (size_t)i * 8) = o8; }
}

__device__ __forceinline__ void gla_cumsum(LAS float* bb, LAS float* scn, int tid) {
    const int k = tid & 31, seg = (tid >> 5) & 7; float loc[8]; float run = 0.f;
    if (tid < 256) {
#pragma unroll
        for (int i = 0; i < 8; ++i) { run += bb[(seg * 8 + i) * 32 + k]; loc[i] = run; }
        scn[seg * 32 + k] = run; }
    __syncthreads();
    if (tid < 256) { float pre = 0.f;
#pragma unroll
        for (int s2 = 0; s2 < 7; ++s2) pre += (s2 < seg) ? scn[s2 * 32 + k] : 0.f;
#pragma unroll
        for (int i = 0; i < 8; ++i) bb[(seg * 8 + i) * 32 + k] = loc[i] + pre; }
    __syncthreads();
}
__device__ __forceinline__ void gla_local_unit(LAS unsigned char* lds, int tid, int ci, int h, const bf16* GQK, const bf16* GV, const float* LAp, float* U, float* DEC) {
    LAS float* kb = (LAS float*)lds;
    LAS float* vb = kb + 64 * 33;
    LAS float* bb = vb + 64 * 64;
    LAS float* scn = bb + 64 * 32;
    const int t0 = ci * 64; const int r = tid >> 3;
    { const int c4 = (tid & 7) * 4; const u32x2 w = *(const u32x2*)(GQK + (size_t)(t0 + r) * 256 + 128 + h * 32 + c4);
      kb[r * 33 + c4 + 0] = bf_lo(w.x); kb[r * 33 + c4 + 1] = bf_hi(w.x); kb[r * 33 + c4 + 2] = bf_lo(w.y); kb[r * 33 + c4 + 3] = bf_hi(w.y);
      const f32x4 a = *(const f32x4*)(LAp + (size_t)(t0 + r) * 128 + h * 32 + c4); *(LAS f32x4*)(bb + r * 32 + c4) = a; }
    { const int c8 = (tid & 7) * 8; const u32x4 w = *(const u32x4*)(GV + (size_t)(t0 + r) * 256 + h * 64 + c8);
      *(LAS f32x4*)(vb + r * 64 + c8) = (f32x4){bf_lo(w.x), bf_hi(w.x), bf_lo(w.y), bf_hi(w.y)}; *(LAS f32x4*)(vb + r * 64 + c8 + 4) = (f32x4){bf_lo(w.z), bf_hi(w.z), bf_lo(w.w), bf_hi(w.w)}; }
    __syncthreads();
    gla_cumsum(bb, scn, tid);
    for (int idx = tid; idx < 2048; idx += 512) { const int c = idx >> 5, k = idx & 31; kb[c * 33 + k] *= __expf(bb[63 * 32 + k] - bb[c * 32 + k]); }
    __syncthreads();
    { const int k = tid >> 4, v0 = (tid & 15) * 4; f32x4 acc = (f32x4){0.f, 0.f, 0.f, 0.f};
#pragma unroll 8
      for (int c = 0; c < 64; ++c) { const float kk = kb[c * 33 + k]; const f32x4 vv = *(const LAS f32x4*)(vb + c * 64 + v0); acc += vv * kk; }
      *(f32x4*)(U + ((size_t)(ci * 4 + h) * 32 + k) * 64 + v0) = acc; }
    if (tid < 32) DEC[(ci * 4 + h) * 32 + tid] = __expf(bb[63 * 32 + tid]);
    __syncthreads();
}
__device__ __forceinline__ void gla_out_unit(LAS unsigned char* lds, int tid, int ci, int h, const bf16* GQK, const bf16* GV, const bf16* GR, const float* LAp, const float* SST, const float* ng, bf16* Y) {
    LAS float* qb = (LAS float*)lds;
    LAS float* kb = qb + 64 * 33;
    LAS float* vb = kb + 64 * 33;
    LAS float* bb = vb + 64 * 64;
    LAS float* Ab = bb + 64 * 32;
    LAS float* Sb = Ab + 64 * 65;
    LAS float* scn = Sb + 32 * 64;
    const int t0 = ci * 64; const int r = tid >> 3;
    { const int c4 = (tid & 7) * 4; const u32x2 wq = *(const u32x2*)(GQK + (size_t)(t0 + r) * 256 + h * 32 + c4); const u32x2 wk = *(const u32x2*)(GQK + (size_t)(t0 + r) * 256 + 128 + h * 32 + c4);
      qb[r * 33 + c4 + 0] = bf_lo(wq.x); qb[r * 33 + c4 + 1] = bf_hi(wq.x); qb[r * 33 + c4 + 2] = bf_lo(wq.y); qb[r * 33 + c4 + 3] = bf_hi(wq.y);
      kb[r * 33 + c4 + 0] = bf_lo(wk.x); kb[r * 33 + c4 + 1] = bf_hi(wk.x); kb[r * 33 + c4 + 2] = bf_lo(wk.y); kb[r * 33 + c4 + 3] = bf_hi(wk.y);
      const f32x4 a = *(const f32x4*)(LAp + (size_t)(t0 + r) * 128 + h * 32 + c4); *(LAS f32x4*)(bb + r * 32 + c4) = a; }
    { const int c8 = (tid & 7) * 8; const u32x4 w = *(const u32x4*)(GV + (size_t)(t0 + r) * 256 + h * 64 + c8);
      *(LAS f32x4*)(vb + r * 64 + c8) = (f32x4){bf_lo(w.x), bf_hi(w.x), bf_lo(w.y), bf_hi(w.y)}; *(LAS f32x4*)(vb + r * 64 + c8 + 4) = (f32x4){bf_lo(w.z), bf_hi(w.z), bf_lo(w.w), bf_hi(w.w)}; }
    { const f32x4 s4 = *(const f32x4*)(SST + (size_t)(ci * 4 + h) * 2048 + tid * 4); *(LAS f32x4*)(Sb + tid * 4) = s4; }
    __syncthreads();
    gla_cumsum(bb, scn, tid);
    for (int idx = tid; idx < 2048; idx += 512) { const int c = idx >> 5, k = idx & 31; const float b = bb[c * 32 + k];
        qb[c * 33 + k] *= 0.17677669529663687f * __expf(b); kb[c * 33 + k] *= __expf(-b); }
    __syncthreads();
    { const int t = tid >> 3, s0 = (tid & 7) * 8; float a[8];
#pragma unroll
      for (int i = 0; i < 8; ++i) a[i] = 0.f;
      for (int k = 0; k < 32; ++k) { const float qv = qb[t * 33 + k];
#pragma unroll
          for (int i = 0; i < 8; ++i) a[i] += qv * kb[(s0 + i) * 33 + k]; }
#pragma unroll
      for (int i = 0; i < 8; ++i) Ab[t * 65 + s0 + i] = (s0 + i <= t) ? a[i] : 0.f; }
    __syncthreads();
    { const int t = tid >> 3, v0 = (tid & 7) * 8; f32x4 o0 = (f32x4){0.f, 0.f, 0.f, 0.f}, o1 = o0;
      for (int s = 0; s < 64; ++s) { const float av = Ab[t * 65 + s]; o0 += *(const LAS f32x4*)(vb + s * 64 + v0) * av; o1 += *(const LAS f32x4*)(vb + s * 64 + v0 + 4) * av; }
      for (int k = 0; k < 32; ++k) { const float qv = qb[t * 33 + k]; o0 += *(const LAS f32x4*)(Sb + k * 64 + v0) * qv; o1 += *(const LAS f32x4*)(Sb + k * 64 + v0 + 4) * qv; }
      float ss = o0[0] * o0[0] + o0[1] * o0[1] + o0[2] * o0[2] + o0[3] * o0[3] + o1[0] * o1[0] + o1[1] * o1[1] + o1[2] * o1[2] + o1[3] * o1[3];
      ss += shx(ss, 1); ss += shx(ss, 2); ss += shx(ss, 4);
      const float rinv = 1.0f / sqrtf(ss * (1.f / 64.f) + RMS_EPS);
      const size_t tok = (size_t)(t0 + t); const u32x4 gw = *(const u32x4*)(GR + tok * 256 + h * 64 + v0);
      const f32x4 g0 = *(const f32x4*)(ng + h * 64 + v0), g1 = *(const f32x4*)(ng + h * 64 + v0 + 4);
      float gr[8] = {bf_lo(gw.x), bf_hi(gw.x), bf_lo(gw.y), bf_hi(gw.y), bf_lo(gw.z), bf_hi(gw.z), bf_lo(gw.w), bf_hi(gw.w)}; float y[8];
#pragma unroll
      for (int i = 0; i < 4; ++i) { y[i] = o0[i] * rinv * g0[i] * (gr[i] * sigmoidf_(gr[i])); y[4 + i] = o1[i] * rinv * g1[i] * (gr[4 + i] * sigmoidf_(gr[4 + i])); }
      u32x4 w; w.x = cvt_pk_bf16(y[0], y[1]); w.y = cvt_pk_bf16(y[2], y[3]); w.z = cvt_pk_bf16(y[4], y[5]); w.w = cvt_pk_bf16(y[6], y[7]);
      *(u32x4*)(Y + tok * 768 + h * 64 + v0) = w; }
    __syncthreads();
}


typedef float f32x16g __attribute__((ext_vector_type(16)));
__device__ __forceinline__ bf16x8 pack8(const float* x) { u32x4 w; w.x = cvt_pk_bf16(x[0], x[1]); w.y = cvt_pk_bf16(x[2], x[3]); w.z = cvt_pk_bf16(x[4], x[5]); w.w = cvt_pk_bf16(x[6], x[7]); return __builtin_bit_cast(bf16x8, w); }
__device__ __forceinline__ void gla_wave_cumsum(const float* LAp, size_t tok, int h, int lane, float (&b)[32]) {
#pragma unroll
    for (int j = 0; j < 8; ++j) { const f32x4 a = *(const f32x4*)(LAp + tok * 128 + h * 32 + j * 4); b[j * 4] = a[0]; b[j * 4 + 1] = a[1]; b[j * 4 + 2] = a[2]; b[j * 4 + 3] = a[3]; }
#pragma unroll
    for (int o = 1; o < 64; o <<= 1) {
#pragma unroll
        for (int k = 0; k < 32; ++k) { const float y = shu(b[k], o); b[k] += (lane >= o) ? y : 0.f; } }
}
__device__ __forceinline__ void load32bf(const bf16* p, float (&x)[32]) {
#pragma unroll
    for (int j = 0; j < 4; ++j) { const u32x4 w = *(const u32x4*)(p + j * 8); x[j * 8] = bf_lo(w.x); x[j * 8 + 1] = bf_hi(w.x); x[j * 8 + 2] = bf_lo(w.y); x[j * 8 + 3] = bf_hi(w.y); x[j * 8 + 4] = bf_lo(w.z); x[j * 8 + 5] = bf_hi(w.z); x[j * 8 + 6] = bf_lo(w.w); x[j * 8 + 7] = bf_hi(w.w); }
}
__device__ __forceinline__ void gla_stage_vt(LAS unsigned char* wl, const bf16* GV, size_t tok, int h, int lane) {
    u32x4 w[8];
#pragma unroll
    for (int j = 0; j < 8; ++j) w[j] = *(const u32x4*)(GV + tok * 256 + h * 64 + j * 8);
    asm volatile("" : "+v"(w[0]), "+v"(w[1]), "+v"(w[2]), "+v"(w[3]), "+v"(w[4]), "+v"(w[5]), "+v"(w[6]), "+v"(w[7]));
#pragma unroll
    for (int j = 0; j < 8; ++j) { const unsigned ww[4] = {w[j].x, w[j].y, w[j].z, w[j].w};
#pragma unroll
        for (int e = 0; e < 4; ++e) { *(LAS bf16*)(wl + 8192 + (j * 8 + 2 * e) * 128 + lane * 2) = (bf16)(ww[e] & 0xffffu); *(LAS bf16*)(wl + 8192 + (j * 8 + 2 * e + 1) * 128 + lane * 2) = (bf16)(ww[e] >> 16); } }
}
__device__ __forceinline__ void gla_local_wave(LAS unsigned char* wl, int lane, int ci, int h, const bf16* GQK, const bf16* GV, const float* LAp, float* U, float* DEC) {
    const size_t tok = (size_t)ci * 64 + lane; const int r32 = lane & 31, hi = lane >> 5;
    float b[32]; gla_wave_cumsum(LAp, tok, h, lane, b);
    float kx[32]; load32bf(GQK + tok * 256 + 128 + h * 32, kx);
    float myl = 0.f;
#pragma unroll
    for (int k = 0; k < 32; ++k) { const float bl = __uint_as_float((unsigned)__builtin_amdgcn_readlane((int)__float_as_uint(b[k]), 63)); kx[k] *= __expf(bl - b[k]); myl = (lane == k) ? bl : myl;
        *(LAS bf16*)(wl + k * 128 + lane * 2) = (bf16)(cvt_pk_bf16(kx[k], 0.f) & 0xffffu); }
    if (lane < 32) DEC[(ci * 4 + h) * 32 + lane] = __expf(myl);
    gla_stage_vt(wl, GV, tok, h, lane);
    asm volatile("s_waitcnt lgkmcnt(0)" ::: "memory");
    f32x16g u0 = {}, u1 = {};
#pragma unroll
    for (int st = 0; st < 4; ++st) { const bf16x8 ka = *(const LAS bf16x8*)(wl + r32 * 128 + (8 * hi + 16 * st) * 2);
        const bf16x8 v0 = *(const LAS bf16x8*)(wl + 8192 + r32 * 128 + (8 * hi + 16 * st) * 2), v1 = *(const LAS bf16x8*)(wl + 8192 + (r32 + 32) * 128 + (8 * hi + 16 * st) * 2);
        u0 = __builtin_amdgcn_mfma_f32_32x32x16_bf16(ka, v0, u0, 0, 0, 0); u1 = __builtin_amdgcn_mfma_f32_32x32x16_bf16(ka, v1, u1, 0, 0, 0); }
    float* up = U + (size_t)(ci * 4 + h) * 2048;
#pragma unroll
    for (int r = 0; r < 16; ++r) { const int k = (r & 3) + 8 * (r >> 2) + 4 * hi; up[k * 64 + r32] = u0[r]; up[k * 64 + 32 + r32] = u1[r]; }
    asm volatile("s_waitcnt lgkmcnt(0)" ::: "memory");
}
__device__ __forceinline__ void gla_out_wave(LAS unsigned char* wl, int lane, int ci, int h, const bf16* GQK, const bf16* GV, const bf16* GR, const float* LAp, const float* SST, const float* ng, bf16* Y) {
    const size_t tok = (size_t)ci * 64 + lane; const int r32 = lane & 31, hi = lane >> 5;
    { float b[32]; gla_wave_cumsum(LAp, tok, h, lane, b);
      float qx[32], kx[32]; load32bf(GQK + tok * 256 + h * 32, qx); load32bf(GQK + tok * 256 + 128 + h * 32, kx);
#pragma unroll
      for (int k = 0; k < 32; ++k) { const float eb = __expf(b[k]); qx[k] *= 0.17677669529663687f * eb; kx[k] *= fast_rcp(eb); }
#pragma unroll
      for (int j = 0; j < 4; ++j) { *(LAS bf16x8*)(wl + lane * 64 + j * 16) = pack8(qx + j * 8); *(LAS bf16x8*)(wl + 4096 + lane * 64 + j * 16) = pack8(kx + j * 8); } }
    gla_stage_vt(wl, GV, tok, h, lane);
    asm volatile("s_waitcnt lgkmcnt(0)" ::: "memory");
    bf16x8 qf[2][2], kf[2][2];
#pragma unroll
    for (int tb = 0; tb < 2; ++tb)
#pragma unroll
        for (int st = 0; st < 2; ++st) { qf[tb][st] = *(const LAS bf16x8*)(wl + (r32 + 32 * tb) * 64 + (8 * hi + 16 * st) * 2); kf[tb][st] = *(const LAS bf16x8*)(wl + 4096 + (r32 + 32 * tb) * 64 + (8 * hi + 16 * st) * 2); }
    f32x16g a00 = {}, a01 = {}, a11 = {};
#pragma unroll
    for (int st = 0; st < 2; ++st) { a00 = __builtin_amdgcn_mfma_f32_32x32x16_bf16(kf[0][st], qf[0][st], a00, 0, 0, 0); a01 = __builtin_amdgcn_mfma_f32_32x32x16_bf16(kf[0][st], qf[1][st], a01, 0, 0, 0); a11 = __builtin_amdgcn_mfma_f32_32x32x16_bf16(kf[1][st], qf[1][st], a11, 0, 0, 0); }
    bf16x8 p00[2], p01[2], p11[2];
    { float t0[16], t1[16], t2[16];
#pragma unroll
      for (int r = 0; r < 16; ++r) { const bool keep = ((r & 3) + 8 * (r >> 2) + 4 * hi) <= r32; t0[r] = keep ? a00[r] : 0.f; t1[r] = a01[r]; t2[r] = keep ? a11[r] : 0.f; }
      p00[0] = pack8(t0); p00[1] = pack8(t0 + 8); p01[0] = pack8(t1); p01[1] = pack8(t1 + 8); p11[0] = pack8(t2); p11[1] = pack8(t2 + 8); }
    f32x16g o[2][2] = {};
    const float* sp = SST + (size_t)(ci * 4 + h) * 2048;
#pragma unroll
    for (int vb = 0; vb < 2; ++vb) {
#pragma unroll
        for (int sb = 0; sb < 2; ++sb)
#pragma unroll
            for (int j = 0; j < 2; ++j) { const LAS unsigned char* vp = wl + 8192 + (r32 + 32 * vb) * 128 + (32 * sb + 16 * j + 4 * hi) * 2;
                const u32x2 lo = *(const LAS u32x2*)vp, hh = *(const LAS u32x2*)(vp + 16); const bf16x8 vf = __builtin_bit_cast(bf16x8, (u32x4){lo.x, lo.y, hh.x, hh.y});
                if (sb == 0) { o[vb][0] = __builtin_amdgcn_mfma_f32_32x32x16_bf16(vf, p00[j], o[vb][0], 0, 0, 0); o[vb][1] = __builtin_amdgcn_mfma_f32_32x32x16_bf16(vf, p01[j], o[vb][1], 0, 0, 0); }
                else o[vb][1] = __builtin_amdgcn_mfma_f32_32x32x16_bf16(vf, p11[j], o[vb][1], 0, 0, 0); }
#pragma unroll
        for (int st = 0; st < 2; ++st) { float sx[8];
#pragma unroll
            for (int e = 0; e < 8; ++e) sx[e] = sp[(8 * hi + 16 * st + e) * 64 + r32 + 32 * vb];
            const bf16x8 sf = pack8(sx);
            o[vb][0] = __builtin_amdgcn_mfma_f32_32x32x16_bf16(sf, qf[0][st], o[vb][0], 0, 0, 0); o[vb][1] = __builtin_amdgcn_mfma_f32_32x32x16_bf16(sf, qf[1][st], o[vb][1], 0, 0, 0); } }
#pragma unroll
    for (int tb = 0; tb < 2; ++tb) { float ss = 0.f;
#pragma unroll
        for (int vb = 0; vb < 2; ++vb)
#pragma unroll
            for (int r = 0; r < 16; ++r) ss += o[vb][tb][r] * o[vb][tb][r];
        { auto rr = __builtin_amdgcn_permlane32_swap(__float_as_uint(ss), __float_as_uint(ss), false, false); ss = __uint_as_float(rr[0]) + __uint_as_float(rr[1]); }
        const float rinv = 1.0f / sqrtf(ss * (1.f / 64.f) + RMS_EPS); const size_t t = (size_t)ci * 64 + r32 + 32 * tb;
#pragma unroll
        for (int vb = 0; vb < 2; ++vb)
#pragma unroll
            for (int g = 0; g < 4; ++g) { const int v0 = 32 * vb + 8 * g + 4 * hi; const u32x2 gw = *(const u32x2*)(GR + t * 256 + h * 64 + v0); const f32x4 gn = *(const f32x4*)(ng + h * 64 + v0);
                const float gr[4] = {bf_lo(gw.x), bf_hi(gw.x), bf_lo(gw.y), bf_hi(gw.y)}; float y[4];
#pragma unroll
                for (int i = 0; i < 4; ++i) y[i] = o[vb][tb][4 * g + i] * rinv * gn[i] * (gr[i] * sigmoidf_(gr[i]));
                u32x2 w; w.x = cvt_pk_bf16(y[0], y[1]); w.y = cvt_pk_bf16(y[2], y[3]); *(u32x2*)(Y + t * 768 + h * 64 + v0) = w; } }
    asm volatile("s_waitcnt lgkmcnt(0)" ::: "memory");
}
namespace attn {
using s16x4 = __attribute__((ext_vector_type(4))) short;
using f32x16 = __attribute__((ext_vector_type(16))) float;
constexpr int DM = 256;
constexpr int NW = 8, QBLK = 32, KVBLK = 64;
constexpr int NSLOT = 3, SLOTB = 8192;
constexpr int LDS_K = 0, LDS_V = NSLOT * SLOTB, LDS_WS = 2 * NSLOT * SLOTB, LDS_OST = LDS_WS + NW * 64 * 4, LDS_CK = LDS_OST + NW * 4096, LDS_ENT = LDS_CK + 8192, LDS_BYTES = LDS_ENT + NW * 128;
__device__ __forceinline__ int crow(int r, int hi) { return (r & 3) + 8 * (r >> 2) + 4 * hi; }
#define SBAR() __builtin_amdgcn_sched_barrier(0)
__device__ __forceinline__ void cmask(f32x16& p0, f32x16& p1, int jb, int qrel, int hi) {
  const float NEG = -INFINITY; int kb = 64 * jb + 4 * hi;
#pragma unroll
  for (int r = 0; r < 16; ++r) { int kv = kb + (r & 3) + 8 * (r >> 2); if (kv > qrel) p0[r] = NEG; if (kv + 32 > qrel) p1[r] = NEG; }
}
__device__ __forceinline__ void glds16(const void* gbase, unsigned voff, unsigned lds_dst) { unsigned keep;
  asm volatile("s_mov_b32 %0, m0\n\ts_mov_b32 m0, %3\n\ts_nop 0\n\tglobal_load_lds_dwordx4 %1, %2\n\ts_mov_b32 m0, %0" : "=&s"(keep) : "v"(voff), "s"(gbase), "s"(lds_dst) : "memory"); }
__device__ __forceinline__ float max3f(float a, float b, float c) { float r; asm("v_max3_f32 %0, %1, %2, %3" : "=v"(r) : "v"(a), "v"(b), "v"(c)); return r; }
__device__ __forceinline__ float max2f(float a, float b) { float r; asm("v_max_f32_e32 %0, %1, %2" : "=v"(r) : "v"(a), "v"(b)); return r; }
__device__ __forceinline__ float fadd_s(float a, float b) { float r; asm("v_add_f32_e32 %0, %1, %2" : "=v"(r) : "v"(a), "v"(b)); return r; }
__device__ __forceinline__ float fsub_s(float a, float b) { float r; asm("v_sub_f32_e32 %0, %1, %2" : "=v"(r) : "v"(a), "v"(b)); return r; }
__device__ __forceinline__ unsigned cvtpk_s(float lo, float hi) { f32x2 v = {lo, hi}; bf16x2_t b = __builtin_convertvector(v, bf16x2_t); return __builtin_bit_cast(unsigned, b); }
#define WAIT_BAR(N) asm volatile("s_waitcnt vmcnt(" #N ") lgkmcnt(0)\n\ts_barrier" ::: "memory")
typedef __attribute__((address_space(3))) const char* lds_cptr;
typedef short v4i16_t __attribute__((ext_vector_type(4)));
__device__ __forceinline__ void qkt(f32x16& p0, f32x16& p1, const char* Kslot, const bf16x8* qr, int r32, int hi) {
  const char* kb = Kslot + hi * 1024 + r32 * 16;
#pragma unroll
  for (int d0 = 0; d0 < 4; ++d0) {
    const bf16x8 b0 = *reinterpret_cast<const bf16x8*>(kb + d0 * 2048);
    const bf16x8 b1 = *reinterpret_cast<const bf16x8*>(kb + d0 * 2048 + 512);
    p0 = __builtin_amdgcn_mfma_f32_32x32x16_bf16(b0, qr[d0], p0, 0, 0, 0); p1 = __builtin_amdgcn_mfma_f32_32x32x16_bf16(b1, qr[d0], p1, 0, 0, 0); }
}
__device__ __forceinline__ void kload8(bf16x8* kf, lds_cptr kp) {
  kf[0] = *(const LAS bf16x8*)(kp);        kf[1] = *(const LAS bf16x8*)(kp + 512);
  kf[2] = *(const LAS bf16x8*)(kp + 2048); kf[3] = *(const LAS bf16x8*)(kp + 2560);
  kf[4] = *(const LAS bf16x8*)(kp + 4096); kf[5] = *(const LAS bf16x8*)(kp + 4608);
  kf[6] = *(const LAS bf16x8*)(kp + 6144); kf[7] = *(const LAS bf16x8*)(kp + 6656);
}
__device__ __forceinline__ void kload2(bf16x8* kf, lds_cptr kp, int j) { kf[2 * j] = *(const LAS bf16x8*)(kp + j * 2048); kf[2 * j + 1] = *(const LAS bf16x8*)(kp + j * 2048 + 512); }
__device__ __forceinline__ s16x4 vtr(lds_cptr p) { return __builtin_bit_cast(s16x4, __builtin_amdgcn_ds_read_tr16_b64_v4i16((LAS v4i16_t*)p)); }
__device__ __forceinline__ float rowmax(const f32x16& p0, const f32x16& p1) {
  float a = max3f(p0[0], p0[1], p1[0]), b = max3f(p0[2], p0[3], p1[1]); a = max3f(a, p1[2], p1[3]);
#pragma unroll
  for (int r = 4; r < 16; r += 4) { a = max3f(a, p0[r], p0[r + 1]); b = max3f(b, p0[r + 2], p0[r + 3]); a = max3f(a, p1[r], p1[r + 1]); b = max3f(b, p1[r + 2], p1[r + 3]); }
  const float m = max2f(a, b);
  auto rr = __builtin_amdgcn_permlane32_swap(__float_as_uint(m), __float_as_uint(m), false, false);
  return max2f(__uint_as_float(rr[0]), __uint_as_float(rr[1]));
}
__device__ __forceinline__ void pv(f32x16* o, int vb, bf16x8 pa0, bf16x8 pa1, bf16x8 pa2, bf16x8 pa3) {
#pragma unroll
  for (int d0 = 0; d0 < 2; ++d0) { s16x4 lo[4], hi[4];
#pragma unroll
    for (int ks = 0; ks < 4; ++ks) {
      asm volatile("ds_read_b64_tr_b16 %0,%1 offset:%c2" : "=&v"(lo[ks]) : "v"(vb), "i"(d0 * 4096 + ks * 1024) : "memory");
      asm volatile("ds_read_b64_tr_b16 %0,%1 offset:%c2" : "=&v"(hi[ks]) : "v"(vb), "i"(d0 * 4096 + ks * 1024 + 512) : "memory"); }
    asm volatile("s_waitcnt lgkmcnt(0)" ::: "memory"); SBAR();
#define PK(k) (bf16x8){lo[k][0], lo[k][1], lo[k][2], lo[k][3], hi[k][0], hi[k][1], hi[k][2], hi[k][3]}
    o[d0] = __builtin_amdgcn_mfma_f32_32x32x16_bf16(pa0, PK(0), o[d0], 0, 0, 0);
    o[d0] = __builtin_amdgcn_mfma_f32_32x32x16_bf16(pa1, PK(1), o[d0], 0, 0, 0);
    o[d0] = __builtin_amdgcn_mfma_f32_32x32x16_bf16(pa2, PK(2), o[d0], 0, 0, 0);
    o[d0] = __builtin_amdgcn_mfma_f32_32x32x16_bf16(pa3, PK(3), o[d0], 0, 0, 0);
#undef PK
  }
}

template <int THRL> __device__ __forceinline__ void attn_unit(const bf16* Qrow, const bf16* __restrict__ Kh, const bf16* __restrict__ Vh, const int NT, const bool band,
                                                             const float cq, const float* ckg, const int dest, bf16* PO, float* LSEp, char* shm, const int tid) {
  const int lane = tid & 63, r32 = lane & 31, hi = lane >> 5; const int wid = __builtin_amdgcn_readfirstlane(tid >> 6);
  const unsigned lds0 = (unsigned)(uintptr_t)shm;
  float* wsf = (float*)(shm + LDS_WS) + wid * 64;
  f32x4 ckv = (f32x4){0.f, 0.f, 0.f, 0.f};
  if (ckg && tid * 4 < NT * 64) ckv = *(const f32x4*)(ckg + tid * 4);
  const unsigned koff = (unsigned)(lane * DM + wid * 8) * 2u;
  const unsigned voff = (unsigned)((16 * (wid & 3) + (lane >> 2)) * DM + (wid >> 2) * 32 + (lane & 3) * 8) * 2u;
  const unsigned kdst = lds0 + LDS_K + wid * 1024, vdst = lds0 + LDS_V + wid * 1024;
#define DMA_K(t, slot) glds16(Kh + (long)(t) * KVBLK * DM, koff, (unsigned)__builtin_amdgcn_readfirstlane(kdst + (slot)))
#define DMA_V(t, slot) glds16(Vh + (long)(t) * KVBLK * DM, voff, (unsigned)__builtin_amdgcn_readfirstlane(vdst + (slot)))
  const char* Kbase = shm + LDS_K; bf16x8 kf[8];
  const lds_cptr shm3 = (lds_cptr)shm; const lds_cptr kp0 = shm3 + LDS_K + hi * 1024 + r32 * 16; const lds_cptr vp0 = shm3 + LDS_V + ((lane >> 4) & 1) * 32 + (lane & 3) * 8 + (4 * hi + ((lane & 15) >> 2)) * 64;
  const LAS f32x4* ck4 = (const LAS f32x4*)(shm3 + LDS_CK) + hi;
  DMA_K(0, 0); DMA_V(0, 0); DMA_K(1, SLOTB);
  bf16x8 qr[4];
#pragma unroll
  for (int d0 = 0; d0 < 4; ++d0) qr[d0] = *reinterpret_cast<const bf16x8*>(&Qrow[d0 * 16 + hi * 8]);
  *(LAS f32x4*)((LAS char*)shm3 + LDS_CK + tid * 16) = ckv;
  if (hi == 0) *(LAS int*)((LAS char*)shm3 + LDS_ENT + wid * 128 + r32 * 4) = dest;
  float mhat = 0.f, l_reg = 0.f, nb = cq; f32x16 o[2]; o[0] = f32x16{}; o[1] = f32x16{};
  const int qrel = wid * QBLK + r32;
#define CMASK(P0, P1, t) do { int jb_ = (t) - (NT - 4); if (band && jb_ >= 0) cmask(P0, P1, jb_, qrel, hi); } while (0)
#define BINIT(P0, P1, t) do { _Pragma("unroll") for (int g_ = 0; g_ < 4; ++g_) { const f32x4 a_ = ck4[16 * (t) + 2 * g_], b_ = ck4[16 * (t) + 8 + 2 * g_]; \
      _Pragma("unroll") for (int i_ = 0; i_ < 4; ++i_) { P0[4 * g_ + i_] = nb - a_[i_]; P1[4 * g_ + i_] = nb - b_[i_]; } } } while (0)
  bool resc = false;
#define START(P0, P1) do { const float rm = rowmax(P0, P1); resc = false; \
    { const float dl = rm; mhat = fadd_s(mhat, dl); nb = fsub_s(nb, dl); \
      _Pragma("unroll") for (int r = 0; r < 16; ++r) { P0[r] = fsub_s(P0[r], dl); P1[r] = fsub_s(P1[r], dl); } } \
    _Pragma("unroll") for (int r = 0; r < 16; ++r) P0[r] = __builtin_amdgcn_exp2f(P0[r]); } while (0)
#define RESC() do { if (resc) { asm volatile("s_waitcnt lgkmcnt(0)" ::: "memory"); \
      _Pragma("unroll") for (int d_ = 0; d_ < 2; ++d_) _Pragma("unroll") for (int r = 0; r < 16; ++r) o[d_][r] *= wsf[crow(r, hi)]; } } while (0)
  f32x16 pA0, pA1, pB0, pB1;
  int sl_prev = 0, sl_cur = 0, sl_next = SLOTB;
#define ROT() do { sl_prev = sl_cur; sl_cur = sl_next; sl_next = (sl_next == (NSLOT - 1) * SLOTB) ? 0 : sl_next + SLOTB; } while (0)
  DMA_K(2, 2 * SLOTB);
  WAIT_BAR(3);
  BINIT(pA0, pA1, 0);
  qkt(pA0, pA1, Kbase, qr, r32, hi); asm volatile("s_nop 15\n\ts_nop 7" : "+v"(pA0), "+v"(pA1)); CMASK(pA0, pA1, 0);
  START(pA0, pA1);
  _Pragma("unroll") for (int r = 0; r < 16; ++r) pA1[r] = __builtin_amdgcn_exp2f(pA1[r]);
  BINIT(pB0, pB1, 1);
  WAIT_BAR(0);
  DMA_K(3, 0); DMA_V(1, SLOTB);
  ROT();
  kload8(kf, kp0 + sl_cur);
  WAIT_BAR(2);
  s16x4 vlo[8], vhi[8]; u32x4 pw0, pw1, pw2, pw3;
#define PKW(P, B) cvtpk_s(P[B], P[B + 1])
#define PAF(k) __builtin_bit_cast(bf16x8, pw##k)
#define VFR(i) (bf16x8){vlo[i][0], vlo[i][1], vlo[i][2], vlo[i][3], vhi[i][0], vhi[i][1], vhi[i][2], vhi[i][3]}
#define PIN(x) asm volatile("" : "+v"(x))
#define MX3(a, b, c) __builtin_fmaxf(__builtin_fmaxf((a), (b)), (c))
#define GAPA(MF, A0, A1, A2, A3, W0, W1, PW) do { MF; sacc += A0; sacc += A1; sacc += A2; sacc += A3; PIN(sacc); W0; W1; PIN(PW); SBAR(); } while (0)
#define EX(v) __builtin_amdgcn_exp2f(v)
#define GAPB(MF, X, B) do { MF; X[B] = EX(X[B]); X[B + 1] = EX(X[B + 1]); X[B + 2] = EX(X[B + 2]); X[B + 3] = EX(X[B + 3]); PIN(X); SBAR(); } while (0)
#define VRD(i) do { vlo[i] = vtr(vp_ + (((i) >> 2) * 4096 + ((i) & 3) * 1024)); vhi[i] = vtr(vp_ + (((i) >> 2) * 4096 + ((i) & 3) * 1024 + 512)); } while (0)
#define KRD(G, j) do { if (G) { kload2(kf, kp0 + sl_next, j); SBAR(); } } while (0)
#define BRD(G, P0, P1, t, g) do { if (G) { const f32x4 a_ = ck4[16 * ((t) + 1) + 2 * (g)], b_ = ck4[16 * ((t) + 1) + 8 + 2 * (g)]; \
      P0[4 * (g)] = a_[0]; P0[4 * (g) + 1] = a_[1]; P0[4 * (g) + 2] = a_[2]; P0[4 * (g) + 3] = a_[3]; P1[4 * (g)] = b_[0]; P1[4 * (g) + 1] = b_[1]; P1[4 * (g) + 2] = b_[2]; P1[4 * (g) + 3] = b_[3]; SBAR(); } } while (0)
#define BSB(G, P0, P1) do { if (G) { _Pragma("unroll") for (int r = 0; r < 16; ++r) { P0[r] = nb - P0[r]; P1[r] = nb - P1[r]; } PIN(P0); PIN(P1); SBAR(); } } while (0)
#define STEP(C0, C1, P0, P1, t, GK, GV, GL) do { SBAR(); \
    const lds_cptr vp_ = vp0 + sl_prev; \
    VRD(0); SBAR(); float sacc = (P0[0] + P0[1]); \
    GAPA(C0 = __builtin_amdgcn_mfma_f32_32x32x16_bf16(kf[0], qr[0], C0, 0, 0, 0), P0[2], P0[3], P0[4], P0[5],     pw0[0] = PKW(P0, 0), pw0[1] = PKW(P0, 2), pw0); \
    VRD(4); SBAR(); GAPA(C1 = __builtin_amdgcn_mfma_f32_32x32x16_bf16(kf[1], qr[0], C1, 0, 0, 0), P0[6], P0[7], P0[8], P0[9],     pw0[2] = PKW(P0, 4), pw0[3] = PKW(P0, 6), pw0); \
    VRD(1); SBAR(); GAPA(C0 = __builtin_amdgcn_mfma_f32_32x32x16_bf16(kf[2], qr[1], C0, 0, 0, 0),   P0[10], P0[11], P0[12], P0[13], pw1[0] = PKW(P0, 8), pw1[1] = PKW(P0, 10), pw1); \
    VRD(5); SBAR(); GAPA(C1 = __builtin_amdgcn_mfma_f32_32x32x16_bf16(kf[3], qr[1], C1, 0, 0, 0),   P0[14], P0[15], P1[0], P1[1],   pw1[2] = PKW(P0, 12), pw1[3] = PKW(P0, 14), pw1); \
    VRD(2); SBAR(); GAPA(C0 = __builtin_amdgcn_mfma_f32_32x32x16_bf16(kf[4], qr[2], C0, 0, 0, 0),   P1[2], P1[3], P1[4], P1[5],     pw2[0] = PKW(P1, 0), pw2[1] = PKW(P1, 2), pw2); \
    VRD(6); SBAR(); GAPA(C1 = __builtin_amdgcn_mfma_f32_32x32x16_bf16(kf[5], qr[2], C1, 0, 0, 0),   P1[6], P1[7], P1[8], P1[9],     pw2[2] = PKW(P1, 4), pw2[3] = PKW(P1, 6), pw2); \
    VRD(3); SBAR(); GAPA(C0 = __builtin_amdgcn_mfma_f32_32x32x16_bf16(kf[6], qr[3], C0, 0, 0, 0),   P1[10], P1[11], P1[12], P1[13], pw3[0] = PKW(P1, 8), pw3[1] = PKW(P1, 10), pw3); \
    VRD(7); SBAR(); GAPA(C1 = __builtin_amdgcn_mfma_f32_32x32x16_bf16(kf[7], qr[3], C1, 0, 0, 0),   P1[14], P1[15], 0.f, 0.f,       pw3[2] = PKW(P1, 12), pw3[3] = PKW(P1, 14), pw3); \
    l_reg += sacc; \
    if (GK) { DMA_K((t) + 3, sl_cur); } if (GV) { DMA_V((t) + 1, sl_next); } \
    CMASK(C0, C1, t); \
    { float a = MX3(C0[0], C0[1], C1[0]), b = MX3(C0[2], C0[3], C1[1]); a = MX3(a, C1[2], C1[3]); \
      _Pragma("unroll") for (int r = 4; r < 16; r += 4) { a = MX3(a, C0[r], C0[r + 1]); b = MX3(b, C0[r + 2], C0[r + 3]); a = MX3(a, C1[r], C1[r + 1]); b = MX3(b, C1[r + 2], C1[r + 3]); } \
      float rm = __builtin_fmaxf(a, b); { auto rr = __builtin_amdgcn_permlane32_swap(__float_as_uint(rm), __float_as_uint(rm), false, false); rm = __builtin_fmaxf(__uint_as_float(rr[0]), __uint_as_float(rr[1])); } \
      resc = false; \
      if (__builtin_expect(__any(rm > (float)THRL), 0)) { const float dl = __builtin_fmaxf(rm, 0.f); mhat += dl; nb -= dl; \
        _Pragma("unroll") for (int r = 0; r < 16; ++r) { C0[r] -= dl; C1[r] -= dl; } \
        const float f = __builtin_amdgcn_exp2f(-dl); l_reg *= f; if (hi == 0) wsf[r32] = f; resc = true; } } \
    SBAR(); \
    BRD(GL, P0, P1, t, 0); BRD(GL, P0, P1, t, 1); \
    GAPB(o[0] = __builtin_amdgcn_mfma_f32_32x32x16_bf16(PAF(0), VFR(0), o[0], 0, 0, 0), C0, 0); \
    BRD(GL, P0, P1, t, 2); BRD(GL, P0, P1, t, 3); \
    GAPB(o[1] = __builtin_amdgcn_mfma_f32_32x32x16_bf16(PAF(0), VFR(4), o[1], 0, 0, 0), C0, 4); \
    KRD(GL, 0); GAPB(o[0] = __builtin_amdgcn_mfma_f32_32x32x16_bf16(PAF(1), VFR(1), o[0], 0, 0, 0), C0, 8); \
    KRD(GL, 1); GAPB(o[1] = __builtin_amdgcn_mfma_f32_32x32x16_bf16(PAF(1), VFR(5), o[1], 0, 0, 0), C0, 12); \
    KRD(GL, 2); GAPB(o[0] = __builtin_amdgcn_mfma_f32_32x32x16_bf16(PAF(2), VFR(2), o[0], 0, 0, 0), C1, 0); \
    KRD(GL, 3); GAPB(o[1] = __builtin_amdgcn_mfma_f32_32x32x16_bf16(PAF(2), VFR(6), o[1], 0, 0, 0), C1, 4); \
    GAPB(o[0] = __builtin_amdgcn_mfma_f32_32x32x16_bf16(PAF(3), VFR(3), o[0], 0, 0, 0), C1, 8); \
    GAPB(o[1] = __builtin_amdgcn_mfma_f32_32x32x16_bf16(PAF(3), VFR(7), o[1], 0, 0, 0), C1, 12); \
    BSB(GL, P0, P1); \
    } while (0)
  int t = 1;
#undef CMASK
#define CMASK(P0, P1, t) do {} while (0)
  for (; t + 5 < NT; t += 2) {
    STEP(pB0, pB1, pA0, pA1, t, true, true, true);     WAIT_BAR(2); RESC(); ROT();
    STEP(pA0, pA1, pB0, pB1, t + 1, true, true, true); WAIT_BAR(2); RESC(); ROT();
  }
#undef CMASK
#define CMASK(P0, P1, t) do { int jb_ = (t) - (NT - 4); if (band && jb_ >= 0) cmask(P0, P1, jb_, qrel, hi); } while (0)
#define ENDW(tt) do { if ((tt) + 3 < NT) { WAIT_BAR(2); } else if ((tt) + 2 < NT) { WAIT_BAR(1); } else { WAIT_BAR(0); } } while (0)
  for (; t + 1 < NT; t += 2) {
    STEP(pB0, pB1, pA0, pA1, t, (t + 3 < NT), (t + 1 < NT), (t + 1 < NT));         ENDW(t);     RESC(); ROT();
    STEP(pA0, pA1, pB0, pB1, t + 1, (t + 4 < NT), (t + 2 < NT), (t + 2 < NT));     ENDW(t + 1); RESC(); ROT();
  }
  STEP(pB0, pB1, pA0, pA1, NT - 1, false, false, false); RESC();
  { float sacc = pB0[0] + pB0[1]; _Pragma("unroll") for (int r = 2; r < 16; ++r) sacc += pB0[r]; _Pragma("unroll") for (int r = 0; r < 16; ++r) sacc += pB1[r]; l_reg += sacc;
    pw0 = (u32x4){PKW(pB0, 0), PKW(pB0, 2), PKW(pB0, 4), PKW(pB0, 6)}; pw1 = (u32x4){PKW(pB0, 8), PKW(pB0, 10), PKW(pB0, 12), PKW(pB0, 14)}; pw2 = (u32x4){PKW(pB1, 0), PKW(pB1, 2), PKW(pB1, 4), PKW(pB1, 6)}; pw3 = (u32x4){PKW(pB1, 8), PKW(pB1, 10), PKW(pB1, 12), PKW(pB1, 14)};
    const int vb0 = (int)(lds0 + LDS_V) + ((lane >> 4) & 1) * 32 + (lane & 3) * 8 + (4 * hi + ((lane & 15) >> 2)) * 64;
    SBAR(); pv(o, vb0 + sl_cur, PAF(0), PAF(1), PAF(2), PAF(3)); }
#undef PKW
#undef PAF
#undef VFR
#undef PIN
#undef MX3
#undef GAPA
#undef GAPB
#undef EX
#undef VRD
#undef KRD
#undef BRD
#undef BSB
#undef STEP
#undef ENDW
  { auto rr = __builtin_amdgcn_permlane32_swap(__float_as_uint(l_reg), __float_as_uint(l_reg), false, false); l_reg = __uint_as_float(rr[0]) + __uint_as_float(rr[1]); }
  if (hi == 0) { wsf[32 + r32] = l_reg; const int de0 = *(const LAS int*)((LAS char*)shm3 + LDS_ENT + wid * 128 + r32 * 4); if (de0 >= 0) LSEp[de0] = mhat + __builtin_amdgcn_logf(l_reg); }
  asm volatile("s_waitcnt lgkmcnt(0)" ::: "memory");
  float rli[16];
#pragma unroll
  for (int r = 0; r < 16; ++r) rli[r] = __builtin_amdgcn_rcpf(wsf[32 + crow(r, hi)]);
  { bf16* stg = (bf16*)(shm + LDS_OST) + wid * 2048;
#pragma unroll
    for (int r = 0; r < 16; ++r) { const int orow = crow(r, hi);
#pragma unroll
      for (int d0 = 0; d0 < 2; ++d0) stg[orow * 64 + d0 * 32 + r32] = (bf16)(cvtpk_s(o[d0][r] * rli[r], 0.f) & 0xffffu); }
    asm volatile("s_waitcnt lgkmcnt(0)" ::: "memory");
    const LAS int* ents = (const LAS int*)((LAS char*)shm3 + LDS_ENT + wid * 128);
#pragma unroll
    for (int i = 0; i < 4; ++i) { const int row = i * 8 + (lane >> 3), ch = lane & 7; const u32x4 v = *(const u32x4*)(stg + row * 64 + ch * 8); const int de = ents[row];
      if (de >= 0) *(u32x4*)(PO + (size_t)de * 64 + ch * 8) = v; } }
  asm volatile("s_waitcnt lgkmcnt(0)\n\ts_barrier" ::: "memory");
#undef DMA_K
#undef DMA_V
#undef CMASK
#undef BINIT
#undef START
#undef RESC
#undef ROT
}
#undef SBAR
#undef WAIT_BAR
}

__device__ __forceinline__ void load16(const bf16* p, float (&v)[16]) {
    const u32x4 a = *(const u32x4*)p, b = *(const u32x4*)(p + 8);
    v[0] = bf_lo(a.x); v[1] = bf_hi(a.x); v[2] = bf_lo(a.y); v[3] = bf_hi(a.y); v[4] = bf_lo(a.z); v[5] = bf_hi(a.z); v[6] = bf_lo(a.w); v[7] = bf_hi(a.w);
    v[8] = bf_lo(b.x); v[9] = bf_hi(b.x); v[10] = bf_lo(b.y); v[11] = bf_hi(b.y); v[12] = bf_lo(b.z); v[13] = bf_hi(b.z); v[14] = bf_lo(b.w); v[15] = bf_hi(b.w);
}
__device__ __forceinline__ void moba_gate_batch(LAS unsigned char* lds, int tid, int b, const bf16* MQ, const float* KM, int* QL, unsigned* MCNT) {
    typedef float f32x16 __attribute__((ext_vector_type(16)));
    LAS int* hist = (LAS int*)(lds + 65536);
    LAS int* base = hist + 256;
    const int own = (b * 128) >> 8, nsel = own < 3 ? own : 3;
    const int lane = tid & 63, r32 = lane & 31, hi = lane >> 5, w = tid >> 6, h = w & 3, th = w >> 2;
    if (tid < 256) hist[tid] = 0;
    __syncthreads();
    LAS int* sres = base + 256;
    if (own > 0) {
        bf16x8 kh[2][4], kl[2][4];
#pragma unroll
        for (int nb = 0; nb < 2; ++nb)
#pragma unroll
            for (int st = 0; st < 4; ++st) { const float* kp = KM + ((size_t)h * 64 + r32 + 32 * nb) * 64 + 8 * hi + 16 * st; const f32x4 a = *(const f32x4*)kp, c = *(const f32x4*)(kp + 4);
                const float x[8] = {a[0], a[1], a[2], a[3], c[0], c[1], c[2], c[3]}; float lo[8]; u32x4 hw;
                hw.x = cvt_pk_bf16(x[0], x[1]); hw.y = cvt_pk_bf16(x[2], x[3]); hw.z = cvt_pk_bf16(x[4], x[5]); hw.w = cvt_pk_bf16(x[6], x[7]);
                const unsigned hh[4] = {hw.x, hw.y, hw.z, hw.w};
#pragma unroll
                for (int e = 0; e < 4; ++e) { lo[2 * e] = x[2 * e] - bf_lo(hh[e]); lo[2 * e + 1] = x[2 * e + 1] - bf_hi(hh[e]); }
                kh[nb][st] = __builtin_bit_cast(bf16x8, hw); kl[nb][st] = pack8(lo); }
#pragma unroll 1
        for (int g = 0; g < 2; ++g) { const int t = b * 128 + th * 64 + g * 32 + r32;
            f32x16 a0 = {}, a1 = {};
#pragma unroll
            for (int st = 0; st < 4; ++st) { const bf16x8 qf = *(const bf16x8*)(MQ + (size_t)t * 256 + h * 64 + 8 * hi + 16 * st);
                a0 = __builtin_amdgcn_mfma_f32_32x32x16_bf16(kh[0][st], qf, a0, 0, 0, 0); a0 = __builtin_amdgcn_mfma_f32_32x32x16_bf16(kl[0][st], qf, a0, 0, 0, 0);
                a1 = __builtin_amdgcn_mfma_f32_32x32x16_bf16(kh[1][st], qf, a1, 0, 0, 0); a1 = __builtin_amdgcn_mfma_f32_32x32x16_bf16(kl[1][st], qf, a1, 0, 0, 0); }
            float v0 = -INFINITY, v1 = -INFINITY, v2 = -INFINITY; int i0 = 0, i1 = 0, i2 = 0;
#pragma unroll
            for (int nb = 0; nb < 2; ++nb)
#pragma unroll
                for (int r = 0; r < 16; ++r) { const int n = (r & 3) + 8 * (r >> 2) + 4 * hi + 32 * nb; const float s = (n < own) ? (nb == 0 ? a0[r] : a1[r]) : -INFINITY;
                    if (s > v0) { v2 = v1; i2 = i1; v1 = v0; i1 = i0; v0 = s; i0 = n; }
                    else if (s > v1) { v2 = v1; i2 = i1; v1 = s; i1 = n; }
                    else if (s > v2) { v2 = s; i2 = n; } }
            float pv[3]; int pi[3];
            { const float mv[3] = {v0, v1, v2}; const int mi[3] = {i0, i1, i2};
#pragma unroll
              for (int c = 0; c < 3; ++c) { auto rv = __builtin_amdgcn_permlane32_swap(__float_as_uint(mv[c]), __float_as_uint(mv[c]), false, false); pv[c] = __uint_as_float(hi ? rv[0] : rv[1]);
                  auto ri = __builtin_amdgcn_permlane32_swap((unsigned)mi[c], (unsigned)mi[c], false, false); pi[c] = (int)(hi ? ri[0] : ri[1]); } }
            float cv[6] = {v0, v1, v2, pv[0], pv[1], pv[2]}; int cix[6] = {i0, i1, i2, pi[0], pi[1], pi[2]};
#pragma unroll
            for (int s3 = 0; s3 < 3; ++s3) { float bv = -INFINITY; int bi = 0x7fffffff, bc = 0;
#pragma unroll
                for (int c = 0; c < 6; ++c) { const bool better = (cv[c] > bv) || (cv[c] == bv && cix[c] < bi); if (better) { bv = cv[c]; bi = cix[c]; bc = c; } }
#pragma unroll
                for (int c = 0; c < 6; ++c) if (c == bc) { cv[c] = -INFINITY; cix[c] = 0x7fffffff; }
                if (hi == 0 && s3 < nsel) { const int rnk = __hip_atomic_fetch_add(hist + h * 64 + bi, 1, __ATOMIC_RELAXED, __HIP_MEMORY_SCOPE_WORKGROUP); sres[((w * 2 + g) * 32 + r32) * 3 + s3] = (bi << 16) | rnk; } }
        }
    }
    __syncthreads();
    if (tid < 256) { const int c = hist[tid]; base[tid] = c > 0 ? (int)__hip_atomic_fetch_add(MCNT + tid, (unsigned)c, __ATOMIC_RELAXED, __HIP_MEMORY_SCOPE_AGENT) : 0; }
    __syncthreads();
    if (own > 0 && hi == 0) {
#pragma unroll
        for (int g = 0; g < 2; ++g) { const int t = b * 128 + th * 64 + g * 32 + r32;
#pragma unroll
            for (int s3 = 0; s3 < 3; ++s3) if (s3 < nsel) { const int pk = sres[((w * 2 + g) * 32 + r32) * 3 + s3]; const int bi = pk >> 16, rnk = pk & 0xffff; QL[((size_t)h * 63 + bi) * 16384 + base[h * 64 + bi] + rnk] = t * 4 + s3; } } }
    __syncthreads();
}

__device__ __forceinline__ void moe_table(const unsigned* cntg, LAS int* tab, int tid) {
    if (tid < 64) { const int e = tid; const int c = e < 32 ? (int)__hip_atomic_load(cntg + e, __ATOMIC_RELAXED, __HIP_MEMORY_SCOPE_AGENT) : 0; const int nt = (c + 255) >> 8;
        const int tail = (c > 0 && ((c - 1) & 255) < 128) ? 1 : 0;
        int incl = nt, itail = tail;
#pragma unroll
        for (int o = 1; o < 64; o <<= 1) { const int y = shu(incl, o), z = shu(itail, o); if (e >= o) { incl += y; itail += z; } }
        if (e < 32) { tab[e] = c; tab[32 + e] = incl - nt; tab[96 + e] = ((incl - nt) - (itail - tail)) | ((itail - tail) << 10) | (tail << 16); }
        if (e == 31) { tab[64] = incl; tab[65] = incl; tab[66] = incl - itail; } }
    __syncthreads();
    const int ntl = tab[65], nfull = tab[66];
    for (int m = tid; m < ntl; m += 512) { int e = 0;
        for (int j = 1; j < 32; ++j) if (tab[32 + j] <= m) e = j;
        tab[128 + m] = e;
        const int pk = tab[96 + e], i = m - tab[32 + e], nte = (tab[e] + 255) >> 8;
        const int k = ((pk >> 16) & 1) && i == nte - 1 ? nfull + ((pk >> 10) & 63) : (pk & 1023) + i;
        tab[448 + k] = m; }
    __syncthreads();
}

__device__ __forceinline__ void ln1_router_block(LAS unsigned char* lds, int tid, int blk, const bf16* XB, const bf16* Y, const float* g1, const float* b1, const float* brt, const bf16* WRT,
                                                 bf16* X1, unsigned char* X1F, unsigned* CNT, int* TOK, int* TE, int* TP, float* TG) {
    typedef float f32x16 __attribute__((ext_vector_type(16)));
    LAS float* part = (LAS float*)lds;
    LAS int* hist = (LAS int*)(lds + RT_OFF); LAS int* base = hist + 32; LAS int* sel_e = base + 32; LAS int* sel_r = sel_e + 256; LAS float* sel_g = (LAS float*)(sel_r + 256);
    const int lane = tid & 63, wave = tid >> 6;
    if (tid < 32) hist[tid] = 0;
    { u32x2 yn[2][4], xn[2][4];
      { const size_t t = (size_t)blk * 64 + wave * 8;
#pragma unroll
        for (int r = 0; r < 2; ++r)
#pragma unroll
            for (int j = 0; j < 4; ++j) { const int c = 4 * lane + 256 * j; yn[r][j] = *(const u32x2*)(Y + (t + r) * 1024 + c); xn[r][j] = *(const u32x2*)(XB + (t + r) * 1024 + c); } }
      f32x4 gv[4], bv[4];
#pragma unroll
      for (int j = 0; j < 4; ++j) { gv[j] = *(const f32x4*)(g1 + 4 * lane + 256 * j); bv[j] = *(const f32x4*)(b1 + 4 * lane + 256 * j); }
#pragma unroll 1
      for (int rr = 0; rr < 8; rr += 2) {
        const size_t t = (size_t)blk * 64 + wave * 8 + rr;
        f32x4 v[2][4]; float s[2] = {0.f, 0.f};
#pragma unroll
        for (int r = 0; r < 2; ++r)
#pragma unroll
            for (int j = 0; j < 4; ++j) { v[r][j] = (f32x4){bf_lo(xn[r][j].x), bf_hi(xn[r][j].x), bf_lo(xn[r][j].y), bf_hi(xn[r][j].y)} * ALPHA + (f32x4){bf_lo(yn[r][j].x), bf_hi(yn[r][j].x), bf_lo(yn[r][j].y), bf_hi(yn[r][j].y)}; s[r] += (v[r][j][0] + v[r][j][1]) + (v[r][j][2] + v[r][j][3]); }
        if (rr < 6) {
#pragma unroll
            for (int r = 0; r < 2; ++r)
#pragma unroll
                for (int j = 0; j < 4; ++j) { const int c = 4 * lane + 256 * j; yn[r][j] = *(const u32x2*)(Y + (t + 2 + r) * 1024 + c); xn[r][j] = *(const u32x2*)(XB + (t + 2 + r) * 1024 + c); } }
        float mean[2], s2[2] = {0.f, 0.f}, rstd[2];
#pragma unroll
        for (int o = 1; o < 64; o <<= 1) { s[0] += shx(s[0], o); s[1] += shx(s[1], o); }
#pragma unroll
        for (int r = 0; r < 2; ++r) { mean[r] = s[r] * (1.f / 1024.f);
#pragma unroll
            for (int j = 0; j < 4; ++j) { v[r][j] = v[r][j] - mean[r]; s2[r] += (v[r][j][0] * v[r][j][0] + v[r][j][1] * v[r][j][1]) + (v[r][j][2] * v[r][j][2] + v[r][j][3] * v[r][j][3]); } }
#pragma unroll
        for (int o = 1; o < 64; o <<= 1) { s2[0] += shx(s2[0], o); s2[1] += shx(s2[1], o); }
#pragma unroll
        for (int r = 0; r < 2; ++r) { rstd[r] = 1.f / sqrtf(s2[r] * (1.f / 1024.f) + LN_EPS);
#pragma unroll
            for (int j = 0; j < 4; ++j) { const int c = 4 * lane + 256 * j; v[r][j] = v[r][j] * rstd[r] * gv[j] + bv[j];
                u32x2 w; w.x = cvt_pk_bf16(v[r][j][0], v[r][j][1]); w.y = cvt_pk_bf16(v[r][j][2], v[r][j][3]); *(u32x2*)(X1 + (t + r) * 1024 + c) = w;
                *(unsigned*)(X1F + (t + r) * 1024 + c) = cvt4_fp8(v[r][j][0], v[r][j][1], v[r][j][2], v[r][j][3]); } } } }
    asm volatile("s_waitcnt vmcnt(0)" ::: "memory");
    __syncthreads();
    { const int r32 = lane & 31, hi = lane >> 5, grp = wave & 1, kq = wave >> 1;
      const bf16* xr = X1 + ((size_t)blk * 64 + grp * 32 + r32) * 1024 + kq * 256 + hi * 8;
      const bf16* wh = WRT + (size_t)r32 * 1024 + kq * 256 + hi * 8;
      f32x16 acc = {};
#pragma unroll
      for (int half = 0; half < 2; ++half) { bf16x8 xf[8], wf[8], wl[8];
#pragma unroll
          for (int s = 0; s < 8; ++s) { const int ko = (half * 8 + s) * 16; xf[s] = *(const bf16x8*)(xr + ko); wf[s] = *(const bf16x8*)(wh + ko); wl[s] = *(const bf16x8*)(wh + 32768 + ko); }
#pragma unroll
          for (int s = 0; s < 8; ++s) { acc = __builtin_amdgcn_mfma_f32_32x32x16_bf16(wf[s], xf[s], acc, 0, 0, 0); acc = __builtin_amdgcn_mfma_f32_32x32x16_bf16(wl[s], xf[s], acc, 0, 0, 0); } }
      LAS float* pw = part + ((size_t)wave * 32 + r32) * 36 + 4 * hi;
#pragma unroll
      for (int g = 0; g < 4; ++g) *(LAS f32x4*)(pw + 8 * g) = (f32x4){acc[4 * g], acc[4 * g + 1], acc[4 * g + 2], acc[4 * g + 3]}; }
    __syncthreads();
    if (tid < 64) { const int grp = tid >> 5, tk = tid & 31; float lv[32];
#pragma unroll
        for (int e4 = 0; e4 < 8; ++e4) { f32x4 x = *(const f32x4*)(brt + e4 * 4);
#pragma unroll
            for (int q = 0; q < 4; ++q) x += *(const LAS f32x4*)(part + ((size_t)(q * 2 + grp) * 32 + tk) * 36 + e4 * 4);
            lv[e4 * 4] = x[0]; lv[e4 * 4 + 1] = x[1]; lv[e4 * 4 + 2] = x[2]; lv[e4 * 4 + 3] = x[3]; }
        float tv[4]; int ti[4];
#pragma unroll
        for (int k = 0; k < 4; ++k) { float bvv = -INFINITY; int bi = 0;
#pragma unroll
            for (int e = 0; e < 32; ++e) { const bool taken = (k > 0 && ti[0] == e) || (k > 1 && ti[1] == e) || (k > 2 && ti[2] == e); if (!taken && lv[e] > bvv) { bvv = lv[e]; bi = e; } }
            tv[k] = bvv; ti[k] = bi; }
        const float e1 = __expf(tv[1] - tv[0]), e2 = __expf(tv[2] - tv[0]), e3 = __expf(tv[3] - tv[0]); const float inv = 1.f / (1.f + e1 + e2 + e3);
        const float gk[4] = {inv, e1 * inv, e2 * inv, e3 * inv};
#pragma unroll
        for (int k = 0; k < 4; ++k) { const int rk = __hip_atomic_fetch_add(hist + ti[k], 1, __ATOMIC_RELAXED, __HIP_MEMORY_SCOPE_WORKGROUP); sel_e[tid * 4 + k] = ti[k]; sel_r[tid * 4 + k] = rk; sel_g[tid * 4 + k] = gk[k]; } }
    __syncthreads();
    if (tid < 32) { const int c = hist[tid]; base[tid] = c > 0 ? (int)__hip_atomic_fetch_add(CNT + tid, (unsigned)c, __ATOMIC_RELAXED, __HIP_MEMORY_SCOPE_AGENT) : 0; }
    __syncthreads();
    if (tid < 256) { const int tl = tid >> 2; const int t = blk * 64 + tl; const int e = sel_e[tid], pos = base[e] + sel_r[tid];
        TOK[e * 16384 + pos] = t; TE[(size_t)t * 4 + (tid & 3)] = e; TP[(size_t)t * 4 + (tid & 3)] = pos; TG[(size_t)t * 4 + (tid & 3)] = sel_g[tid]; }
    __syncthreads();
}

__device__ __forceinline__ void ln2_rows8(int lane, int t0, const bf16* X1, const bf16* YB, const LAS int* tab, const int* TE, const int* TP, const float* TG, const float* g2, const float* b2, bf16* XB, unsigned char* XB8, float* outp) {
    int slot_l = 0; float g_l = 0.f;
    if (lane < 32) { const int e = TE[(size_t)t0 * 4 + lane], pos = TP[(size_t)t0 * 4 + lane]; g_l = TG[(size_t)t0 * 4 + lane]; slot_l = tab[32 + e] * 256 + pos; }
    f32x4 gv[4], bv[4];
#pragma unroll
    for (int j = 0; j < 4; ++j) { gv[j] = *(const f32x4*)(g2 + 4 * lane + 256 * j); bv[j] = *(const f32x4*)(b2 + 4 * lane + 256 * j); }
    const unsigned char* YB8 = (const unsigned char*)YB;
    for (int rp = 0; rp < 8; rp += 2) {
        u32x2 xw[2][4]; unsigned yw[2][4][4]; float gg[2][4];
#pragma unroll
        for (int r = 0; r < 2; ++r) { const size_t t = (size_t)t0 + rp + r;
#pragma unroll
            for (int j = 0; j < 4; ++j) xw[r][j] = *(const u32x2*)(X1 + t * 1024 + 4 * lane + 256 * j);
#pragma unroll
            for (int k = 0; k < 4; ++k) { const size_t slot = (size_t)__builtin_amdgcn_readlane(slot_l, (rp + r) * 4 + k); gg[r][k] = __uint_as_float(__builtin_amdgcn_readlane(__float_as_uint(g_l), (rp + r) * 4 + k)) * 0.0625f;
#pragma unroll
                for (int j = 0; j < 4; ++j) yw[r][k][j] = *(const unsigned*)(YB8 + slot * 1024 + 4 * lane + 256 * j); } }
#pragma unroll
        for (int r = 0; r < 2; ++r) { const size_t t = (size_t)t0 + rp + r; f32x4 v[4]; float s = 0.f;
#pragma unroll
            for (int j = 0; j < 4; ++j) { v[j] = (f32x4){bf_lo(xw[r][j].x), bf_hi(xw[r][j].x), bf_lo(xw[r][j].y), bf_hi(xw[r][j].y)} * ALPHA;
#pragma unroll
                for (int k = 0; k < 4; ++k) { const f32x2 lo2 = __builtin_amdgcn_cvt_pk_f32_fp8((int)yw[r][k][j], false), hi2 = __builtin_amdgcn_cvt_pk_f32_fp8((int)yw[r][k][j], true); v[j] += (f32x4){lo2[0], lo2[1], hi2[0], hi2[1]} * gg[r][k]; }
                s += (v[j][0] + v[j][1]) + (v[j][2] + v[j][3]); }
            const float mean = wave_sum(s) * (1.f / 1024.f); float s2 = 0.f;
#pragma unroll
            for (int j = 0; j < 4; ++j) { v[j] = v[j] - mean; s2 += (v[j][0] * v[j][0] + v[j][1] * v[j][1]) + (v[j][2] * v[j][2] + v[j][3] * v[j][3]); }
            const float rstd = 1.f / sqrtf(wave_sum(s2) * (1.f / 1024.f) + LN_EPS);
#pragma unroll
            for (int j = 0; j < 4; ++j) { const int c = 4 * lane + 256 * j; v[j] = v[j] * rstd * gv[j] + bv[j];
                u32x2 w; w.x = cvt_pk_bf16(v[j][0], v[j][1]); w.y = cvt_pk_bf16(v[j][2], v[j][3]); *(u32x2*)(XB + t * 1024 + c) = w;
                *(unsigned*)(XB8 + t * 1024 + c) = cvt4_fp8(v[j][0], v[j][1], v[j][2], v[j][3]);
                if (outp) *(f32x4*)(outp + t * 1024 + c) = v[j]; } }
    }
}

constexpr int NFOX_FULL = 928, NFOX = 1152;
__device__ __forceinline__ void fox_item(int idx, int& h, int& qb, int& p, int& NT, bool& band) {
    if (idx < NFOX_FULL) { h = idx / 232; const int k = idx % 232; int pp = 0, base = 0;
#pragma unroll
        for (int j = 0; j < 7; ++j) { const int cnt = 57 - 8 * j; if (k >= base + cnt && pp == j) { base += cnt; pp = j + 1; } }
        p = pp; qb = 8 * pp + 7 + (k - base); NT = 32; band = (8 * (pp + 1) == qb + 1); }
    else { const int i2 = idx - NFOX_FULL, cls = i2 >> 5, w = i2 & 31, r = 7 - cls; h = w >> 3; p = w & 7; qb = 8 * p + r - 1; NT = 4 * r; band = true; }
}
__device__ __forceinline__ void attn_item(int item, int nsel_items, const LAS int* mpre, unsigned char* ws, const unsigned* mcnt, char* shm, const int tid) {
    const int lane = tid & 63, r32 = lane & 31; const int wid = __builtin_amdgcn_readfirstlane(tid >> 6);
    const bf16* PROJ = (const bf16*)(ws + WS_PROJ);
    const int rw = wid * 32 + r32;
    int h, NT, tok, dest, kv0, tq; bool band; float cq = 0.f; const float* ckg = nullptr; bf16* PO; float* LSEp;
    if (item < NFOX) { int qb, p; fox_item(item, h, qb, p, NT, band);
        const float* CF = (const float*)(ws + WS_CF) + (size_t)h * S;
        tok = qb * 256 + rw; kv0 = p * 2048; dest = (tok * 4 + h) * 8 + p; tq = 0;
        PO = (bf16*)(ws + WS_POF); LSEp = (float*)(ws + WS_LSF);
        { const float* QN = (const float*)(ws + WS_NRM) + h * 256; const float* KN = QN + 1024;
          const float qm = fmaxf(fmaxf(QN[qb * 4], QN[qb * 4 + 1]), fmaxf(QN[qb * 4 + 2], QN[qb * 4 + 3])), ko = fmaxf(fmaxf(KN[qb * 4], KN[qb * 4 + 1]), fmaxf(KN[qb * 4 + 2], KN[qb * 4 + 3]));
          const int nfree = band ? NT - 4 : NT; const int ti = lane & 31; bool sk = false;
          if (ti < nfree) sk = qm * (KN[kv0 / 64 + ti] + ko) + (CF[qb * 256] - CF[kv0 + ti * 64 + 63]) < -40.f;
          const unsigned long long bal = __ballot(sk); int ns = __builtin_ctzll(~(bal & 0xffffffffull) | (1ull << 32));
          ns = __builtin_amdgcn_readfirstlane(ns) & ~1;
          if (!band && NT - ns < 4) { if (ns >= NT) { if (tid < 256) LSEp[((qb * 256 + tid) * 4 + h) * 8 + p] = -1e30f; return; } ns = NT - 4; }
          kv0 += ns * 64; NT -= ns; }
        cq = CF[tok]; ckg = CF + kv0;
    } else { int j; NT = 4; tq = 3; PO = (bf16*)(ws + WS_POM); LSEp = (float*)(ws + WS_LSM);
        if (item < NFOX + nsel_items) { const int k = item - NFOX; int lo = 0, hi_ = 252;
            while (hi_ - lo > 1) { const int mid = (lo + hi_) >> 1; if (mpre[mid] <= k) lo = mid; else hi_ = mid; }
            const int hj = lo, c = k - mpre[hj]; h = hj / 63; j = hj % 63; const int n = (int)mcnt[h * 64 + j] - c * 256;
            const int e = rw < n ? ((const int*)(ws + WS_QL))[((size_t)h * 63 + j) * 16384 + c * 256 + rw] : -1;
            tok = e < 0 ? 0 : (e >> 2); dest = e < 0 ? -1 : (tok * 4 + h) * 4 + (e & 3); band = false; }
        else { const int k = item - NFOX - nsel_items; h = k >> 6; j = k & 63; tok = j * 256 + rw; dest = (tok * 4 + h) * 4 + 3; band = true; }
        kv0 = j * 256; }
    attn::attn_unit<8>(PROJ + (size_t)tq * S * 256 + (size_t)tok * 256 + h * 64, PROJ + (size_t)(tq + 1) * S * 256 + (size_t)kv0 * 256 + h * 64, PROJ + (size_t)(tq + 2) * S * 256 + (size_t)kv0 * 256 + h * 64,
                       NT, band, cq, ckg, dest, PO, LSEp, shm, tid);
}
__device__ __forceinline__ void combine_token(int lane, int tok, unsigned char* ws) {
    const int h = lane >> 4, d4 = (lane & 15) * 4; bf16* YS = (bf16*)(ws + WS_YS);
    const int np = (tok >> 11) + 1; const float* LF = (const float*)(ws + WS_LSF) + ((size_t)tok * 4 + h) * 8; const bf16* PF = (const bf16*)(ws + WS_POF) + ((size_t)tok * 4 + h) * 8 * 64 + d4;
    const int own = tok >> 8, nsel = own < 3 ? own : 3; const float* LM = (const float*)(ws + WS_LSM) + ((size_t)tok * 4 + h) * 4; const bf16* PM = (const bf16*)(ws + WS_POM) + ((size_t)tok * 4 + h) * 4 * 64 + d4;
    float lf[8], lm[4]; u32x2 xf[8], xm[4];
#pragma unroll
    for (int p = 0; p < 8; ++p) { const bool on = p < np; lf[p] = on ? LF[p] : -INFINITY; xf[p] = on ? *(const u32x2*)(PF + p * 64) : (u32x2){0u, 0u}; }
#pragma unroll
    for (int s = 0; s < 4; ++s) { const bool on = s < nsel || s == 3; lm[s] = on ? LM[s] : -INFINITY; xm[s] = on ? *(const u32x2*)(PM + s * 64) : (u32x2){0u, 0u}; }
    { float m = lf[0];
#pragma unroll
      for (int p = 1; p < 8; ++p) m = fmaxf(m, lf[p]);
      float den = 0.f; f32x4 acc = (f32x4){0.f, 0.f, 0.f, 0.f};
#pragma unroll
      for (int p = 0; p < 8; ++p) { const float w = fast_exp2(lf[p] - m); den += w; acc += (f32x4){bf_lo(xf[p].x), bf_hi(xf[p].x), bf_lo(xf[p].y), bf_hi(xf[p].y)} * w; }
      const float inv = 1.f / den; u32x2 o; o.x = cvt_pk_bf16(acc[0] * inv, acc[1] * inv); o.y = cvt_pk_bf16(acc[2] * inv, acc[3] * inv);
      *(u32x2*)(YS + (size_t)tok * 768 + h * 64 + d4) = o; }
    { float m = lm[3];
#pragma unroll
      for (int s = 0; s < 3; ++s) m = fmaxf(m, lm[s]);
      float den = 0.f; f32x4 acc = (f32x4){0.f, 0.f, 0.f, 0.f};
#pragma unroll
      for (int s = 0; s < 4; ++s) { const float w = fast_exp2(lm[s] - m); den += w; acc += (f32x4){bf_lo(xm[s].x), bf_hi(xm[s].x), bf_lo(xm[s].y), bf_hi(xm[s].y)} * w; }
      const float inv = 1.f / den; u32x2 o; o.x = cvt_pk_bf16(acc[0] * inv, acc[1] * inv); o.y = cvt_pk_bf16(acc[2] * inv, acc[3] * inv);
      *(u32x2*)(YS + (size_t)tok * 768 + 512 + h * 64 + d4) = o; }
}
__global__ void __launch_bounds__(512, 2) mk_fwd(Args args_in_kernarg) {
    extern __shared__ __attribute__((aligned(16))) unsigned char lds_raw[];
    LAS unsigned char* lds = (LAS unsigned char*)lds_raw;
    const int tid0 = threadIdx.x; const int wave0 = __builtin_amdgcn_readfirstlane(tid0 >> 6);
    const int G = gridDim.x; const int bx = blockIdx.x; const int vcu = (G % 8 == 0) ? (bx % 8) * (G / 8) + bx / 8 : bx;
    const CAS unsigned char* const kargs = (const CAS unsigned char*)__builtin_amdgcn_kernarg_segment_ptr();
    for (int u = tid0; u < (LDS_BYTES - LDSCTL_OFF) / 4; u += 512) ((LAS unsigned*)(lds + LDSCTL_OFF))[u] = 0u;
    __syncthreads();
    const int lo = *(const CAS int*)(kargs + 160), hi = *(const CAS int*)(kargs + 164);
    XcdBarrier bar; bar.bar = (unsigned*)KARG_WS(kargs) + CW_BAR; bar.x = 0; bar.st = nullptr;
    if (hi - lo > 1) bar = xcd_barrier_post((unsigned*)KARG_WS(kargs) + CW_BAR, (volatile LAS unsigned*)(lds + MISC_OFF) + 8, tid0 == 0);
#if PROBE_MASK
    unsigned long long probe_t0 = 0;
#define PROBE_T0() probe_t0 = __builtin_amdgcn_s_memrealtime()
#define PROBE_END(p) do { if ((PROBE_MASK >> (p)) & 1) { asm volatile("s_waitcnt vmcnt(0)" ::: "memory"); const unsigned long long t1_ = __builtin_amdgcn_s_memrealtime(), dt_ = t1_ - probe_t0; \
        if (probe_t0 != 0) while (__builtin_amdgcn_s_memrealtime() - t1_ < dt_) __builtin_amdgcn_s_sleep(8); } probe_t0 = 0; } while (0)
#else
#define PROBE_T0() do {} while (0)
#define PROBE_END(p) do {} while (0)
#endif
#define IN(k) (lo <= (k) && (k) < hi)
#define SEAM(k) do { if (IN(k) && IN((k) + 1)) { const CAS unsigned char* kq_ = kargs; asm volatile("" : "+s"(kq_)); XcdBarrier b2_ = bar; b2_.bar = (unsigned*)KARG_WS(kq_) + CW_BAR; \
        xcd_barrier(b2_, wave0 == 0 && lane_id_now() == 0u); } } while (0)
#define PHASE_PTRS() const CAS unsigned char* kp = kargs; asm volatile("" : "+s"(kp)); unsigned char* const ws = KARG_WS(kp); (void)ws; \
    int tid = wave0 * 64 + (int)lane_id_now(); asm volatile("" : "+v"(tid)); const int lane = tid & 63, wave = __builtin_amdgcn_readfirstlane(tid >> 6); (void)lane; (void)wave
#define PROJ_ ((bf16*)(ws + WS_PROJ))
#define FQ_ (PROJ_)
#define FK_ (PROJ_ + (size_t)1 * S * 256)
#define FV_ (PROJ_ + (size_t)2 * S * 256)
#define MQ_ (PROJ_ + (size_t)3 * S * 256)
#define MK_ (PROJ_ + (size_t)4 * S * 256)
#define MV_ (PROJ_ + (size_t)5 * S * 256)
#define GQK_ (PROJ_ + (size_t)6 * S * 256)
#define GV_ (PROJ_ + (size_t)7 * S * 256)
#define GR_ (PROJ_ + (size_t)8 * S * 256)
    LAS int* const tab = (LAS int*)(lds + TAB_OFF);

    if (IN(0)) { PROBE_T0(); PHASE_PTRS(); p0_prologue(kp, lds, vcu, G, tid); }
    PROBE_END(15); SEAM(0);

    for (int l = 0; l < DEPTH; ++l) {
        const int pb = 1 + l * NPH;
        if (hi <= pb || lo >= pb + NPH) continue;
        if (IN(pb + 0)) { PROBE_T0(); PHASE_PTRS();
            { pg8::DenseOrder So; So.init(S, NIN, 1024, (const bf16*)(ws + WS_WIN) + (size_t)l * NIN * 1024, G, bx);
              pg8::EpiIn E{PROJ_, (bf16*)(ws + WS_SG), (float*)(ws + WS_LA), (float*)(ws + WS_FFL), KARG_IN(kp, 4) + l * 128, KARG_IN(kp, 2) + l * 4};
              pg8::gemm_phase<pg8::EpiIn, pg8::DenseOrder, true, false>(lds, (const bf16*)(ws + WS_XB), 1024, 1024, So, E, tid); }
            asm volatile("s_waitcnt vmcnt(0)" ::: "memory"); __syncthreads();
            { int Kq = 1024; asm volatile("" : "+s"(Kq));
              pg8::DenseOrder So; So.init(S, 3072, Kq, (const bf16*)(ws + WS_WIN8 + (size_t)l * 3072 * 1024), G, bx); So.K = Kq; So.split = (G == 256) ? 128 : 0;
              pg8::EpiGate E{(unsigned char*)(ws + WS_SG)};
              pg8::gemm_phase<pg8::EpiGate, pg8::DenseOrder, true, false, true>(lds, (const bf16*)(ws + WS_XB8), Kq, Kq, So, E, tid); }
        }
        PROBE_END(0); SEAM(pb + 0);
        if (IN(pb + 1)) { PROBE_T0(); PHASE_PTRS();
            const bf16* MK = MK_; float* KM = (float*)(ws + WS_KM);
            for (int wj = vcu * 8 + wave; wj < 1024 + 2048 + 256; wj += G * 8) {
                if (wj < 1024) gla_local_wave(lds + wave * 16384, lane, wj >> 2, wj & 3, GQK_, GV_, (const float*)(ws + WS_LA), (float*)(ws + WS_U), (float*)(ws + WS_DEC));
                else if (wj < 3072) {
                    const int idx = wj - 1024, tile = idx >> 3, which = (idx >> 2) & 1, h = idx & 3;
                    const bf16* src_ = PROJ_ + (size_t)which * S * 256 + (size_t)(tile * 64 + lane) * 256 + h * 64; float ss = 0.f;
#pragma unroll
                    for (int c = 0; c < 8; ++c) { const u32x4 w = *(const u32x4*)(src_ + c * 8); const float a0 = bf_lo(w.x), a1 = bf_hi(w.x), a2 = bf_lo(w.y), a3 = bf_hi(w.y), a4 = bf_lo(w.z), a5 = bf_hi(w.z), a6 = bf_lo(w.w), a7 = bf_hi(w.w);
                        ss += (a0 * a0 + a1 * a1) + (a2 * a2 + a3 * a3) + (a4 * a4 + a5 * a5) + (a6 * a6 + a7 * a7); }
                    float nm = sqrtf(ss);
#pragma unroll
                    for (int o = 1; o < 64; o <<= 1) nm = fmaxf(nm, shx(nm, o));
                    if (lane == 0) ((float*)(ws + WS_NRM))[(which * 4 + h) * 256 + tile] = nm; }
                else {
                    const int hj = wj - 3072, h = hj >> 6, j = hj & 63, kp = lane >> 4, dq = lane & 15;
                    const bf16* mk = MK_ + (size_t)(j * 256 + kp) * 256 + h * 64 + dq * 4; f32x4 s4 = (f32x4){0.f, 0.f, 0.f, 0.f};
#pragma unroll 1
                    for (int ib = 0; ib < 64; ib += 16) { u32x2 w[16];
#pragma unroll
                        for (int i = 0; i < 16; ++i) w[i] = *(const u32x2*)(mk + (size_t)(ib + i) * 4 * 256);
                        asm volatile("" : "+v"(w[0]), "+v"(w[1]), "+v"(w[2]), "+v"(w[3]), "+v"(w[4]), "+v"(w[5]), "+v"(w[6]), "+v"(w[7]), "+v"(w[8]), "+v"(w[9]), "+v"(w[10]), "+v"(w[11]), "+v"(w[12]), "+v"(w[13]), "+v"(w[14]), "+v"(w[15]));
#pragma unroll
                        for (int i = 0; i < 16; ++i) s4 += (f32x4){bf_lo(w[i].x), bf_hi(w[i].x), bf_lo(w[i].y), bf_hi(w[i].y)}; }
#pragma unroll
                    for (int c = 0; c < 4; ++c) { s4[c] += shx(s4[c], 16); s4[c] += shx(s4[c], 32); }
                    if (kp == 0) *(f32x4*)((float*)(ws + WS_KM) + (size_t)(h * 64 + j) * 64 + dq * 4) = s4 * (1.f / 256.f); }
            }
        }
        PROBE_END(1); SEAM(pb + 1);
        if (IN(pb + 2)) { PROBE_T0(); PHASE_PTRS();
            for (int job = vcu; job < 128 + 4 + 128; job += G) {
                if (job < 128) {
                    const float* DEC = (const float*)(ws + WS_DEC); const float* Ub = (const float*)(ws + WS_U); float* SST = (float*)(ws + WS_SST);
                    LAS float* cd = (LAS float*)lds; LAS float* cu = cd + 512;
                    const int e = job * 64 + lane; const float* dp = DEC + (size_t)wave * 32 * 128 + (e >> 6); const float* up = Ub + (size_t)wave * 32 * 8192 + e; float* sp = SST + (size_t)wave * 32 * 8192 + e;
                    float d[32], u[32];
#pragma unroll
                    for (int k = 0; k < 32; ++k) { d[k] = dp[k * 128]; u[k] = up[(size_t)k * 8192]; }
                    float dd = 1.f, uu = 0.f;
#pragma unroll
                    for (int k = 0; k < 32; ++k) { uu = uu * d[k] + u[k]; dd *= d[k]; }
                    cd[wave * 64 + lane] = dd; cu[wave * 64 + lane] = uu;
                    __syncthreads();
                    float s = 0.f;
                    for (int g2 = 0; g2 < wave; ++g2) s = s * cd[g2 * 64 + lane] + cu[g2 * 64 + lane];
#pragma unroll
                    for (int k = 0; k < 32; ++k) { sp[(size_t)k * 8192] = s; s = s * d[k] + u[k]; }
                    __syncthreads(); }
                else if (job < 132) { const float* FFL = (const float*)(ws + WS_FFL); float* CF = (float*)(ws + WS_CF);
                    const int h = job - 128; LAS float* wt = (LAS float*)lds; const f32x4* sp4 = (const f32x4*)(FFL + (size_t)h * S + tid * 32); f32x4 x[8];
#pragma unroll
                    for (int i = 0; i < 8; ++i) x[i] = sp4[i];
                    float run = 0.f;
#pragma unroll
                    for (int i = 0; i < 8; ++i) { x[i][0] += run; x[i][1] += x[i][0]; x[i][2] += x[i][1]; x[i][3] += x[i][2]; run = x[i][3]; }
                    float tot = run;
#pragma unroll
                    for (int o = 1; o < 64; o <<= 1) { const float y = shu(tot, o); if (lane >= o) tot += y; }
                    if (lane == 63) wt[wave] = tot;
                    __syncthreads();
                    float pre = tot - run;
                    for (int w = 0; w < wave; ++w) pre += wt[w];
                    f32x4* dp4 = (f32x4*)(CF + (size_t)h * S + tid * 32);
#pragma unroll
                    for (int i = 0; i < 8; ++i) dp4[i] = (x[i] + pre) * LOG2E;
                    __syncthreads(); }
                else moba_gate_batch(lds, tid, 127 - (job - 132), MQ_, (const float*)(ws + WS_KM), (int*)(ws + WS_QL), (unsigned*)ws + CW_MCNT + l * 256);
            }
        }
        PROBE_END(2); SEAM(pb + 2);
        if (IN(pb + 3)) { PROBE_T0(); PHASE_PTRS();
            bf16* const YS = (bf16*)(ws + WS_YS);
            for (int wj = vcu * 8 + wave; wj < 1024; wj += G * 8) gla_out_wave(lds + wave * 16384, lane, wj >> 2, wj & 3, GQK_, GV_, GR_, (const float*)(ws + WS_LA), (const float*)(ws + WS_SST), KARG_IN(kp, 5) + l * 256, YS + 256);
            __syncthreads();
            LAS int* const mpre = (LAS int*)(lds + RT_OFF); LAS int* const qslot = mpre + 256;
            const unsigned* mcnt = (const unsigned*)ws + CW_MCNT + l * 256; unsigned* qhead = (unsigned*)ws + CW_Q + l * 64;
            if (tid < 64) { int c4[4]; int s4 = 0;
#pragma unroll
                for (int i = 0; i < 4; ++i) { const int hj = tid * 4 + i; const int c = hj < 252 ? (int)mcnt[(hj / 63) * 64 + hj % 63] : 0; c4[i] = (c + 255) >> 8; s4 += c4[i]; }
                int incl = s4;
#pragma unroll
                for (int o = 1; o < 64; o <<= 1) { const int y = shu(incl, o); if (tid >= o) incl += y; }
                int run = incl - s4;
#pragma unroll
                for (int i = 0; i < 4; ++i) { if (tid * 4 + i <= 252) mpre[tid * 4 + i] = run; run += c4[i]; } }
            if (tid == 0) qslot[0] = (int)__hip_atomic_fetch_add(qhead, 1u, __ATOMIC_RELAXED, __HIP_MEMORY_SCOPE_AGENT);
            __syncthreads();
            const int nsel_items = mpre[252], total = NFOX + nsel_items + 256;
            int cur = qslot[0];
            __syncthreads();
            while (cur < total) {
                int nxt = 0;
                if (tid == 0) nxt = (int)__hip_atomic_fetch_add(qhead, 1u, __ATOMIC_RELAXED, __HIP_MEMORY_SCOPE_AGENT);
                attn_item(cur, nsel_items, mpre, ws, mcnt, (char*)lds_raw, tid);
                if (tid == 0) qslot[0] = nxt;
                __syncthreads();
                cur = qslot[0];
                __syncthreads();
            }
        }
        PROBE_END(3); SEAM(pb + 3);
        if (IN(pb + 4)) { PROBE_T0(); PHASE_PTRS();
            for (int t = (vcu * 8 + wave) * 8; t < S; t += G * 64) {
#pragma unroll 2
                for (int i = 0; i < 8; ++i) combine_token(lane, t + i, ws); }
        }
        PROBE_END(4); SEAM(pb + 4);
        if (IN(pb + 5)) { PROBE_T0(); PHASE_PTRS();
            int Kl = 768; asm volatile("" : "+s"(Kl));
            pg8::DenseOrder So; So.init(S, 1024, Kl, (const bf16*)(ws + WS_WBR) + (size_t)l * 1024 * 768, G, bx);
            pg8::EpiLift E{(const unsigned char*)(ws + WS_SG), (bf16*)(ws + WS_MRG)};
            pg8::gemm_phase<pg8::EpiLift, pg8::DenseOrder, true, false, false, true>(lds, (const bf16*)(ws + WS_YS), Kl, Kl, So, E, tid);
        }
        PROBE_END(5); SEAM(pb + 5);
        if (IN(pb + 6)) { PROBE_T0(); PHASE_PTRS();
            pg8::DenseOrder So; So.init(S, 1024, 1024, (const bf16*)(ws + WS_WOUT) + (size_t)l * 1024 * 1024, G, bx);
            pg8::EpiF32 E{(bf16*)(ws + WS_Y)};
            pg8::gemm_phase<pg8::EpiF32, pg8::DenseOrder, true, false>(lds, (const bf16*)(ws + WS_MRG), 1024, 1024, So, E, tid);
        }
        PROBE_END(6); SEAM(pb + 6);
        if (IN(pb + 7)) { PROBE_T0(); PHASE_PTRS();
            for (int blk = vcu; blk < S / 64; blk += G)
                ln1_router_block(lds, tid, blk, (const bf16*)(ws + WS_XB), (const bf16*)(ws + WS_Y), KARG_IN(kp, 8) + l * 1024, KARG_IN(kp, 9) + l * 1024, KARG_IN(kp, 11) + l * 32, (const bf16*)(ws + WS_WRT) + (size_t)l * 65536, (bf16*)(ws + WS_X1), (unsigned char*)(ws + WS_X1F),
                                 (unsigned*)ws + CW_CNT + l * 64, (int*)(ws + WS_TOK), (int*)(ws + WS_TE), (int*)(ws + WS_TP), (float*)(ws + WS_TG));
        }
        PROBE_END(7); SEAM(pb + 7);
        if (IN(pb + 8)) { PROBE_T0(); PHASE_PTRS();
            moe_table((const unsigned*)ws + CW_CNT + l * 64, tab, tid);
            pg8::MoeOrder So{G, vcu, 8, tab[65], tab, (const int*)(ws + WS_TOK), (const char*)(ws + WS_WGU) + (size_t)l * 32 * 2048 * 1024, (size_t)2048 * 1024, 1024};
            pg8::EpiMoe1 E{(unsigned char*)(ws + WS_ACT), KARG_IN(kp, 13) + (size_t)l * 32 * 2048, (const LAS float*)(lds + RT_OFF)};
            int Kq = 1024; asm volatile("" : "+s"(Kq));
            pg8::gemm_phase<pg8::EpiMoe1, pg8::MoeOrder, true, true, true, false, true>(lds, (const bf16*)(ws + WS_X1F), Kq, Kq, So, E, tid);
        }
        PROBE_END(8); SEAM(pb + 8);
        if (IN(pb + 9)) { PROBE_T0(); PHASE_PTRS();
            moe_table((const unsigned*)ws + CW_CNT + l * 64, tab, tid);
            pg8::MoeOrder So{G, vcu, 4, tab[65], tab, nullptr, (const char*)(ws + WS_WDN) + (size_t)l * 32 * 1024 * 1024, (size_t)1024 * 1024, 1024};
            pg8::EpiMoe2 E{(bf16*)(ws + WS_YB), KARG_IN(kp, 15) + (size_t)l * 32 * 1024, (const LAS float*)(lds + RT_OFF)};
            int Kq = 1024; asm volatile("" : "+s"(Kq));
            pg8::gemm_phase<pg8::EpiMoe2, pg8::MoeOrder, true, false, true, false, true>(lds, (const bf16*)(ws + WS_ACT), Kq, Kq, So, E, tid);
        }
        PROBE_END(9); SEAM(pb + 9);
        if (IN(pb + 10)) { PROBE_T0(); PHASE_PTRS();
            moe_table((const unsigned*)ws + CW_CNT + l * 64, tab, tid);
            float* outp = (l == DEPTH - 1) ? KARG_OUT(kp) : nullptr;
            for (int t0 = (vcu * 8 + wave) * 8; t0 < S; t0 += G * 64) ln2_rows8(lane, t0, (const bf16*)(ws + WS_X1), (const bf16*)(ws + WS_YB), tab, (const int*)(ws + WS_TE), (const int*)(ws + WS_TP), (const float*)(ws + WS_TG),
                                                                            KARG_IN(kp, 16) + l * 1024, KARG_IN(kp, 17) + l * 1024, (bf16*)(ws + WS_XB), (unsigned char*)(ws + WS_XB8), outp);
        }
        PROBE_END(10); SEAM(pb + 10);
    }
#undef IN
#undef SEAM
}

extern "C" void kernel_launch(void* const* d_in, const int* in_sizes, int n_in, void* d_out, int out_size, void* d_ws, size_t ws_size, hipStream_t stream) {
    static int grid = 0;
    if (grid == 0) {
        if (n_in != 18 || out_size != S * D || ws_size < WS_END) { fprintf(stderr, "kernel_launch: unexpected shapes (n_in %d out %d ws %zu, need %zu)\n", n_in, out_size, ws_size, (size_t)WS_END); grid = -1; return; }
        int dev = 0, cus = 0, per_cu = 0;
        if (hipGetDevice(&dev) != hipSuccess || hipDeviceGetAttribute(&cus, hipDeviceAttributeMultiprocessorCount, dev) != hipSuccess) { grid = -1; return; }
        if (hipFuncSetAttribute((const void*)mk_fwd, hipFuncAttributeMaxDynamicSharedMemorySize, LDS_BYTES) != hipSuccess) { fprintf(stderr, "kernel_launch: hipFuncSetAttribute failed\n"); grid = -1; return; }
        if (hipOccupancyMaxActiveBlocksPerMultiprocessor(&per_cu, (const void*)mk_fwd, 512, LDS_BYTES) != hipSuccess || per_cu < 1) fprintf(stderr, "kernel_launch: occupancy query says %d\n", per_cu);
        (void)hipGetLastError();
        grid = cus;
    }
    if (grid < 0) return;
    (void)hipMemsetAsync((char*)d_ws + WS_CTL, 0, CTL_ZERO_BYTES, stream);
    Args a{};
    for (int i = 0; i < 18; ++i) a.in[i] = (const float*)d_in[i];
    a.out = (float*)d_out; a.ws = (unsigned char*)d_ws;
#if MK_PER_PHASE
    for (int p = 0; p < NPHASE; ++p) { a.ph_lo = p; a.ph_hi = p + 1; hipLaunchKernelGGL(mk_fwd, dim3(grid), dim3(512), LDS_BYTES, stream, a); }
#else
    a.ph_lo = 0; a.ph_hi = NPHASE;
    hipLaunchKernelGGL(mk_fwd, dim3(grid), dim3(512), LDS_BYTES, stream, a);
#endif
}
```
